# Optimizing an MI355X kernel written in HIP

```python
import math
import jax, jax.numpy as jnp
from jax import lax
import numpy as np

D_MODEL = 1024
BATCH = 4
SEQ = 8192
DEPTH = 1

HEAD_DIM = 128
HEADS_PER_GROUP = 4
DILATED_GROUPS = ((128, 1), (512, 4), (2048, 16))
N_GROUPS = 3
N_ATTN_HEADS = N_GROUPS * HEADS_PER_GROUP
ATTN_QKV_WIDTH = N_ATTN_HEADS * HEAD_DIM
ATTN_OUT_WIDTH = HEADS_PER_GROUP * HEAD_DIM
BAND_BLOCK = 128
LRU_WIDTH = D_MODEL
LRU_HEADS = 4
LRU_HEAD_DIM = LRU_WIDTH // LRU_HEADS
CONV_WIDTH = 4
LRU_C = 8.0
D_FF = 2816
REL_BUCKETS = 32
REL_MAX_DISTANCE = 2048
NORM_EPS = 1e-6
N_BRANCHES = 2
W_IN_COLS = 3 * ATTN_QKV_WIDTH + 2 * LRU_WIDTH + N_BRANCHES * D_MODEL

kernel_name = "hybrid_dilated_attn_rglru_macaron"


def rms_norm(x, g):
    xf = x.astype(jnp.float32)
    y = xf * lax.rsqrt(jnp.mean(xf * xf, axis=-1, keepdims=True) + NORM_EPS)
    return (y * g.astype(jnp.float32)).astype(x.dtype)


def swiglu(x, w_gate, w_up, w_down):
    return (jax.nn.silu(x @ w_gate) * (x @ w_up)) @ w_down


def t5_causal_bucket(distance):
    max_exact = REL_BUCKETS // 2
    nf = jnp.maximum(distance, 1).astype(jnp.float32)
    large = max_exact + (jnp.log(nf / max_exact) / math.log(REL_MAX_DISTANCE / max_exact)
                         * (REL_BUCKETS - max_exact)).astype(jnp.int32)
    large = jnp.minimum(large, REL_BUCKETS - 1)
    return jnp.where(distance < max_exact, distance, large)


def dilated_group_attention(q, k, v, bias_table_g, window, dilation):
    B, S, H, E = q.shape
    d = dilation
    L = S // d
    nb = -(-L // BAND_BLOCK)
    Lp = nb * BAND_BLOCK
    m_max = window // d

    def to_blocks(t):
        t = t.reshape(B, L, d, H, E)
        t = jnp.pad(t, ((0, 0), (0, Lp - L), (0, 0), (0, 0), (0, 0)))
        return t.reshape(B, nb, BAND_BLOCK, d, H, E)

    def band(t):
        tb = jnp.pad(to_blocks(t), ((0, 0), (1, 0), (0, 0), (0, 0), (0, 0), (0, 0)))
        return jnp.concatenate([tb[:, :-1], tb[:, 1:]], axis=2)

    qb = to_blocks(q)
    kb = band(k)
    vb = band(v)

    qi = jnp.arange(BAND_BLOCK)[:, None]
    kj = jnp.arange(2 * BAND_BLOCK)[None, :]
    steps = qi + BAND_BLOCK - kj
    key_idx = jnp.arange(nb)[:, None, None] * BAND_BLOCK - BAND_BLOCK + kj[None]
    valid = (steps >= 0) & (steps <= m_max) & (key_idx >= 0)
    bucket = t5_causal_bucket(jnp.maximum(steps, 0) * d)
    bias = jnp.transpose(bias_table_g[bucket], (2, 0, 1)).astype(jnp.float32)

    scale = 1.0 / math.sqrt(E)
    scores = jnp.einsum('bnqphe,bnkphe->bphnqk', qb, kb).astype(jnp.float32) * scale
    scores = scores + bias[None, None, :, None]
    scores = jnp.where(valid[None, None, None], scores, -jnp.inf)
    mx = jnp.max(scores, axis=-1, keepdims=True)
    e = jnp.exp(scores - mx)
    den = jnp.sum(e, axis=-1, keepdims=True)
    o = jnp.einsum('bphnqk,bnkphe->bnqphe', (e / den).astype(v.dtype), vb)
    lse = (mx + jnp.log(den))[..., 0]
    o = o.reshape(B, Lp, d, H, E)[:, :L].reshape(B, S, H, E)
    lse = jnp.transpose(lse, (0, 3, 4, 1, 2)).reshape(B, Lp, d, H)[:, :L].reshape(B, S, H)
    return o, lse


def rg_lru_branch(xr, conv_w, conv_b, w_x, b_x, w_a, b_a, a_param):
    B, S, C = xr.shape
    xc = lax.conv_general_dilated(
        xr, conv_w[:, None, :].astype(xr.dtype), window_strides=(1,),
        padding=((CONV_WIDTH - 1, 0),), dimension_numbers=('NWC', 'WIO', 'NWC'),
        feature_group_count=C) + conv_b
    xh = xc.reshape(B, S, LRU_HEADS, LRU_HEAD_DIM)
    gate_x = jax.nn.sigmoid(jnp.einsum('bshi,hij->bshj', xh, w_x) + b_x).reshape(B, S, C)
    gate_a = jax.nn.sigmoid(jnp.einsum('bshi,hij->bshj', xh, w_a) + b_a).reshape(B, S, C)
    log_a = -LRU_C * gate_a.astype(jnp.float32) * jax.nn.softplus(-a_param.astype(jnp.float32))
    a = jnp.exp(log_a)
    b = jnp.sqrt(-jnp.expm1(2.0 * log_a)) * (gate_x * xc).astype(jnp.float32)

    def combine(left, right):
        a_l, b_l = left
        a_r, b_r = right
        return a_l * a_r, a_r * b_l + b_r

    _, h = lax.associative_scan(combine, (a, b), axis=1)
    return h.astype(xr.dtype)


def setup_inputs(seed: int = 0) -> dict:
    key = jax.random.key(seed)
    ks = jax.random.split(key, 32)
    f32 = jnp.float32

    def w(k, shape, fan_in):
        return jax.random.normal(k, shape, f32) * (fan_in ** -0.5)

    def gain(k):
        return 1.0 + 0.05 * jax.random.normal(k, (DEPTH, D_MODEL), f32)

    a0 = jax.random.uniform(ks[20], (DEPTH, LRU_WIDTH), f32, 0.9, 0.999)
    s = a0 ** (1.0 / LRU_C)
    a_param = jnp.log(s) - jnp.log1p(-s)

    return {
        "x": jax.random.normal(ks[0], (BATCH, SEQ, D_MODEL), f32),
        "ffn1_norm_pre": gain(ks[1]),
        "ffn1_norm_post": gain(ks[2]),
        "ffn1_w_gate": w(ks[3], (DEPTH, D_MODEL, D_FF), D_MODEL),
        "ffn1_w_up": w(ks[4], (DEPTH, D_MODEL, D_FF), D_MODEL),
        "ffn1_w_down": w(ks[5], (DEPTH, D_FF, D_MODEL), D_FF),
        "mix_norm_pre": gain(ks[6]),
        "mix_norm_post": gain(ks[7]),
        "w_in": w(ks[8], (DEPTH, D_MODEL, W_IN_COLS), D_MODEL),
        "rel_bias_table": 0.2 * jax.random.normal(ks[9], (REL_BUCKETS, N_ATTN_HEADS), f32),
        "conv_w": w(ks[10], (DEPTH, CONV_WIDTH, LRU_WIDTH), CONV_WIDTH),
        "conv_b": 0.02 * jax.random.normal(ks[11], (DEPTH, LRU_WIDTH), f32),
        "lru_w_x": w(ks[12], (DEPTH, LRU_HEADS, LRU_HEAD_DIM, LRU_HEAD_DIM), LRU_HEAD_DIM),
        "lru_b_x": 0.02 * jax.random.normal(ks[13], (DEPTH, LRU_HEADS, LRU_HEAD_DIM), f32),
        "lru_w_a": w(ks[14], (DEPTH, LRU_HEADS, LRU_HEAD_DIM, LRU_HEAD_DIM), LRU_HEAD_DIM),
        "lru_b_a": 0.02 * jax.random.normal(ks[15], (DEPTH, LRU_HEADS, LRU_HEAD_DIM), f32),
        "lru_a_param": a_param,
        "w_attn_branch": w(ks[16], (DEPTH, ATTN_OUT_WIDTH, D_MODEL), ATTN_OUT_WIDTH),
        "w_rec_branch": w(ks[17], (DEPTH, LRU_WIDTH, D_MODEL), LRU_WIDTH),
        "w_out": w(ks[18], (DEPTH, D_MODEL, D_MODEL), D_MODEL),
        "ffn2_norm_pre": gain(ks[21]),
        "ffn2_norm_post": gain(ks[22]),
        "ffn2_w_gate": w(ks[23], (DEPTH, D_MODEL, D_FF), D_MODEL),
        "ffn2_w_up": w(ks[24], (DEPTH, D_MODEL, D_FF), D_MODEL),
        "ffn2_w_down": w(ks[25], (DEPTH, D_FF, D_MODEL), D_FF),
    }


def reference(x, ffn1_norm_pre, ffn1_norm_post, ffn1_w_gate, ffn1_w_up, ffn1_w_down,
              mix_norm_pre, mix_norm_post, w_in, rel_bias_table, conv_w, conv_b,
              lru_w_x, lru_b_x, lru_w_a, lru_b_a, lru_a_param,
              w_attn_branch, w_rec_branch, w_out,
              ffn2_norm_pre, ffn2_norm_post, ffn2_w_gate, ffn2_w_up, ffn2_w_down):
    B, S, _ = x.shape
    splits = [ATTN_QKV_WIDTH, 2 * ATTN_QKV_WIDTH, 3 * ATTN_QKV_WIDTH,
              3 * ATTN_QKV_WIDTH + LRU_WIDTH, 3 * ATTN_QKV_WIDTH + 2 * LRU_WIDTH]
    h = x
    for l in range(DEPTH):
        f = swiglu(rms_norm(h, ffn1_norm_pre[l]), ffn1_w_gate[l], ffn1_w_up[l], ffn1_w_down[l])
        h = h + 0.5 * rms_norm(f, ffn1_norm_post[l])

        u = rms_norm(h, mix_norm_pre[l])
        proj = u @ w_in[l]
        q, k, v, xr, yr, gl = jnp.split(proj, splits, axis=-1)
        q = q.reshape(B, S, N_GROUPS, HEADS_PER_GROUP, HEAD_DIM)
        k = k.reshape(B, S, N_GROUPS, HEADS_PER_GROUP, HEAD_DIM)
        v = v.reshape(B, S, N_GROUPS, HEADS_PER_GROUP, HEAD_DIM)

        outs, lses = [], []
        for g, (window, dilation) in enumerate(DILATED_GROUPS):
            o_g, lse_g = dilated_group_attention(
                q[:, :, g], k[:, :, g], v[:, :, g],
                rel_bias_table[:, g * HEADS_PER_GROUP:(g + 1) * HEADS_PER_GROUP],
                window, dilation)
            outs.append(o_g)
            lses.append(lse_g)
        alpha = jax.nn.softmax(jnp.stack(lses, axis=0), axis=0)
        attn = jnp.einsum('gbsh,gbshe->bshe', alpha, jnp.stack(outs, axis=0).astype(jnp.float32))
        attn_d = attn.astype(x.dtype).reshape(B, S, ATTN_OUT_WIDTH) @ w_attn_branch[l]

        rec = rg_lru_branch(xr, conv_w[l], conv_b[l], lru_w_x[l], lru_b_x[l],
                            lru_w_a[l], lru_b_a[l], lru_a_param[l]) * jax.nn.gelu(yr)
        rec_d = rec @ w_rec_branch[l]

        gates = jax.nn.sigmoid(gl).reshape(B, S, N_BRANCHES, D_MODEL)
        merged = gates[:, :, 0] * attn_d + gates[:, :, 1] * rec_d
        h = h + rms_norm(merged @ w_out[l], mix_norm_post[l])

        f = swiglu(rms_norm(h, ffn2_norm_pre[l]), ffn2_w_gate[l], ffn2_w_up[l], ffn2_w_down[l])
        h = h + 0.5 * rms_norm(f, ffn2_norm_post[l])
    return h
```

```cpp
#include <hip/hip_runtime.h>
#include <cstdio>
#include <cstdint>
#include <cmath>

namespace v0 {
constexpr int B = 4, S = 8192, D = 1024, M = B * S, FF = 2816, NH = 12, HD = 128, QW = 1536, WIN = 8704;
constexpr float EPS = 1e-6f;

__device__ __forceinline__ float wave_sum(float v) {
#pragma unroll
    for (int o = 1; o < 64; o <<= 1) v += __shfl_xor(v, o);
    return v;
}
__device__ __forceinline__ float wave_max(float v) {
#pragma unroll
    for (int o = 1; o < 64; o <<= 1) v = fmaxf(v, __shfl_xor(v, o));
    return v;
}
__device__ __forceinline__ float sigmoidf_(float x) { return 1.f / (1.f + expf(-x)); }
__device__ __forceinline__ float gelu_tanh(float x) { const float u = 0.7978845608028654f * (x + 0.044715f * x * x * x); return 0.5f * x * (1.f + tanhf(u)); }

__global__ void k_rmsnorm(const float* __restrict__ in, const float* __restrict__ g, const float* res, float* out, float coef, int rows) {
    const int wave = (blockIdx.x * blockDim.x + threadIdx.x) >> 6, lane = threadIdx.x & 63;
    if (wave >= rows) return;
    const float* x = in + (size_t)wave * D;
    float v[16]; float s = 0.f;
#pragma unroll
    for (int j = 0; j < 16; ++j) { v[j] = x[lane + 64 * j]; s += v[j] * v[j]; }
    s = wave_sum(s);
    const float r = rsqrtf(s * (1.f / D) + EPS);
#pragma unroll
    for (int j = 0; j < 16; ++j) { const int c = lane + 64 * j; float o = coef * v[j] * r * g[c]; if (res) o += res[(size_t)wave * D + c]; out[(size_t)wave * D + c] = o; }
}

__global__ void __launch_bounds__(256) k_gemm(const float* __restrict__ A, int lda, const float* __restrict__ Bm, int ldb, float* __restrict__ C, int ldc, int K) {
    __shared__ float As[8][128 + 4];
    __shared__ float Bs[8][128 + 4];
    const int tid = threadIdx.x, tx = tid & 15, ty = tid >> 4;
    const int row0 = blockIdx.y * 128, col0 = blockIdx.x * 128;
    float acc[8][8];
#pragma unroll
    for (int i = 0; i < 8; ++i)
#pragma unroll
        for (int j = 0; j < 8; ++j) acc[i][j] = 0.f;
    for (int k0 = 0; k0 < K; k0 += 8) {
        { const int r = tid >> 1, c = (tid & 1) * 4; const float4 a = *(const float4*)(A + (size_t)(row0 + r) * lda + k0 + c);
          As[c + 0][r] = a.x; As[c + 1][r] = a.y; As[c + 2][r] = a.z; As[c + 3][r] = a.w; }
        { const int r = tid >> 5, c = (tid & 31) * 4; const float4 b = *(const float4*)(Bm + (size_t)(k0 + r) * ldb + col0 + c);
          *(float4*)&Bs[r][c] = b; }
        __syncthreads();
#pragma unroll
        for (int k = 0; k < 8; ++k) {
            float a[8], b[8];
#pragma unroll
            for (int i = 0; i < 8; ++i) a[i] = As[k][ty * 8 + i];
#pragma unroll
            for (int j = 0; j < 8; ++j) b[j] = Bs[k][tx * 8 + j];
#pragma unroll
            for (int i = 0; i < 8; ++i)
#pragma unroll
                for (int j = 0; j < 8; ++j) acc[i][j] += a[i] * b[j];
        }
        __syncthreads();
    }
#pragma unroll
    for (int i = 0; i < 8; ++i) { float* cp = C + (size_t)(row0 + ty * 8 + i) * ldc + col0 + tx * 8;
        *(float4*)cp = make_float4(acc[i][0], acc[i][1], acc[i][2], acc[i][3]); *(float4*)(cp + 4) = make_float4(acc[i][4], acc[i][5], acc[i][6], acc[i][7]); }
}

__global__ void k_swiglu(const float* __restrict__ gu, float* __restrict__ hid, int rows) {
    const size_t i = (size_t)blockIdx.x * blockDim.x + threadIdx.x; if (i >= (size_t)rows * FF) return;
    const size_t r = i / FF; const int c = (int)(i % FF);
    const float g = gu[r * 2 * FF + c], u = gu[r * 2 * FF + FF + c];
    hid[i] = g * sigmoidf_(g) * u;
}

__device__ __forceinline__ int t5_bucket(int dist) {
    if (dist < 16) return dist;
    const double v = log((double)dist / 16.0) / log(128.0) * 16.0;
    int b = 16 + (int)v; return b < 31 ? b : 31;
}

__global__ void k_attn(const float* __restrict__ qkv, const float* __restrict__ bias_table, float* __restrict__ o, float* __restrict__ lse) {
    const int wave = (blockIdx.x * blockDim.x + threadIdx.x) >> 6, lane = threadIdx.x & 63;
    if (wave >= S * NH) return;
    const int t = wave / NH, head = wave % NH, g = head >> 2, hh = head & 3;
    const int dil = (g == 0) ? 1 : (g == 1 ? 4 : 16);
    const float* q = qkv + (size_t)t * 4608 + head * HD;
    const float scale = 0.08838834764831845f;
    float sc[3]; int tk[3];
#pragma unroll
    for (int j = 0; j < 3; ++j) {
        const int m = lane + 64 * j; const bool use = (j < 2) || (lane == 0);
        const int tt = t - m * dil; tk[j] = tt;
        float s = -INFINITY;
        if (use && m <= 128 && tt >= 0) {
            const float* k = qkv + (size_t)tt * 4608 + QW + head * HD; float a = 0.f;
            for (int e = 0; e < HD; ++e) a += q[e] * k[e];
            s = a * scale + bias_table[t5_bucket(m * dil) * NH + head];
        }
        sc[j] = s;
    }
    const float mx = wave_max(fmaxf(fmaxf(sc[0], sc[1]), sc[2]));
    float p[3]; float den = 0.f;
#pragma unroll
    for (int j = 0; j < 3; ++j) { p[j] = (sc[j] == -INFINITY) ? 0.f : expf(sc[j] - mx); den += p[j]; }
    den = wave_sum(den);
    float o0 = 0.f, o1 = 0.f;
    for (int m = 0; m <= 128; ++m) {
        const int j = m >> 6, src = m & 63;
        const float pm = __shfl(j == 0 ? p[0] : (j == 1 ? p[1] : p[2]), src);
        const int tt = t - m * dil;
        if (tt >= 0) { const float* v = qkv + (size_t)tt * 4608 + 2 * QW + head * HD; o0 += pm * v[lane]; o1 += pm * v[lane + 64]; }
    }
    float* op = o + (((size_t)g * S + t) * 4 + hh) * HD;
    op[lane] = o0 / den; op[lane + 64] = o1 / den;
    if (lane == 0) lse[((size_t)g * S + t) * 4 + hh] = mx + logf(den);
}

__global__ void k_merge(const float* __restrict__ o, const float* __restrict__ lse, float* __restrict__ attn) {
    const size_t i = (size_t)blockIdx.x * blockDim.x + threadIdx.x; if (i >= (size_t)S * 512) return;
    const int t = (int)(i / 512), c = (int)(i % 512), hh = c >> 7;
    const float l0 = lse[((size_t)0 * S + t) * 4 + hh], l1 = lse[((size_t)1 * S + t) * 4 + hh], l2 = lse[((size_t)2 * S + t) * 4 + hh];
    const float mx = fmaxf(l0, fmaxf(l1, l2)); const float e0 = expf(l0 - mx), e1 = expf(l1 - mx), e2 = expf(l2 - mx), inv = 1.f / (e0 + e1 + e2);
    attn[i] = (e0 * o[((size_t)0 * S + t) * 512 + c] + e1 * o[((size_t)1 * S + t) * 512 + c] + e2 * o[((size_t)2 * S + t) * 512 + c]) * inv;
}

__global__ void k_conv(const float* __restrict__ xr, int ldx, const float* __restrict__ cw, const float* __restrict__ cb, float* __restrict__ xc) {
    const size_t i = (size_t)blockIdx.x * blockDim.x + threadIdx.x; if (i >= (size_t)S * D) return;
    const int t = (int)(i / D), c = (int)(i % D);
    float a = cb[c];
#pragma unroll
    for (int j = 0; j < 4; ++j) { const int tt = t - 3 + j; if (tt >= 0) a += cw[j * D + c] * xr[(size_t)tt * ldx + c]; }
    xc[i] = a;
}

__global__ void k_lru_ab(float* gx, float* ga, const float* __restrict__ xc, const float* __restrict__ bx, const float* __restrict__ ba, const float* __restrict__ ap) {
    const size_t i = (size_t)blockIdx.x * blockDim.x + threadIdx.x; if (i >= (size_t)S * D) return;
    const int c = (int)(i % D);
    const float gxx = sigmoidf_(gx[i] + bx[c]), gaa = sigmoidf_(ga[i] + ba[c]);
    const float nap = -ap[c]; const float sp = (nap > 20.f) ? nap : log1pf(expf(nap));
    const float la = -8.f * gaa * sp;
    gx[i] = expf(la); ga[i] = sqrtf(-expm1f(2.f * la)) * gxx * xc[i];
}

__global__ void k_scan(const float* __restrict__ a, const float* __restrict__ b, const float* __restrict__ yr, int ldy, float* __restrict__ rec) {
    const int c = blockIdx.x * blockDim.x + threadIdx.x; if (c >= D) return;
    float h = 0.f;
    for (int t = 0; t < S; ++t) { h = a[(size_t)t * D + c] * h + b[(size_t)t * D + c]; rec[(size_t)t * D + c] = h * gelu_tanh(yr[(size_t)t * ldy + c]); }
}

__global__ void k_gate_merge(float* ad, const float* __restrict__ rd, const float* __restrict__ gl, int ldg) {
    const size_t i = (size_t)blockIdx.x * blockDim.x + threadIdx.x; if (i >= (size_t)S * D) return;
    const int t = (int)(i / D), c = (int)(i % D);
    ad[i] = sigmoidf_(gl[(size_t)t * ldg + c]) * ad[i] + sigmoidf_(gl[(size_t)t * ldg + D + c]) * rd[i];
}
}

extern "C" void kernel_launch(void* const* d_in, const int* in_sizes, int n_in, void* d_out, int out_size, void* d_ws, size_t ws_size, hipStream_t stream) {
    using namespace v0;
    const float* x = (const float*)d_in[0];
    const float *n1pre = (const float*)d_in[1], *n1post = (const float*)d_in[2], *w1g = (const float*)d_in[3], *w1u = (const float*)d_in[4], *w1d = (const float*)d_in[5];
    const float *mpre = (const float*)d_in[6], *mpost = (const float*)d_in[7], *win = (const float*)d_in[8], *btab = (const float*)d_in[9];
    const float *cw = (const float*)d_in[10], *cb = (const float*)d_in[11], *wx = (const float*)d_in[12], *bx = (const float*)d_in[13], *wa = (const float*)d_in[14], *ba = (const float*)d_in[15], *ap = (const float*)d_in[16];
    const float *wab = (const float*)d_in[17], *wrb = (const float*)d_in[18], *wout = (const float*)d_in[19];
    const float *n2pre = (const float*)d_in[20], *n2post = (const float*)d_in[21], *w2g = (const float*)d_in[22], *w2u = (const float*)d_in[23], *w2d = (const float*)d_in[24];
    float* out = (float*)d_out;
    const size_t MiB = 1u << 20;
    char* ws = (char*)d_ws;
    float* U = (float*)(ws + 0 * MiB);
    float* BIG = (float*)(ws + 32 * MiB);
    float* HID = (float*)(ws + 208 * MiB);
    float* F = (float*)(ws + 296 * MiB);
    float* GXA = (float*)(ws + 328 * MiB);
    float* REC = (float*)(ws + 392 * MiB);
    float* AD = (float*)(ws + 424 * MiB);
    if (ws_size < 456 * MiB) { fprintf(stderr, "ws too small\n"); return; }
    auto gemm = [&](const float* A, int lda, const float* Bm, int ldb, float* C, int ldc, int rows, int N, int K) {
        hipLaunchKernelGGL(k_gemm, dim3(N / 128, rows / 128), dim3(256), 0, stream, A, lda, Bm, ldb, C, ldc, K);
    };
    for (int b = 0; b < B; ++b) {
        const float* xb = x + (size_t)b * S * D; float* h = out + (size_t)b * S * D;
        hipLaunchKernelGGL(k_rmsnorm, dim3(S / 4), dim3(256), 0, stream, xb, n1pre, (const float*)nullptr, U, 1.f, S);
        gemm(U, D, w1g, FF, BIG, 2 * FF, S, FF, D);
        gemm(U, D, w1u, FF, BIG + FF, 2 * FF, S, FF, D);
        hipLaunchKernelGGL(k_swiglu, dim3((unsigned)(((size_t)S * FF + 255) / 256)), dim3(256), 0, stream, BIG, HID, S);
        gemm(HID, FF, w1d, D, F, D, S, D, FF);
        hipLaunchKernelGGL(k_rmsnorm, dim3(S / 4), dim3(256), 0, stream, F, n1post, xb, h, 0.5f, S);
        hipLaunchKernelGGL(k_rmsnorm, dim3(S / 4), dim3(256), 0, stream, h, mpre, (const float*)nullptr, U, 1.f, S);
        float* QKV = BIG;
        gemm(U, D, win, WIN, QKV, 4608, S, 4608, D);
        float* OG = HID; float* ATT = HID + (size_t)3 * S * 512; float* LSE = ATT + (size_t)S * 512;
        hipLaunchKernelGGL(k_attn, dim3(S * NH / 4), dim3(256), 0, stream, QKV, btab, OG, LSE);
        hipLaunchKernelGGL(k_merge, dim3(S * 512 / 256), dim3(256), 0, stream, OG, LSE, ATT);
        float* XY = BIG; float* GL = BIG + (size_t)S * 2048;
        gemm(U, D, win + 4608, WIN, XY, 2048, S, 2048, D);
        gemm(U, D, win + 6656, WIN, GL, 2048, S, 2048, D);
        float* XC = F;
        hipLaunchKernelGGL(k_conv, dim3(S * D / 256), dim3(256), 0, stream, XY, 2048, cw, cb, XC);
        float* GX = GXA; float* GA = GXA + (size_t)S * D;
        for (int hd = 0; hd < 4; ++hd) {
            gemm(XC + hd * 256, D, wx + (size_t)hd * 65536, 256, GX + hd * 256, D, S, 256, 256);
            gemm(XC + hd * 256, D, wa + (size_t)hd * 65536, 256, GA + hd * 256, D, S, 256, 256);
        }
        hipLaunchKernelGGL(k_lru_ab, dim3(S * D / 256), dim3(256), 0, stream, GX, GA, XC, bx, ba, ap);
        hipLaunchKernelGGL(k_scan, dim3(D / 64), dim3(64), 0, stream, GX, GA, XY + D, 2048, REC);
        gemm(ATT, 512, wab, D, AD, D, S, D, 512);
        float* RD = F;
        gemm(REC, D, wrb, D, RD, D, S, D, D);
        hipLaunchKernelGGL(k_gate_merge, dim3(S * D / 256), dim3(256), 0, stream, AD, RD, GL, 2048);
        gemm(AD, D, wout, D, F, D, S, D, D);
        hipLaunchKernelGGL(k_rmsnorm, dim3(S / 4), dim3(256), 0, stream, F, mpost, h, h, 1.0f, S);
        hipLaunchKernelGGL(k_rmsnorm, dim3(S / 4), dim3(256), 0, stream, h, n2pre, (const float*)nullptr, U, 1.f, S);
        gemm(U, D, w2g, FF, BIG, 2 * FF, S, FF, D);
        gemm(U, D, w2u, FF, BIG + FF, 2 * FF, S, FF, D);
        hipLaunchKernelGGL(k_swiglu, dim3((unsigned)(((size_t)S * FF + 255) / 256)), dim3(256), 0, stream, BIG, HID, S);
        gemm(HID, FF, w2d, D, F, D, S, D, FF);
        hipLaunchKernelGGL(k_rmsnorm, dim3(S / 4), dim3(256), 0, stream, F, n2post, h, h, 0.5f, S);
    }
}
```

```cpp
#include <hip/hip_runtime.h>
#include <hip/hip_cooperative_groups.h>
#include <cstdio>
#include <cstdint>
#include <cmath>
namespace cg = cooperative_groups;

#define LAS __attribute__((address_space(3)))
typedef unsigned short bf16_t;
typedef short bf16x8 __attribute__((ext_vector_type(8)));
typedef float f32x4 __attribute__((ext_vector_type(4)));
typedef float f32x16 __attribute__((ext_vector_type(16)));
typedef unsigned u32x4 __attribute__((ext_vector_type(4)));
typedef unsigned u32x2 __attribute__((ext_vector_type(2)));
typedef short s16x4 __attribute__((ext_vector_type(4)));

constexpr int BATCH = 4, SEQ = 8192, DM = 1024, M = BATCH * SEQ, FF = 2816, NH = 12, HD = 128, QW = 1536, WINC = 8704;
constexpr float EPS = 1e-6f;
constexpr float LOG2E = 1.4426950408889634f;
constexpr float C2 = 0.08838834764831845f * 1.4426950408889634f;
constexpr int NWAVES = 8, NTHREADS = 512;

constexpr size_t MiB = 1u << 20;
constexpr size_t WS_RSQ0 = 64 * 1024, WS_RSQ1 = WS_RSQ0 + 128 * 1024, WS_RSQ2 = WS_RSQ1 + 128 * 1024;
constexpr size_t WS_WGU1 = 1 * MiB, WS_WD1 = 12 * MiB, WS_WIN = 18 * MiB, WS_WLRU = 35 * MiB, WS_WAB = 36 * MiB, WS_WRB = 37 * MiB, WS_WOUT = 39 * MiB, WS_WGU2 = 41 * MiB, WS_WD2 = 52 * MiB;
constexpr size_t WS_LSE = 58 * MiB;
constexpr size_t WS_AB = 60 * MiB;
constexpr size_t WS_Q = 124 * MiB, WS_K = 220 * MiB, WS_V = 316 * MiB;
constexpr size_t WS_OG = 412 * MiB;
constexpr size_t WS_HID = 124 * MiB;
constexpr size_t WS_F = 300 * MiB;
constexpr size_t WS_XR = 124 * MiB, WS_YG = 188 * MiB, WS_GT = 252 * MiB, WS_ATT = 380 * MiB, WS_XC = 60 * MiB;
constexpr size_t WS_LA = 124 * MiB, WS_BB = 412 * MiB, WS_CA = 476 * MiB, WS_CH = 478 * MiB;
constexpr size_t WS_REC = 60 * MiB, WS_MG = 124 * MiB;
constexpr size_t WS_END = 508 * MiB;
static_assert(WS_V - WS_K == WS_K - WS_Q && WS_GT - WS_YG == WS_YG - WS_XR, "section strides");

__device__ __forceinline__ float bf2f(unsigned short h) { return __uint_as_float((unsigned)h << 16); }
__device__ __forceinline__ float bflo(unsigned w) { return __uint_as_float(w << 16); }
__device__ __forceinline__ float bfhi(unsigned w) { return __uint_as_float(w & 0xffff0000u); }
__device__ __forceinline__ unsigned cvt_pk_bf16(float lo, float hi) { unsigned r; asm volatile("v_cvt_pk_bf16_f32 %0, %1, %2" : "=v"(r) : "v"(lo), "v"(hi)); return r; }
__device__ __forceinline__ float wave_sum(float v) {
#pragma unroll
    for (int o = 1; o < 64; o <<= 1) v += __shfl_xor(v, o);
    return v;
}
__device__ __forceinline__ float fast_sigmoid(float x) { return __builtin_amdgcn_rcpf(1.f + __builtin_amdgcn_exp2f(-x * LOG2E)); }
__device__ __forceinline__ float gelu_tanh(float x) {
    const float u = 0.7978845608028654f * (x + 0.044715f * x * x * x);
    return x * fast_sigmoid(2.f * u);
}

namespace pg8 {
constexpr int BM = 256, BK = 64, HALF = 128, HTB = HALF * BK * 2, STAGE_BYTES = 8 * HTB, NXCD = 8, WGM = 8;
__host__ __device__ __forceinline__ int lds_byte(int r, int c) { const int st = (r >> 4) * 2 + (c >> 5), rr = r & 15, cc = c & 31, ob = rr * 64 + cc * 2; return st * 1024 + (ob ^ (((ob >> 9) & 1) << 5)); }
__host__ __device__ __forceinline__ void stage_rc(int b, int& R, int& C) { const int st = b / 1024, sb = b % 1024, swz = sb ^ (((sb >> 9) & 1) << 5); R = (st >> 1) * 16 + swz / 64; C = (st & 1) * 32 + (swz % 64) / 2; }
__host__ __device__ __forceinline__ int perm32(int rho) { const int n = rho >> 4, i = rho & 15; return 8 * (i >> 2) + 4 * n + (i & 3); }

struct Unit { int pm, pn; };
struct Gemm { const bf16_t* A; int lda; const bf16_t* Bt; int ldb; int M, N, K; int amode; };

struct StaticOrder {
    int nM, nN, nwg, G, c;
    __device__ void init(int M_, int N_, int G_, int c_) { nM = M_ / BM; nN = N_ / BM; nwg = nM * nN; G = G_; c = c_; }
    __device__ bool next(int i, Unit& u) const {
        const long L = (long)i * G + c; if (L >= nwg) return false;
        int wgid = (int)L; { const int q = nwg / NXCD, r = nwg % NXCD, xcd = wgid % NXCD, off = wgid / NXCD; wgid = (xcd < r ? xcd * (q + 1) : r * (q + 1) + (xcd - r) * q) + off; }
        const int nig = WGM * nN, gid = wgid / nig, fm = gid * WGM, gsz = (nM - fm) < WGM ? (nM - fm) : WGM;
        u.pm = fm + ((wgid % nig) % gsz); u.pn = (wgid % nig) / gsz; return true;
    }
};

template <class Epi>
__device__ __forceinline__ void gemm_phase(LAS unsigned char* lds, const Gemm g, const StaticOrder& S, const Epi& E) {
    int tid = threadIdx.x; asm volatile("" : "+v"(tid));
    const int wid = __builtin_amdgcn_readfirstlane(tid >> 6), lane = tid & 63, wr = wid >> 2, wc = wid & 3, fr = lane & 15, fq = lane >> 4;
    const int K = g.K, nt = K / BK;
    unsigned voffA[2], voffB[2];
#pragma unroll
    for (int i = 0; i < 2; ++i) { int R, C; stage_rc(tid * 16 + i * 8192, R, C); const int Rb = (R & ~31) + perm32(R & 31);
        voffA[i] = (unsigned)(R * g.lda + C) * 2u; voffB[i] = (unsigned)(Rb * g.ldb + C) * 2u; }
    const size_t kstep = (size_t)(BK * 2);
    const size_t hstepA = (size_t)HALF * g.lda * 2, hstepB = (size_t)HALF * g.ldb * 2;
    const unsigned ldsw = (unsigned)wid * 1024u;
    const int aoff = lds_byte(wr * 64 + fr, fq * 8), boff = lds_byte(wc * 32 + fr, fq * 8);
#define PG8_SA(b, h) (((b) * 2 + (h)) * HTB)
#define PG8_SB(b, h) ((4 + (b) * 2 + (h)) * HTB)
#define PG8_STAGE(bufoff, gbase, voff) do { _Pragma("unroll") for (int _i = 0; _i < 2; ++_i) \
        __builtin_amdgcn_global_load_lds((const unsigned*)((const char*)(gbase) + (voff)[_i]), (LAS unsigned*)(lds + (bufoff) + ldsw + _i * 8192), 16, 0, 0); } while (0)
#define PG8_LDA(dst, b, h) do { _Pragma("unroll") for (int m = 0; m < 4; ++m) _Pragma("unroll") for (int k = 0; k < 2; ++k) dst[m][k] = *(const LAS bf16x8*)(lds + PG8_SA(b, h) + aoff + m * 2048 + k * 1024); } while (0)
#define PG8_LDB(dst, b, h) do { _Pragma("unroll") for (int n = 0; n < 2; ++n) _Pragma("unroll") for (int k = 0; k < 2; ++k) dst[n][k] = *(const LAS bf16x8*)(lds + PG8_SB(b, h) + boff + n * 2048 + k * 1024); } while (0)
#define PG8_MMA(ai, bj, At, Bt) do { __builtin_amdgcn_s_setprio(1); _Pragma("unroll") for (int m = 0; m < 4; ++m) _Pragma("unroll") for (int n = 0; n < 2; ++n) _Pragma("unroll") for (int k = 0; k < 2; ++k) \
        acc[ai][bj][m][n] = __builtin_amdgcn_mfma_f32_16x16x32_bf16(Bt[n][k], At[m][k], acc[ai][bj][m][n], 0, 0, 0); __builtin_amdgcn_s_setprio(0); } while (0)
#define PG8_WAIT_V(n) asm volatile("s_waitcnt vmcnt(" #n ")" ::: "memory")
#define PG8_WAIT_L(n) asm volatile("s_waitcnt lgkmcnt(" #n ")" ::: "memory")
#define PG8_BAR __builtin_amdgcn_s_barrier()
#define PG8_SCHED __builtin_amdgcn_sched_barrier(0)
#define PG8_APTR(u) ((const char*)g.A + (size_t)(u).pm * 2 * hstepA + (g.amode == 1 ? (size_t)(((u).pn >> 1) * 256 * 2) : (size_t)0))
#define PG8_BPTR(u) ((const char*)g.Bt + (size_t)(u).pn * 2 * hstepB)
    Unit cur, nxt; int ui = 0;
    if (!S.next(0, cur)) return;
    f32x4 acc[2][2][4][2];
#pragma unroll
    for (int a = 0; a < 2; ++a)
#pragma unroll
        for (int b = 0; b < 2; ++b)
#pragma unroll
            for (int m = 0; m < 4; ++m)
#pragma unroll
                for (int n = 0; n < 2; ++n) acc[a][b][m][n] = (f32x4){0.f, 0.f, 0.f, 0.f};
    bf16x8 At[4][2], B0[2][2], B1[2][2];
    const char* cA = PG8_APTR(cur); const char* cB = PG8_BPTR(cur);
    PG8_STAGE(PG8_SB(0, 0), cB, voffB); PG8_STAGE(PG8_SB(0, 1), cB + hstepB, voffB); PG8_STAGE(PG8_SA(0, 0), cA, voffA); PG8_STAGE(PG8_SA(0, 1), cA + hstepA, voffA);
    if (wr == 1) PG8_BAR;
    PG8_WAIT_V(2); PG8_BAR;
    PG8_STAGE(PG8_SB(1, 0), cB + kstep, voffB); PG8_STAGE(PG8_SA(1, 0), cA + kstep, voffA); PG8_STAGE(PG8_SB(1, 1), cB + hstepB + kstep, voffB);
    PG8_WAIT_V(6); PG8_BAR;
    for (;;) {
        const bool has_next = S.next(ui + 1, nxt);
        const char* nA = has_next ? PG8_APTR(nxt) : cA; const char* nB = has_next ? PG8_BPTR(nxt) : cB;
        for (int t = 0; t < nt; t += 2) {
            const bool last = (t == nt - 2);
            const char* a1 = cA + (size_t)(t + 1) * kstep;
            const char* a2 = last ? nA : cA + (size_t)(t + 2) * kstep; const char* b2 = last ? nB : cB + (size_t)(t + 2) * kstep;
            const char* a3 = a2 + kstep; const char* b3 = b2 + kstep;
            PG8_LDB(B0, 0, 0); PG8_LDB(B1, 0, 1); PG8_SCHED; PG8_LDA(At, 0, 0); PG8_STAGE(PG8_SA(1, 1), a1 + hstepA, voffA);
            PG8_WAIT_V(8); PG8_WAIT_L(0); PG8_BAR; PG8_MMA(0, 0, At, B0); PG8_MMA(0, 1, At, B1); PG8_BAR; PG8_SCHED;
            PG8_LDA(At, 0, 1); PG8_STAGE(PG8_SB(0, 0), b2, voffB); PG8_STAGE(PG8_SB(0, 1), b2 + hstepB, voffB); PG8_STAGE(PG8_SA(0, 0), a2, voffA);
            PG8_WAIT_V(8); PG8_WAIT_L(0); PG8_BAR; PG8_MMA(1, 0, At, B0); PG8_MMA(1, 1, At, B1); PG8_BAR; PG8_SCHED;
            PG8_LDB(B0, 1, 0); PG8_LDB(B1, 1, 1); PG8_SCHED; PG8_LDA(At, 1, 0); PG8_STAGE(PG8_SA(0, 1), a2 + hstepA, voffA);
            PG8_WAIT_V(8); PG8_WAIT_L(0); PG8_BAR; PG8_MMA(0, 0, At, B0); PG8_MMA(0, 1, At, B1); PG8_BAR; PG8_SCHED;
            PG8_LDA(At, 1, 1); PG8_STAGE(PG8_SB(1, 0), b3, voffB); PG8_STAGE(PG8_SB(1, 1), b3 + hstepB, voffB); PG8_STAGE(PG8_SA(1, 0), a3, voffA);
            PG8_WAIT_V(8); PG8_WAIT_L(0); PG8_BAR; PG8_MMA(1, 0, At, B0); PG8_MMA(1, 1, At, B1); PG8_BAR; PG8_SCHED;
        }
        if (wr == 0) PG8_BAR;
        E(acc, cur, wr, wc, fr, fq);
        if (!has_next) break;
#pragma unroll
        for (int a = 0; a < 2; ++a)
#pragma unroll
            for (int b = 0; b < 2; ++b)
#pragma unroll
                for (int m = 0; m < 4; ++m)
#pragma unroll
                    for (int n = 0; n < 2; ++n) acc[a][b][m][n] = (f32x4){0.f, 0.f, 0.f, 0.f};
        cur = nxt; cA = nA; cB = nB; ++ui;
        if (wr == 1) PG8_BAR;
    }
    PG8_WAIT_V(0);
    PG8_BAR;
#undef PG8_SA
#undef PG8_SB
#undef PG8_STAGE
#undef PG8_LDA
#undef PG8_LDB
#undef PG8_MMA
#undef PG8_WAIT_V
#undef PG8_WAIT_L
#undef PG8_BAR
#undef PG8_SCHED
#undef PG8_APTR
#undef PG8_BPTR
}

__device__ __forceinline__ float rowscale(const float* rsq, int row) { return rsqrtf(rsq[row] * (1.f / DM) + EPS); }

struct EpiSwiGLU {
    bf16_t* O; int ldc; const float* rsq;
    __device__ __forceinline__ void operator()(const f32x4 (&acc)[2][2][4][2], const Unit& u, int wr, int wc, int fr, int fq) const {
        const int row0 = u.pm * BM + wr * 64 + fr, col0 = u.pn * HALF + wc * 32 + 8 * fq;
#pragma unroll
        for (int ai = 0; ai < 2; ++ai)
#pragma unroll
            for (int m = 0; m < 4; ++m) { const int row = row0 + ai * HALF + m * 16; const float s = rowscale(rsq, row);
                float o[8];
#pragma unroll
                for (int n = 0; n < 2; ++n)
#pragma unroll
                    for (int i = 0; i < 4; ++i) { const float gt = acc[ai][0][m][n][i] * s, up = acc[ai][1][m][n][i] * s; o[n * 4 + i] = gt * fast_sigmoid(gt) * up; }
                u32x4 w; w.x = cvt_pk_bf16(o[0], o[1]); w.y = cvt_pk_bf16(o[2], o[3]); w.z = cvt_pk_bf16(o[4], o[5]); w.w = cvt_pk_bf16(o[6], o[7]);
                *(u32x4*)(O + (size_t)row * ldc + col0) = w; }
    }
};
struct EpiBf16 {
    bf16_t* O; int ldc;
    __device__ __forceinline__ void operator()(const f32x4 (&acc)[2][2][4][2], const Unit& u, int wr, int wc, int fr, int fq) const {
        const int row0 = u.pm * BM + wr * 64 + fr, col0 = u.pn * BM + wc * 32 + 8 * fq;
#pragma unroll
        for (int ai = 0; ai < 2; ++ai)
#pragma unroll
            for (int m = 0; m < 4; ++m) { bf16_t* rowp = O + (size_t)(row0 + ai * HALF + m * 16) * ldc + col0;
#pragma unroll
                for (int bj = 0; bj < 2; ++bj) { const f32x4 v0 = acc[ai][bj][m][0], v1 = acc[ai][bj][m][1];
                    u32x4 w; w.x = cvt_pk_bf16(v0[0], v0[1]); w.y = cvt_pk_bf16(v0[2], v0[3]); w.z = cvt_pk_bf16(v1[0], v1[1]); w.w = cvt_pk_bf16(v1[2], v1[3]);
                    *(u32x4*)(rowp + bj * HALF) = w; } }
    }
};
template <int MODE> struct EpiProj {
    bf16_t* o0; size_t sec_stride; const float* rsq;
    __device__ __forceinline__ void operator()(const f32x4 (&acc)[2][2][4][2], const Unit& u, int wr, int wc, int fr, int fq) const {
        const int row0 = u.pm * BM + wr * 64 + fr;
        int sec, ldc, colt; float sc = 1.f;
        if (MODE == 0) { sec = u.pn / 6; ldc = QW; colt = (u.pn % 6) * BM; if (sec == 0) sc = C2; }
        else { sec = u.pn < 8 ? (u.pn >> 2) : 2; ldc = u.pn < 8 ? DM : 2 * DM; colt = u.pn < 8 ? (u.pn & 3) * BM : (u.pn - 8) * BM; }
        bf16_t* base = o0 + (size_t)sec * sec_stride;
        const int col0 = colt + wc * 32 + 8 * fq;
#pragma unroll
        for (int ai = 0; ai < 2; ++ai)
#pragma unroll
            for (int m = 0; m < 4; ++m) { const int row = row0 + ai * HALF + m * 16; const float s = rowscale(rsq, row) * sc; bf16_t* rowp = base + (size_t)row * ldc + col0;
#pragma unroll
                for (int bj = 0; bj < 2; ++bj) { f32x4 v0 = acc[ai][bj][m][0] * s, v1 = acc[ai][bj][m][1] * s;
                    if (MODE == 1) {
                        if (sec == 1) {
#pragma unroll
                            for (int i = 0; i < 4; ++i) { v0[i] = gelu_tanh(v0[i]); v1[i] = gelu_tanh(v1[i]); }
                        } else if (sec == 2) {
#pragma unroll
                            for (int i = 0; i < 4; ++i) { v0[i] = fast_sigmoid(v0[i]); v1[i] = fast_sigmoid(v1[i]); }
                        }
                    }
                    u32x4 w; w.x = cvt_pk_bf16(v0[0], v0[1]); w.y = cvt_pk_bf16(v0[2], v0[3]); w.z = cvt_pk_bf16(v1[0], v1[1]); w.w = cvt_pk_bf16(v1[2], v1[3]);
                    *(u32x4*)(rowp + bj * HALF) = w; } }
    }
};
struct EpiLru {
    const bf16_t* XC; const float *bx, *ba, *ap; bf16_t *LA, *BB;
    __device__ __forceinline__ void operator()(const f32x4 (&acc)[2][2][4][2], const Unit& u, int wr, int wc, int fr, int fq) const {
        const int row0 = u.pm * BM + wr * 64 + fr, c0 = (u.pn >> 1) * 256 + (u.pn & 1) * 128 + wc * 32 + 8 * fq;
        float vbx[8], vba[8], vsp[8];
#pragma unroll
        for (int j = 0; j < 8; ++j) { vbx[j] = bx[c0 + j]; vba[j] = ba[c0 + j]; const float nap = -ap[c0 + j]; vsp[j] = -8.f * ((nap > 20.f) ? nap : log1pf(expf(nap))); }
#pragma unroll
        for (int ai = 0; ai < 2; ++ai)
#pragma unroll
            for (int m = 0; m < 4; ++m) { const int row = row0 + ai * HALF + m * 16; const size_t off = (size_t)row * DM + c0;
                const u32x4 xw = *(const u32x4*)(XC + off); float xv[8] = {bflo(xw.x), bfhi(xw.x), bflo(xw.y), bfhi(xw.y), bflo(xw.z), bfhi(xw.z), bflo(xw.w), bfhi(xw.w)};
                float la[8], bb[8];
#pragma unroll
                for (int n = 0; n < 2; ++n)
#pragma unroll
                    for (int i = 0; i < 4; ++i) { const int j = n * 4 + i; const float gx = fast_sigmoid(acc[ai][0][m][n][i] + vbx[j]), ga = fast_sigmoid(acc[ai][1][m][n][i] + vba[j]);
                        const float l = ga * vsp[j]; la[j] = l; const float x2 = 2.f * l;
                        const float om = (x2 > -0.25f) ? -x2 * (1.f + x2 * (0.5f + x2 * (0.16666667f + x2 * (0.041666668f + x2 * (0.0083333333f + x2 * 0.0013888889f))))) : 1.f - __expf(x2);
                        bb[j] = sqrtf(om) * gx * xv[j]; }
                u32x4 w; w.x = cvt_pk_bf16(la[0], la[1]); w.y = cvt_pk_bf16(la[2], la[3]); w.z = cvt_pk_bf16(la[4], la[5]); w.w = cvt_pk_bf16(la[6], la[7]); *(u32x4*)(LA + off) = w;
                u32x4 v; v.x = cvt_pk_bf16(bb[0], bb[1]); v.y = cvt_pk_bf16(bb[2], bb[3]); v.z = cvt_pk_bf16(bb[4], bb[5]); v.w = cvt_pk_bf16(bb[6], bb[7]); *(u32x4*)(BB + off) = v; }
    }
};
struct EpiGate {
    int mode; const bf16_t* GT; bf16_t* MG;
    __device__ __forceinline__ void operator()(const f32x4 (&acc)[2][2][4][2], const Unit& u, int wr, int wc, int fr, int fq) const {
        const int row0 = u.pm * BM + wr * 64 + fr, col0 = u.pn * BM + wc * 32 + 8 * fq;
#pragma unroll
        for (int ai = 0; ai < 2; ++ai)
#pragma unroll
            for (int m = 0; m < 4; ++m) { const int row = row0 + ai * HALF + m * 16;
#pragma unroll
                for (int bj = 0; bj < 2; ++bj) { const int col = col0 + bj * HALF;
                    const u32x4 gw = *(const u32x4*)(GT + (size_t)row * (2 * DM) + mode * DM + col);
                    const float gv[8] = {bflo(gw.x), bfhi(gw.x), bflo(gw.y), bfhi(gw.y), bflo(gw.z), bfhi(gw.z), bflo(gw.w), bfhi(gw.w)};
                    float o[8];
#pragma unroll
                    for (int n = 0; n < 2; ++n)
#pragma unroll
                        for (int i = 0; i < 4; ++i) o[n * 4 + i] = acc[ai][bj][m][n][i] * gv[n * 4 + i];
                    bf16_t* p = MG + (size_t)row * DM + col;
                    if (mode == 1) { const u32x4 pw = *(const u32x4*)p; o[0] += bflo(pw.x); o[1] += bfhi(pw.x); o[2] += bflo(pw.y); o[3] += bfhi(pw.y); o[4] += bflo(pw.z); o[5] += bfhi(pw.z); o[6] += bflo(pw.w); o[7] += bfhi(pw.w); }
                    u32x4 w; w.x = cvt_pk_bf16(o[0], o[1]); w.y = cvt_pk_bf16(o[2], o[3]); w.z = cvt_pk_bf16(o[4], o[5]); w.w = cvt_pk_bf16(o[6], o[7]);
                    *(u32x4*)p = w; } }
    }
};
}

struct Args {
    const float* in[25];
    float* out;
    unsigned char* ws;
};

__device__ __forceinline__ void p0_item(const float* W, int ldw, int k0, int n0, const float* gain, bf16_t* WT, int ldt, int drow0, LAS float* scr, int lane) {
#pragma unroll 8
    for (int i = 0; i < 32; ++i) { const int kk = 2 * i + (lane >> 5); float v = W[(size_t)(k0 + kk) * ldw + n0 + (lane & 31)]; if (gain) v *= gain[k0 + kk]; scr[kk * 33 + (lane & 31)] = v; }
    asm volatile("s_waitcnt lgkmcnt(0)" ::: "memory");
    const int c = lane & 7;
#pragma unroll
    for (int j = 0; j < 4; ++j) { const int n = (lane >> 3) + 8 * j; const LAS float* s = scr + (8 * c) * 33 + n;
        u32x4 o; o.x = cvt_pk_bf16(s[0 * 33], s[1 * 33]); o.y = cvt_pk_bf16(s[2 * 33], s[3 * 33]); o.z = cvt_pk_bf16(s[4 * 33], s[5 * 33]); o.w = cvt_pk_bf16(s[6 * 33], s[7 * 33]);
        *(u32x4*)(WT + (size_t)(drow0 + n) * ldt + k0 + 8 * c) = o; }
    asm volatile("s_waitcnt lgkmcnt(0)" ::: "memory");
}
template <int MAP>
__device__ __forceinline__ bool p0_job(int& r, const float* W, int ldw, int Ksrc, int Nsrc, const float* gain, bf16_t* WT, int ldt, int rowbase, LAS float* scr, int lane) {
    const int nblk = Nsrc / 32, items = (Ksrc / 64) * nblk;
    if (r >= items) { r -= items; return false; }
    const int kb = r / nblk, nb = r % nblk, n0 = nb * 32;
    int drow0 = rowbase + n0;
    if (MAP == 1 || MAP == 3) drow0 = rowbase + (n0 / 128) * 256 + (n0 % 128);
    if (MAP == 2) drow0 = rowbase + (n0 / 128) * 256 + 128 + (n0 % 128);
    p0_item(W, ldw, kb * 64, n0, gain, WT, ldt, drow0, scr, lane);
    return true;
}

__device__ __forceinline__ int t5_bucket(int dist) {
    if (dist < 16) return dist;
    const double v = log((double)dist / 16.0) / log(128.0) * 16.0;
    const int b = 16 + (int)v; return b < 31 ? b : 31;
}

__device__ __forceinline__ void norm_pass(const bf16_t* Fb, bf16_t* AB, const float* res, const float* gpost, float coef, float* hout, float* rsq_out, bool final_, int gw, int NGW, int lane) {
        for (int row = gw; row < M; row += NGW) {
            const bf16_t* fr_ = Fb + (size_t)row * DM; float fv[2][8]; float s = 0.f;
#pragma unroll
            for (int j = 0; j < 2; ++j) { const int c = 8 * lane + 512 * j; const u32x4 w = *(const u32x4*)(fr_ + c);
                fv[j][0] = bflo(w.x); fv[j][1] = bfhi(w.x); fv[j][2] = bflo(w.y); fv[j][3] = bfhi(w.y); fv[j][4] = bflo(w.z); fv[j][5] = bfhi(w.z); fv[j][6] = bflo(w.w); fv[j][7] = bfhi(w.w);
#pragma unroll
                for (int i = 0; i < 8; ++i) s += fv[j][i] * fv[j][i]; }
            s = wave_sum(s);
            const float rs = rsqrtf(s * (1.f / DM) + EPS) * coef; float s2 = 0.f;
#pragma unroll
            for (int j = 0; j < 2; ++j) { const int c = 8 * lane + 512 * j; const f32x4 r0 = *(const f32x4*)(res + (size_t)row * DM + c), r1 = *(const f32x4*)(res + (size_t)row * DM + c + 4);
                const f32x4 g0 = *(const f32x4*)(gpost + c), g1 = *(const f32x4*)(gpost + c + 4);
                f32x4 o0, o1;
#pragma unroll
                for (int i = 0; i < 4; ++i) { o0[i] = r0[i] + fv[j][i] * rs * g0[i]; o1[i] = r1[i] + fv[j][4 + i] * rs * g1[i]; s2 += o0[i] * o0[i] + o1[i] * o1[i]; }
                *(f32x4*)(hout + (size_t)row * DM + c) = o0; *(f32x4*)(hout + (size_t)row * DM + c + 4) = o1;
                if (!final_) { u32x4 w; w.x = cvt_pk_bf16(o0[0], o0[1]); w.y = cvt_pk_bf16(o0[2], o0[3]); w.z = cvt_pk_bf16(o1[0], o1[1]); w.w = cvt_pk_bf16(o1[2], o1[3]); *(u32x4*)(AB + (size_t)row * DM + c) = w; } }
            if (!final_) { s2 = wave_sum(s2); if (lane == 0) rsq_out[row] = s2; }
        }
    }

#ifndef PHMASK
#define PHMASK 0x1FFFF
#endif
#define PH(n) ((PHMASK >> (n)) & 1)
constexpr int LDS_BYTES = 144 * 1024;
constexpr int VSTRIDE = 320;
constexpr int ATT_V_BYTES = 32 * VSTRIDE;
constexpr int ATT_BIAS_OFF = NWAVES * ATT_V_BYTES;

#define P_x INP(0)
#define P_n1pre INP(1)
#define P_n1post INP(2)
#define P_w1g INP(3)
#define P_w1u INP(4)
#define P_w1d INP(5)
#define P_mpre INP(6)
#define P_mpost INP(7)
#define P_win INP(8)
#define P_btab INP(9)
#define P_cw INP(10)
#define P_cb INP(11)
#define P_wx INP(12)
#define P_bxp INP(13)
#define P_wa INP(14)
#define P_bap INP(15)
#define P_app INP(16)
#define P_wab INP(17)
#define P_wrb INP(18)
#define P_wout INP(19)
#define P_n2pre INP(20)
#define P_n2post INP(21)
#define P_w2g INP(22)
#define P_w2u INP(23)
#define P_w2d INP(24)
#define P_RSQ0 WSP(float, WS_RSQ0)
#define P_RSQ1 WSP(float, WS_RSQ1)
#define P_RSQ2 WSP(float, WS_RSQ2)
#define P_WGU1 WSP(bf16_t, WS_WGU1)
#define P_WD1 WSP(bf16_t, WS_WD1)
#define P_WIN WSP(bf16_t, WS_WIN)
#define P_WLRU WSP(bf16_t, WS_WLRU)
#define P_WAB WSP(bf16_t, WS_WAB)
#define P_WRB WSP(bf16_t, WS_WRB)
#define P_WOUT WSP(bf16_t, WS_WOUT)
#define P_WGU2 WSP(bf16_t, WS_WGU2)
#define P_WD2 WSP(bf16_t, WS_WD2)
#define P_AB WSP(bf16_t, WS_AB)
#define P_Qb WSP(bf16_t, WS_Q)
#define P_Kb WSP(bf16_t, WS_K)
#define P_Vb WSP(bf16_t, WS_V)
#define P_OG WSP(bf16_t, WS_OG)
#define P_HID WSP(bf16_t, WS_HID)
#define P_Fb WSP(bf16_t, WS_F)
#define P_XR WSP(bf16_t, WS_XR)
#define P_YG WSP(bf16_t, WS_YG)
#define P_GT WSP(bf16_t, WS_GT)
#define P_ATT WSP(bf16_t, WS_ATT)
#define P_XC WSP(bf16_t, WS_XC)
#define P_LA WSP(bf16_t, WS_LA)
#define P_BB WSP(bf16_t, WS_BB)
#define P_REC WSP(bf16_t, WS_REC)
#define P_MG WSP(bf16_t, WS_MG)
#define P_LSE WSP(float, WS_LSE)
#define P_CA WSP(float, WS_CA)
#define P_CH WSP(float, WS_CH)
#define P_out (KARGS()->out)
__global__ void __launch_bounds__(NTHREADS, 2) mk_fwd(Args args) {
    extern __shared__ __attribute__((aligned(16))) unsigned char lds_raw[];
    LAS unsigned char* lds = (LAS unsigned char*)lds_raw;
    cg::grid_group grid = cg::this_grid();
    const int G = gridDim.x, bx = blockIdx.x;
#define PHASE_IDS() int tid = threadIdx.x; asm volatile("" : "+v"(tid)); const int lane = tid & 63, wave = __builtin_amdgcn_readfirstlane(tid >> 6); \
    const int vcu = (G % 8 == 0) ? (bx % 8) * (G / 8) + bx / 8 : bx; const int gw = vcu * NWAVES + wave, NGW = G * NWAVES; (void)lane; (void)gw; (void)NGW; (void)vcu;
typedef const Args __attribute__((address_space(4)))* kargs_ptr_t;
#define KARGS() ({ kargs_ptr_t p_ = (kargs_ptr_t)__builtin_amdgcn_kernarg_segment_ptr(); asm volatile("" : "+s"(p_)); p_; })
#define INP(i) (KARGS()->in[i])
#define WSP(T, off) ((T*)(KARGS()->ws + (off)))
    if (PH(0)) { PHASE_IDS();
        LAS float* scr = (LAS float*)(lds + wave * 16384);
        constexpr int I_GU = 16 * 88, I_D = 44 * 32, I_IN = 16 * 272, I_L = 4 * 8, I_AB = 8 * 32, I_SQ = 16 * 32;
        constexpr int NITEMS = 6 * I_GU   + I_IN + 8 * I_L + I_AB + 2 * I_SQ;
        static_assert(I_D == I_GU, "item counts");
        for (int it = gw; it < NITEMS; it += NGW) {
            int r = it;
            if (p0_job<1>(r, P_w1g, FF, DM, FF, P_n1pre, P_WGU1, DM, 0, scr, lane)) continue;
            if (p0_job<2>(r, P_w1u, FF, DM, FF, P_n1pre, P_WGU1, DM, 0, scr, lane)) continue;
            if (p0_job<0>(r, P_w1d, DM, FF, DM, nullptr, P_WD1, FF, 0, scr, lane)) continue;
            if (p0_job<0>(r, P_win, WINC, DM, WINC, P_mpre, P_WIN, DM, 0, scr, lane)) continue;
            bool done = false;
#pragma unroll 1
            for (int h = 0; h < 4 && !done; ++h) {
                if (p0_job<1>(r, P_wx + (size_t)h * 65536, 256, 256, 256, nullptr, P_WLRU, 256, h * 512, scr, lane)) { done = true; break; }
                if (p0_job<2>(r, P_wa + (size_t)h * 65536, 256, 256, 256, nullptr, P_WLRU, 256, h * 512, scr, lane)) { done = true; break; }
            }
            if (done) continue;
            if (p0_job<0>(r, P_wab, DM, 512, DM, nullptr, P_WAB, 512, 0, scr, lane)) continue;
            if (p0_job<0>(r, P_wrb, DM, DM, DM, nullptr, P_WRB, DM, 0, scr, lane)) continue;
            if (p0_job<0>(r, P_wout, DM, DM, DM, nullptr, P_WOUT, DM, 0, scr, lane)) continue;
            if (p0_job<1>(r, P_w2g, FF, DM, FF, P_n2pre, P_WGU2, DM, 0, scr, lane)) continue;
            if (p0_job<2>(r, P_w2u, FF, DM, FF, P_n2pre, P_WGU2, DM, 0, scr, lane)) continue;
            p0_job<0>(r, P_w2d, DM, FF, DM, nullptr, P_WD2, FF, 0, scr, lane);
        }
        { const float* x_ = P_x; bf16_t* AB_ = P_AB; float* RSQ0_ = P_RSQ0;
        for (int row = gw; row < M; row += NGW) {
            const float* xr = x_ + (size_t)row * DM; float s = 0.f;
#pragma unroll
            for (int j = 0; j < 2; ++j) { const int c = 8 * lane + 512 * j; const f32x4 a = *(const f32x4*)(xr + c), b = *(const f32x4*)(xr + c + 4);
                s += (a[0] * a[0] + a[1] * a[1]) + (a[2] * a[2] + a[3] * a[3]) + (b[0] * b[0] + b[1] * b[1]) + (b[2] * b[2] + b[3] * b[3]);
                u32x4 w; w.x = cvt_pk_bf16(a[0], a[1]); w.y = cvt_pk_bf16(a[2], a[3]); w.z = cvt_pk_bf16(b[0], b[1]); w.w = cvt_pk_bf16(b[2], b[3]);
                *(u32x4*)(AB_ + (size_t)row * DM + c) = w; }
            s = wave_sum(s); if (lane == 0) RSQ0_[row] = s;
        } }
    }
    grid.sync();

    pg8::StaticOrder SO;
    if (PH(1)) { pg8::Gemm g{P_AB, DM, P_WGU1, DM, M, 2 * FF, DM, 0}; SO.init(M, 2 * FF, G, bx); pg8::EpiSwiGLU E{P_HID, FF, P_RSQ0}; pg8::gemm_phase(lds, g, SO, E); }
    grid.sync();
    if (PH(2)) { pg8::Gemm g{P_HID, FF, P_WD1, FF, M, DM, FF, 0}; SO.init(M, DM, G, bx); pg8::EpiBf16 E{P_Fb, DM}; pg8::gemm_phase(lds, g, SO, E); }
    grid.sync();
    if (PH(3)) { PHASE_IDS(); norm_pass(P_Fb, P_AB, P_x, P_n1post, 0.5f, P_out, P_RSQ1, false, gw, NGW, lane); }
    grid.sync();
    if (PH(4)) { pg8::Gemm g{P_AB, DM, P_WIN, DM, M, 3 * QW, DM, 0}; SO.init(M, 3 * QW, G, bx); pg8::EpiProj<0> E{P_Qb, (size_t)(WS_K - WS_Q) / 2, P_RSQ1}; pg8::gemm_phase(lds, g, SO, E); }
    grid.sync();
    if (PH(5)) { PHASE_IDS();
        LAS float* biasL = (LAS float*)(lds + ATT_BIAS_OFF);
        const float* btab_ = P_btab; const bf16_t *Qb_ = P_Qb, *Kb_ = P_Kb, *Vb_ = P_Vb; bf16_t* OG_ = P_OG; float* LSE_ = P_LSE;
        for (int i = tid; i < NH * 129; i += NTHREADS) { const int head = i / 129, st = i % 129, g_ = head >> 2; const int dil = g_ == 0 ? 1 : (g_ == 1 ? 4 : 16);
            biasL[head * 132 + st] = btab_[t5_bucket(st * dil) * NH + head] * LOG2E; }
        __syncthreads();
        LAS unsigned char* vl = lds + wave * ATT_V_BYTES;
        const int qq = lane & 31, hh2 = lane >> 5;
        const int tr_off = ((lane >> 4) >> 1) * 4 * VSTRIDE + (((lane & 15) >> 2)) * VSTRIDE + ((lane >> 4) & 1) * 32 + (lane & 3) * 8;
        for (int wu = vcu; wu < 1536; wu += G) {
            const int b = wu / 384, rem = wu % 384, head = rem >> 5, rem2 = rem & 31;
            const int g_ = head >> 2, hh = head & 3, dsh = 2 * g_;
            const int per = 32 >> dsh;
            const int p = rem2 / per, ub = rem2 % per;
            const int u0 = ub * 256 + wave * 32;
            const size_t rowb = (size_t)b * SEQ + p;
            const bf16_t* Qh = Qb_ + head * HD; const bf16_t* Kh = Kb_ + head * HD; const bf16_t* Vh = Vb_ + head * HD;
            bf16x8 Qf[8];
            { const bf16_t* qp = Qh + (rowb + ((size_t)(u0 + qq) << dsh)) * QW + hh2 * 8;
#pragma unroll
              for (int ks = 0; ks < 8; ++ks) Qf[ks] = *(const bf16x8*)(qp + ks * 16); }
            f32x16 O[4];
#pragma unroll
            for (int db = 0; db < 4; ++db)
#pragma unroll
                for (int i = 0; i < 16; ++i) O[db][i] = 0.f;
            float mrun = -INFINITY, lsum = 0.f;
            const int jstart = (u0 >= 128) ? 0 : (4 - (u0 >> 5));
            for (int j = jstart; j < 5; ++j) {
                const int kb_u = u0 - 128 + 32 * j;
                bf16x8 Kf[8];
                { const bf16_t* kp = Kh + (rowb + ((size_t)(kb_u + qq) << dsh)) * QW + hh2 * 8;
#pragma unroll
                  for (int ks = 0; ks < 8; ++ks) Kf[ks] = *(const bf16x8*)(kp + ks * 16); }
                u32x4 vst[8];
#pragma unroll
                for (int i = 0; i < 8; ++i) { const int rowi = i * 4 + (lane >> 4); vst[i] = *(const u32x4*)(Vh + (rowb + ((size_t)(kb_u + rowi) << dsh)) * QW + (lane & 15) * 8); }
#pragma unroll
                for (int i = 0; i < 8; ++i) { const int rowi = i * 4 + (lane >> 4); *(LAS u32x4*)(vl + rowi * VSTRIDE + (lane & 15) * 16) = vst[i]; }
                f32x16 Sx;
#pragma unroll
                for (int i = 0; i < 16; ++i) Sx[i] = 0.f;
#pragma unroll
                for (int ks = 0; ks < 8; ++ks) Sx = __builtin_amdgcn_mfma_f32_32x32x16_bf16(Kf[ks], Qf[ks], Sx, 0, 0, 0);
                float mx = -INFINITY;
                const LAS float* bh = biasL + head * 132;
#pragma unroll
                for (int i = 0; i < 16; ++i) { const int kk = (i & 3) + 8 * (i >> 2) + 4 * hh2; const int st = 128 - 32 * j + qq - kk;
                    const bool ok = (st >= 0) && (st <= 128); const float bv = bh[ok ? st : 0];
                    const float sc = ok ? Sx[i] + bv : -INFINITY; Sx[i] = sc; mx = fmaxf(mx, sc); }
                mx = fmaxf(mx, __shfl_xor(mx, 32));
                const float mnew = fmaxf(mrun, mx); const float alpha = __builtin_amdgcn_exp2f(mrun - mnew); mrun = mnew;
                float ps = 0.f;
#pragma unroll
                for (int i = 0; i < 16; ++i) { const float pv = __builtin_amdgcn_exp2f(Sx[i] - mnew); Sx[i] = pv; ps += pv; }
                lsum = lsum * alpha + ps;
#pragma unroll
                for (int db = 0; db < 4; ++db)
#pragma unroll
                    for (int i = 0; i < 16; ++i) O[db][i] *= alpha;
                bf16x8 Pf[2];
#pragma unroll
                for (int s = 0; s < 2; ++s) { u32x4 w; w.x = cvt_pk_bf16(Sx[8 * s + 0], Sx[8 * s + 1]); w.y = cvt_pk_bf16(Sx[8 * s + 2], Sx[8 * s + 3]); w.z = cvt_pk_bf16(Sx[8 * s + 4], Sx[8 * s + 5]); w.w = cvt_pk_bf16(Sx[8 * s + 6], Sx[8 * s + 7]);
                    Pf[s] = __builtin_bit_cast(bf16x8, w); }
                asm volatile("s_waitcnt lgkmcnt(0)" ::: "memory");
#pragma unroll
                for (int db = 0; db < 4; ++db)
#pragma unroll
                    for (int s = 0; s < 2; ++s) {
                        const LAS unsigned char* ap_ = vl + tr_off + (16 * s) * VSTRIDE + 64 * db;
                        const s16x4 lo = __builtin_bit_cast(s16x4, __builtin_amdgcn_ds_read_tr16_b64_v4i16((LAS s16x4*)ap_));
                        const s16x4 hi = __builtin_bit_cast(s16x4, __builtin_amdgcn_ds_read_tr16_b64_v4i16((LAS s16x4*)(ap_ + 8 * VSTRIDE)));
                        const bf16x8 Vf = (bf16x8){lo[0], lo[1], lo[2], lo[3], hi[0], hi[1], hi[2], hi[3]};
                        O[db] = __builtin_amdgcn_mfma_f32_32x32x16_bf16(Vf, Pf[s], O[db], 0, 0, 0);
                    }
                asm volatile("s_waitcnt lgkmcnt(0)" ::: "memory");
            }
            lsum += __shfl_xor(lsum, 32);
            const float inv = 1.f / lsum;
#pragma unroll
            for (int db = 0; db < 4; ++db)
#pragma unroll
                for (int a = 0; a < 4; ++a) { u32x2 w; w.x = cvt_pk_bf16(O[db][4 * a] * inv, O[db][4 * a + 1] * inv); w.y = cvt_pk_bf16(O[db][4 * a + 2] * inv, O[db][4 * a + 3] * inv);
                    *(LAS u32x2*)(vl + qq * VSTRIDE + (32 * db + 8 * a + 4 * hh2) * 2) = w; }
            asm volatile("s_waitcnt lgkmcnt(0)" ::: "memory");
            bf16_t* og = OG_ + (size_t)g_ * M * 512 + hh * HD;
#pragma unroll
            for (int i = 0; i < 8; ++i) { const int rowi = i * 4 + (lane >> 4); const u32x4 v = *(const LAS u32x4*)(vl + rowi * VSTRIDE + (lane & 15) * 16);
                *(u32x4*)(og + (rowb + ((size_t)(u0 + rowi) << dsh)) * 512 + (lane & 15) * 8) = v; }
            if (hh2 == 0) LSE_[((size_t)g_ * M + rowb + ((size_t)(u0 + qq) << dsh)) * 4 + hh] = mrun + __builtin_amdgcn_logf(lsum);
            asm volatile("s_waitcnt lgkmcnt(0)" ::: "memory");
        }
    }
    grid.sync();
    if (PH(6)) { pg8::Gemm g{P_AB, DM, P_WIN + (size_t)3 * QW * DM, DM, M, 4 * DM, DM, 0}; SO.init(M, 4 * DM, G, bx); pg8::EpiProj<1> E{P_XR, (size_t)(WS_YG - WS_XR) / 2, P_RSQ1}; pg8::gemm_phase(lds, g, SO, E); }
    grid.sync();
    if (PH(7)) { PHASE_IDS();
        const float *cw_ = P_cw, *cb_ = P_cb; const bf16_t* XR_ = P_XR; bf16_t* XC_ = P_XC; const float* LSE_ = P_LSE; const bf16_t* OG_ = P_OG; bf16_t* ATT_ = P_ATT;
        for (int it = gw; it < (M / 32) * 2; it += NGW) {
            const int rb = it >> 1, c0 = (it & 1) * 512 + lane * 8, r0 = rb * 32, t0 = r0 % SEQ;
            float w[4][8], bias[8];
#pragma unroll
            for (int j = 0; j < 4; ++j)
#pragma unroll
                for (int i = 0; i < 8; ++i) w[j][i] = cw_[j * DM + c0 + i];
#pragma unroll
            for (int i = 0; i < 8; ++i) bias[i] = cb_[c0 + i];
            float xw[3][8];
#pragma unroll
            for (int j = 0; j < 3; ++j) { const int tt = t0 - 3 + j;
                u32x4 v = (u32x4){0u, 0u, 0u, 0u}; if (tt >= 0) v = *(const u32x4*)(XR_ + (size_t)(r0 - 3 + j) * DM + c0);
                xw[j][0] = bflo(v.x); xw[j][1] = bfhi(v.x); xw[j][2] = bflo(v.y); xw[j][3] = bfhi(v.y); xw[j][4] = bflo(v.z); xw[j][5] = bfhi(v.z); xw[j][6] = bflo(v.w); xw[j][7] = bfhi(v.w); }
#pragma unroll 4
            for (int t = 0; t < 32; ++t) { const u32x4 v = *(const u32x4*)(XR_ + (size_t)(r0 + t) * DM + c0);
                const float x3[8] = {bflo(v.x), bfhi(v.x), bflo(v.y), bfhi(v.y), bflo(v.z), bfhi(v.z), bflo(v.w), bfhi(v.w)}; float o[8];
#pragma unroll
                for (int i = 0; i < 8; ++i) { o[i] = bias[i] + w[0][i] * xw[0][i] + w[1][i] * xw[1][i] + w[2][i] * xw[2][i] + w[3][i] * x3[i]; xw[0][i] = xw[1][i]; xw[1][i] = xw[2][i]; xw[2][i] = x3[i]; }
                u32x4 ov; ov.x = cvt_pk_bf16(o[0], o[1]); ov.y = cvt_pk_bf16(o[2], o[3]); ov.z = cvt_pk_bf16(o[4], o[5]); ov.w = cvt_pk_bf16(o[6], o[7]);
                *(u32x4*)(XC_ + (size_t)(r0 + t) * DM + c0) = ov; }
        }
        for (int row = gw; row < M; row += NGW) {
            const int hh = lane >> 4;
            const float l0 = LSE_[((size_t)0 * M + row) * 4 + hh], l1 = LSE_[((size_t)1 * M + row) * 4 + hh], l2 = LSE_[((size_t)2 * M + row) * 4 + hh];
            const float mx = fmaxf(l0, fmaxf(l1, l2)); const float e0 = __builtin_amdgcn_exp2f(l0 - mx), e1 = __builtin_amdgcn_exp2f(l1 - mx), e2 = __builtin_amdgcn_exp2f(l2 - mx);
            const float inv = 1.f / (e0 + e1 + e2); const float a0 = e0 * inv, a1 = e1 * inv, a2 = e2 * inv;
            const u32x4 v0 = *(const u32x4*)(OG_ + ((size_t)0 * M + row) * 512 + lane * 8), v1 = *(const u32x4*)(OG_ + ((size_t)1 * M + row) * 512 + lane * 8), v2 = *(const u32x4*)(OG_ + ((size_t)2 * M + row) * 512 + lane * 8);
            u32x4 o;
            o.x = cvt_pk_bf16(a0 * bflo(v0.x) + a1 * bflo(v1.x) + a2 * bflo(v2.x), a0 * bfhi(v0.x) + a1 * bfhi(v1.x) + a2 * bfhi(v2.x));
            o.y = cvt_pk_bf16(a0 * bflo(v0.y) + a1 * bflo(v1.y) + a2 * bflo(v2.y), a0 * bfhi(v0.y) + a1 * bfhi(v1.y) + a2 * bfhi(v2.y));
            o.z = cvt_pk_bf16(a0 * bflo(v0.z) + a1 * bflo(v1.z) + a2 * bflo(v2.z), a0 * bfhi(v0.z) + a1 * bfhi(v1.z) + a2 * bfhi(v2.z));
            o.w = cvt_pk_bf16(a0 * bflo(v0.w) + a1 * bflo(v1.w) + a2 * bflo(v2.w), a0 * bfhi(v0.w) + a1 * bfhi(v1.w) + a2 * bfhi(v2.w));
            *(u32x4*)(ATT_ + (size_t)row * 512 + lane * 8) = o;
        }
    }
    grid.sync();
    if (PH(8)) { pg8::Gemm g{P_XC, DM, P_WLRU, 256, M, 2 * DM, 256, 1}; SO.init(M, 2 * DM, G, bx); pg8::EpiLru E{P_XC, P_bxp, P_bap, P_app, P_LA, P_BB}; pg8::gemm_phase(lds, g, SO, E); }
    grid.sync();
    if (PH(9)) { PHASE_IDS(); const bf16_t *LA_ = P_LA, *BB_ = P_BB; float *CA_ = P_CA, *CH_ = P_CH;
    for (int it = gw; it < BATCH * 128 * 4; it += NGW) {
        const int qd = it & 3, ck = (it >> 2) & 127, b = it >> 9; const int c0 = qd * 256 + lane * 4; const size_t r0 = (size_t)b * SEQ + ck * 64;
        float h[4] = {0.f, 0.f, 0.f, 0.f}, sl[4] = {0.f, 0.f, 0.f, 0.f};
#pragma unroll 8
        for (int t = 0; t < 64; ++t) { const u32x2 lw = *(const u32x2*)(LA_ + (r0 + t) * DM + c0), bw = *(const u32x2*)(BB_ + (r0 + t) * DM + c0);
            const float l[4] = {bflo(lw.x), bfhi(lw.x), bflo(lw.y), bfhi(lw.y)}, bv[4] = {bflo(bw.x), bfhi(bw.x), bflo(bw.y), bfhi(bw.y)};
#pragma unroll
            for (int i = 0; i < 4; ++i) { sl[i] += l[i]; h[i] = __builtin_amdgcn_exp2f(l[i] * LOG2E) * h[i] + bv[i]; } }
        *(f32x4*)(CA_ + ((size_t)(b * 128 + ck)) * DM + c0) = (f32x4){sl[0], sl[1], sl[2], sl[3]};
        *(f32x4*)(CH_ + ((size_t)(b * 128 + ck)) * DM + c0) = (f32x4){h[0], h[1], h[2], h[3]};
    } }
    grid.sync();
    if (PH(10)) { PHASE_IDS(); const bf16_t *LA_ = P_LA, *BB_ = P_BB, *YG_ = P_YG; const float *CA_ = P_CA, *CH_ = P_CH; bf16_t* REC_ = P_REC;
    for (int it = gw; it < BATCH * 128 * 4; it += NGW) {
        const int qd = it & 3, ck = (it >> 2) & 127, b = it >> 9; const int c0 = qd * 256 + lane * 4; const size_t r0 = (size_t)b * SEQ + ck * 64;
        float h[4] = {0.f, 0.f, 0.f, 0.f};
        for (int k = 0; k < ck; ++k) { const f32x4 a = *(const f32x4*)(CA_ + ((size_t)(b * 128 + k)) * DM + c0), hv = *(const f32x4*)(CH_ + ((size_t)(b * 128 + k)) * DM + c0);
#pragma unroll
            for (int i = 0; i < 4; ++i) h[i] = __builtin_amdgcn_exp2f(a[i] * LOG2E) * h[i] + hv[i]; }
#pragma unroll 8
        for (int t = 0; t < 64; ++t) { const u32x2 lw = *(const u32x2*)(LA_ + (r0 + t) * DM + c0), bw = *(const u32x2*)(BB_ + (r0 + t) * DM + c0), yw = *(const u32x2*)(YG_ + (r0 + t) * DM + c0);
            const float l[4] = {bflo(lw.x), bfhi(lw.x), bflo(lw.y), bfhi(lw.y)}, bv[4] = {bflo(bw.x), bfhi(bw.x), bflo(bw.y), bfhi(bw.y)}, yv[4] = {bflo(yw.x), bfhi(yw.x), bflo(yw.y), bfhi(yw.y)};
            float o[4];
#pragma unroll
            for (int i = 0; i < 4; ++i) { h[i] = __builtin_amdgcn_exp2f(l[i] * LOG2E) * h[i] + bv[i]; o[i] = h[i] * yv[i]; }
            u32x2 w; w.x = cvt_pk_bf16(o[0], o[1]); w.y = cvt_pk_bf16(o[2], o[3]); *(u32x2*)(REC_ + (r0 + t) * DM + c0) = w; }
    } }
    grid.sync();
    if (PH(11)) { pg8::Gemm g{P_ATT, 512, P_WAB, 512, M, DM, 512, 0}; SO.init(M, DM, G, bx); pg8::EpiGate E{0, P_GT, P_MG}; pg8::gemm_phase(lds, g, SO, E); }
    if (PH(11)) { pg8::Gemm g{P_REC, DM, P_WRB, DM, M, DM, DM, 0}; SO.init(M, DM, G, bx); pg8::EpiGate E{1, P_GT, P_MG}; pg8::gemm_phase(lds, g, SO, E); }
    grid.sync();
    if (PH(12)) { pg8::Gemm g{P_MG, DM, P_WOUT, DM, M, DM, DM, 0}; SO.init(M, DM, G, bx); pg8::EpiBf16 E{P_Fb, DM}; pg8::gemm_phase(lds, g, SO, E); }
    grid.sync();
    if (PH(13)) { PHASE_IDS(); norm_pass(P_Fb, P_AB, P_out, P_mpost, 1.0f, P_out, P_RSQ2, false, gw, NGW, lane); }
    grid.sync();
    if (PH(14)) { pg8::Gemm g{P_AB, DM, P_WGU2, DM, M, 2 * FF, DM, 0}; SO.init(M, 2 * FF, G, bx); pg8::EpiSwiGLU E{P_HID, FF, P_RSQ2}; pg8::gemm_phase(lds, g, SO, E); }
    grid.sync();
    if (PH(15)) { pg8::Gemm g{P_HID, FF, P_WD2, FF, M, DM, FF, 0}; SO.init(M, DM, G, bx); pg8::EpiBf16 E{P_Fb, DM}; pg8::gemm_phase(lds, g, SO, E); }
    grid.sync();
    if (PH(16)) { PHASE_IDS(); norm_pass(P_Fb, P_AB, P_out, P_n2post, 0.5f, P_out, nullptr, true, gw, NGW, lane); }
}

extern "C" void kernel_launch(void* const* d_in, const int* in_sizes, int n_in, void* d_out, int out_size, void* d_ws, size_t ws_size, hipStream_t stream) {
    static int grid = 0;
    if (grid == 0) {
        if (n_in != 25 || out_size != M * DM || ws_size < WS_END) { fprintf(stderr, "kernel_launch: unexpected shapes (n_in %d out %d ws %zu)\n", n_in, out_size, ws_size); grid = -1; return; }
        int dev = 0, cus = 0, per_cu = 0;
        hipGetDevice(&dev); hipDeviceGetAttribute(&cus, hipDeviceAttributeMultiprocessorCount, dev);
        hipFuncSetAttribute((const void*)mk_fwd, hipFuncAttributeMaxDynamicSharedMemorySize, LDS_BYTES);
        hipOccupancyMaxActiveBlocksPerMultiprocessor(&per_cu, (const void*)mk_fwd, NTHREADS, LDS_BYTES);
        if (per_cu < 1) { fprintf(stderr, "kernel_launch: occupancy query says %d blocks per CU\n", per_cu); per_cu = 1; }
        grid = cus;
        fprintf(stderr, "kernel_launch: cus %d per_cu %d grid %d\n", cus, per_cu, grid);
    }
    if (grid < 0) return;
    Args a{};
    for (int i = 0; i < 25; ++i) a.in[i] = (const float*)d_in[i];
    a.out = (float*)d_out; a.ws = (unsigned char*)d_ws;
    void* kargs[] = {&a};
    hipError_t e = hipLaunchCooperativeKernel((const void*)mk_fwd, dim3(grid), dim3(NTHREADS), kargs, LDS_BYTES, stream);
    if (e != hipSuccess) fprintf(stderr, "cooperative launch failed: %s (grid %d)\n", hipGetErrorString(e), grid);
}
```

```cpp
#include <hip/hip_runtime.h>
#include <hip/hip_cooperative_groups.h>
#include <cstdio>
#include <cstdint>
#include <cmath>
namespace cg = cooperative_groups;

#define LAS __attribute__((address_space(3)))
typedef unsigned short bf16_t;
typedef short bf16x8 __attribute__((ext_vector_type(8)));
typedef float f32x4 __attribute__((ext_vector_type(4)));
typedef float f32x16 __attribute__((ext_vector_type(16)));
typedef unsigned u32x4 __attribute__((ext_vector_type(4)));
typedef unsigned u32x2 __attribute__((ext_vector_type(2)));
typedef short s16x4 __attribute__((ext_vector_type(4)));

constexpr int BATCH = 4, SEQ = 8192, DM = 1024, M = BATCH * SEQ, FF = 2816, NH = 12, HD = 128, QW = 1536, WINC = 8704;
constexpr float EPS = 1e-6f;
constexpr float LOG2E = 1.4426950408889634f;
constexpr float C2 = 0.08838834764831845f * 1.4426950408889634f;
constexpr int NWAVES = 8, NTHREADS = 512;

constexpr size_t MiB = 1u << 20;
constexpr size_t WS_RSQ0 = 64 * 1024, WS_RSQ1 = WS_RSQ0 + 128 * 1024, WS_RSQ2 = WS_RSQ1 + 128 * 1024;
constexpr size_t WS_WGU1 = 1 * MiB, WS_WD1 = 12 * MiB, WS_WIN = 18 * MiB, WS_WLRU = 35 * MiB, WS_WAB = 36 * MiB, WS_WRB = 37 * MiB, WS_WOUT = 39 * MiB, WS_WGU2 = 41 * MiB, WS_WD2 = 52 * MiB;
constexpr size_t WS_LSE = 58 * MiB;
constexpr size_t WS_AB = 60 * MiB;
constexpr size_t WS_Q = 124 * MiB, WS_K = 220 * MiB, WS_V = 316 * MiB;
constexpr size_t WS_OG = 412 * MiB;
constexpr size_t WS_HID = 124 * MiB;
constexpr size_t WS_F = 300 * MiB;
constexpr size_t WS_XR = 124 * MiB, WS_YG = 188 * MiB, WS_GT = 252 * MiB, WS_ATT = 380 * MiB, WS_XC = 60 * MiB;
constexpr size_t WS_LA = 124 * MiB, WS_BB = 412 * MiB, WS_CA = 476 * MiB, WS_CH = 478 * MiB;
constexpr size_t WS_REC = 60 * MiB, WS_MG = 124 * MiB;
constexpr size_t WS_END = 508 * MiB;
static_assert(WS_V - WS_K == WS_K - WS_Q && WS_GT - WS_YG == WS_YG - WS_XR, "section strides");

__device__ __forceinline__ float bf2f(unsigned short h) { return __uint_as_float((unsigned)h << 16); }
__device__ __forceinline__ float bflo(unsigned w) { return __uint_as_float(w << 16); }
__device__ __forceinline__ float bfhi(unsigned w) { return __uint_as_float(w & 0xffff0000u); }
__device__ __forceinline__ unsigned cvt_pk_bf16(float lo, float hi) { unsigned r; asm volatile("v_cvt_pk_bf16_f32 %0, %1, %2" : "=v"(r) : "v"(lo), "v"(hi)); return r; }
__device__ __forceinline__ float wave_sum(float v) {
#pragma unroll
    for (int o = 1; o < 64; o <<= 1) v += __shfl_xor(v, o);
    return v;
}
__device__ __forceinline__ float fast_sigmoid(float x) { return __builtin_amdgcn_rcpf(1.f + __builtin_amdgcn_exp2f(-x * LOG2E)); }
__device__ __forceinline__ float gelu_tanh(float x) {
    const float u = 0.7978845608028654f * (x + 0.044715f * x * x * x);
    return x * fast_sigmoid(2.f * u);
}

namespace pg8 {
constexpr int BM = 256, BK = 64, HALF = 128, HTB = HALF * BK * 2, STAGE_BYTES = 8 * HTB, NXCD = 8, WGM = 8;
__host__ __device__ __forceinline__ int lds_byte(int r, int c) { const int st = (r >> 4) * 2 + (c >> 5), rr = r & 15, cc = c & 31, ob = rr * 64 + cc * 2; return st * 1024 + (ob ^ (((ob >> 9) & 1) << 5)); }
__host__ __device__ __forceinline__ void stage_rc(int b, int& R, int& C) { const int st = b / 1024, sb = b % 1024, swz = sb ^ (((sb >> 9) & 1) << 5); R = (st >> 1) * 16 + swz / 64; C = (st & 1) * 32 + (swz % 64) / 2; }
__host__ __device__ __forceinline__ int perm32(int rho) { const int n = rho >> 4, i = rho & 15; return 8 * (i >> 2) + 4 * n + (i & 3); }

struct Unit { int pm, pn; };
struct Gemm { const bf16_t* A; int lda; const bf16_t* Bt; int ldb; int M, N, K; int amode; };

struct StaticOrder {
    int nM, nN, nwg, G, c;
    __device__ void init(int M_, int N_, int G_, int c_) { nM = M_ / BM; nN = N_ / BM; nwg = nM * nN; G = G_; c = c_; }
    __device__ bool next(int i, Unit& u) const {
        const long L = (long)i * G + c; if (L >= nwg) return false;
        int wgid = (int)L; { const int q = nwg / NXCD, r = nwg % NXCD, xcd = wgid % NXCD, off = wgid / NXCD; wgid = (xcd < r ? xcd * (q + 1) : r * (q + 1) + (xcd - r) * q) + off; }
        const int nig = WGM * nN, gid = wgid / nig, fm = gid * WGM, gsz = (nM - fm) < WGM ? (nM - fm) : WGM;
        u.pm = fm + ((wgid % nig) % gsz); u.pn = (wgid % nig) / gsz; return true;
    }
};

template <class Epi>
__device__ __forceinline__ void gemm_phase(LAS unsigned char* lds, const Gemm g, const StaticOrder& S, const Epi& E) {
    int tid = threadIdx.x; asm volatile("" : "+v"(tid));
    const int wid = __builtin_amdgcn_readfirstlane(tid >> 6), lane = tid & 63, wr = wid >> 2, wc = wid & 3, fr = lane & 15, fq = lane >> 4;
    const int K = g.K, nt = K / BK;
    unsigned voffA[2], voffB[2];
#pragma unroll
    for (int i = 0; i < 2; ++i) { int R, C; stage_rc(tid * 16 + i * 8192, R, C); const int Rb = (R & ~31) + perm32(R & 31);
        voffA[i] = (unsigned)(R * g.lda + C) * 2u; voffB[i] = (unsigned)(Rb * g.ldb + C) * 2u; }
    const size_t kstep = (size_t)(BK * 2);
    const size_t hstepA = (size_t)HALF * g.lda * 2, hstepB = (size_t)HALF * g.ldb * 2;
    const unsigned ldsw = (unsigned)wid * 1024u;
    const int aoff = lds_byte(wr * 64 + fr, fq * 8), boff = lds_byte(wc * 32 + fr, fq * 8);
#define PG8_SA(b, h) (((b) * 2 + (h)) * HTB)
#define PG8_SB(b, h) ((4 + (b) * 2 + (h)) * HTB)
#define PG8_STAGE(bufoff, gbase, voff) do { _Pragma("unroll") for (int _i = 0; _i < 2; ++_i) \
        __builtin_amdgcn_global_load_lds((const unsigned*)((const char*)(gbase) + (voff)[_i]), (LAS unsigned*)(lds + (bufoff) + ldsw + _i * 8192), 16, 0, 0); } while (0)
#define PG8_LDA(dst, b, h) do { _Pragma("unroll") for (int m = 0; m < 4; ++m) _Pragma("unroll") for (int k = 0; k < 2; ++k) dst[m][k] = *(const LAS bf16x8*)(lds + PG8_SA(b, h) + aoff + m * 2048 + k * 1024); } while (0)
#define PG8_LDB(dst, b, h) do { _Pragma("unroll") for (int n = 0; n < 2; ++n) _Pragma("unroll") for (int k = 0; k < 2; ++k) dst[n][k] = *(const LAS bf16x8*)(lds + PG8_SB(b, h) + boff + n * 2048 + k * 1024); } while (0)
#define PG8_MMA(ai, bj, At, Bt) do { __builtin_amdgcn_s_setprio(1); _Pragma("unroll") for (int m = 0; m < 4; ++m) _Pragma("unroll") for (int n = 0; n < 2; ++n) _Pragma("unroll") for (int k = 0; k < 2; ++k) \
        acc[ai][bj][m][n] = __builtin_amdgcn_mfma_f32_16x16x32_bf16(Bt[n][k], At[m][k], acc[ai][bj][m][n], 0, 0, 0); __builtin_amdgcn_s_setprio(0); } while (0)
#define PG8_WAIT_V(n) asm volatile("s_waitcnt vmcnt(" #n ")" ::: "memory")
#define PG8_WAIT_L(n) asm volatile("s_waitcnt lgkmcnt(" #n ")" ::: "memory")
#define PG8_BAR __builtin_amdgcn_s_barrier()
#define PG8_SCHED __builtin_amdgcn_sched_barrier(0)
#define PG8_APTR(u) ((const char*)g.A + (size_t)(u).pm * 2 * hstepA + (g.amode == 1 ? (size_t)(((u).pn >> 1) * 256 * 2) : (size_t)0))
#define PG8_BPTR(u) ((const char*)g.Bt + (size_t)(u).pn * 2 * hstepB)
    Unit cur, nxt; int ui = 0;
    if (!S.next(0, cur)) return;
    f32x4 acc[2][2][4][2];
#pragma unroll
    for (int a = 0; a < 2; ++a)
#pragma unroll
        for (int b = 0; b < 2; ++b)
#pragma unroll
            for (int m = 0; m < 4; ++m)
#pragma unroll
                for (int n = 0; n < 2; ++n) acc[a][b][m][n] = (f32x4){0.f, 0.f, 0.f, 0.f};
    bf16x8 At[4][2], B0[2][2], B1[2][2];
    const char* cA = PG8_APTR(cur); const char* cB = PG8_BPTR(cur);
    PG8_STAGE(PG8_SB(0, 0), cB, voffB); PG8_STAGE(PG8_SB(0, 1), cB + hstepB, voffB); PG8_STAGE(PG8_SA(0, 0), cA, voffA); PG8_STAGE(PG8_SA(0, 1), cA + hstepA, voffA);
    if (wr == 1) PG8_BAR;
    PG8_WAIT_V(2); PG8_BAR;
    PG8_STAGE(PG8_SB(1, 0), cB + kstep, voffB); PG8_STAGE(PG8_SA(1, 0), cA + kstep, voffA); PG8_STAGE(PG8_SB(1, 1), cB + hstepB + kstep, voffB);
    PG8_WAIT_V(6); PG8_BAR;
    for (;;) {
        const bool has_next = S.next(ui + 1, nxt);
        const char* nA = has_next ? PG8_APTR(nxt) : cA; const char* nB = has_next ? PG8_BPTR(nxt) : cB;
        for (int t = 0; t < nt; t += 2) {
            const bool last = (t == nt - 2);
            const char* a1 = cA + (size_t)(t + 1) * kstep;
            const char* a2 = last ? nA : cA + (size_t)(t + 2) * kstep; const char* b2 = last ? nB : cB + (size_t)(t + 2) * kstep;
            const char* a3 = a2 + kstep; const char* b3 = b2 + kstep;
            PG8_LDB(B0, 0, 0); PG8_LDB(B1, 0, 1); PG8_SCHED; PG8_LDA(At, 0, 0); PG8_STAGE(PG8_SA(1, 1), a1 + hstepA, voffA);
            PG8_WAIT_V(8); PG8_WAIT_L(0); PG8_BAR; PG8_MMA(0, 0, At, B0); PG8_MMA(0, 1, At, B1); PG8_BAR; PG8_SCHED;
            PG8_LDA(At, 0, 1); PG8_STAGE(PG8_SB(0, 0), b2, voffB); PG8_STAGE(PG8_SB(0, 1), b2 + hstepB, voffB); PG8_STAGE(PG8_SA(0, 0), a2, voffA);
            PG8_WAIT_V(8); PG8_WAIT_L(0); PG8_BAR; PG8_MMA(1, 0, At, B0); PG8_MMA(1, 1, At, B1); PG8_BAR; PG8_SCHED;
            PG8_LDB(B0, 1, 0); PG8_LDB(B1, 1, 1); PG8_SCHED; PG8_LDA(At, 1, 0); PG8_STAGE(PG8_SA(0, 1), a2 + hstepA, voffA);
            PG8_WAIT_V(8); PG8_WAIT_L(0); PG8_BAR; PG8_MMA(0, 0, At, B0); PG8_MMA(0, 1, At, B1); PG8_BAR; PG8_SCHED;
            PG8_LDA(At, 1, 1); PG8_STAGE(PG8_SB(1, 0), b3, voffB); PG8_STAGE(PG8_SB(1, 1), b3 + hstepB, voffB); PG8_STAGE(PG8_SA(1, 0), a3, voffA);
            PG8_WAIT_V(8); PG8_WAIT_L(0); PG8_BAR; PG8_MMA(1, 0, At, B0); PG8_MMA(1, 1, At, B1); PG8_BAR; PG8_SCHED;
        }
        if (wr == 0) PG8_BAR;
        E(acc, cur, wr, wc, fr, fq);
        if (!has_next) break;
#pragma unroll
        for (int a = 0; a < 2; ++a)
#pragma unroll
            for (int b = 0; b < 2; ++b)
#pragma unroll
                for (int m = 0; m < 4; ++m)
#pragma unroll
                    for (int n = 0; n < 2; ++n) acc[a][b][m][n] = (f32x4){0.f, 0.f, 0.f, 0.f};
        cur = nxt; cA = nA; cB = nB; ++ui;
        if (wr == 1) PG8_BAR;
    }
    PG8_WAIT_V(0);
    PG8_BAR;
#undef PG8_SA
#undef PG8_SB
#undef PG8_STAGE
#undef PG8_LDA
#undef PG8_LDB
#undef PG8_MMA
#undef PG8_WAIT_V
#undef PG8_WAIT_L
#undef PG8_BAR
#undef PG8_SCHED
#undef PG8_APTR
#undef PG8_BPTR
}

__device__ __forceinline__ float rowscale(const float* rsq, int row) { return rsqrtf(rsq[row] * (1.f / DM) + EPS); }

struct EpiSwiGLU {
    bf16_t* O; int ldc; const float* rsq;
    __device__ __forceinline__ void operator()(const f32x4 (&acc)[2][2][4][2], const Unit& u, int wr, int wc, int fr, int fq) const {
        const int row0 = u.pm * BM + wr * 64 + fr, col0 = u.pn * HALF + wc * 32 + 8 * fq;
#pragma unroll
        for (int ai = 0; ai < 2; ++ai)
#pragma unroll
            for (int m = 0; m < 4; ++m) { const int row = row0 + ai * HALF + m * 16; const float s = rowscale(rsq, row);
                float o[8];
#pragma unroll
                for (int n = 0; n < 2; ++n)
#pragma unroll
                    for (int i = 0; i < 4; ++i) { const float gt = acc[ai][0][m][n][i] * s, up = acc[ai][1][m][n][i] * s; o[n * 4 + i] = gt * fast_sigmoid(gt) * up; }
                u32x4 w; w.x = cvt_pk_bf16(o[0], o[1]); w.y = cvt_pk_bf16(o[2], o[3]); w.z = cvt_pk_bf16(o[4], o[5]); w.w = cvt_pk_bf16(o[6], o[7]);
                *(u32x4*)(O + (size_t)row * ldc + col0) = w; }
    }
};
struct EpiBf16 {
    bf16_t* O; int ldc;
    __device__ __forceinline__ void operator()(const f32x4 (&acc)[2][2][4][2], const Unit& u, int wr, int wc, int fr, int fq) const {
        const int row0 = u.pm * BM + wr * 64 + fr, col0 = u.pn * BM + wc * 32 + 8 * fq;
#pragma unroll
        for (int ai = 0; ai < 2; ++ai)
#pragma unroll
            for (int m = 0; m < 4; ++m) { bf16_t* rowp = O + (size_t)(row0 + ai * HALF + m * 16) * ldc + col0;
#pragma unroll
                for (int bj = 0; bj < 2; ++bj) { const f32x4 v0 = acc[ai][bj][m][0], v1 = acc[ai][bj][m][1];
                    u32x4 w; w.x = cvt_pk_bf16(v0[0], v0[1]); w.y = cvt_pk_bf16(v0[2], v0[3]); w.z = cvt_pk_bf16(v1[0], v1[1]); w.w = cvt_pk_bf16(v1[2], v1[3]);
                    *(u32x4*)(rowp + bj * HALF) = w; } }
    }
};
template <int MODE> struct EpiProj {
    bf16_t* o0; size_t sec_stride; const float* rsq;
    __device__ __forceinline__ void operator()(const f32x4 (&acc)[2][2][4][2], const Unit& u, int wr, int wc, int fr, int fq) const {
        const int row0 = u.pm * BM + wr * 64 + fr;
        int sec, ldc, colt; float sc = 1.f;
        if (MODE == 0) { sec = u.pn / 6; ldc = QW; colt = (u.pn % 6) * BM; if (sec == 0) sc = C2; }
        else { sec = u.pn < 8 ? (u.pn >> 2) : 2; ldc = u.pn < 8 ? DM : 2 * DM; colt = u.pn < 8 ? (u.pn & 3) * BM : (u.pn - 8) * BM; }
        bf16_t* base = o0 + (size_t)sec * sec_stride;
        const int col0 = colt + wc * 32 + 8 * fq;
#pragma unroll
        for (int ai = 0; ai < 2; ++ai)
#pragma unroll
            for (int m = 0; m < 4; ++m) { const int row = row0 + ai * HALF + m * 16; const float s = rowscale(rsq, row) * sc; bf16_t* rowp = base + (size_t)row * ldc + col0;
#pragma unroll
                for (int bj = 0; bj < 2; ++bj) { f32x4 v0 = acc[ai][bj][m][0] * s, v1 = acc[ai][bj][m][1] * s;
                    if (MODE == 1) {
                        if (sec == 1) {
#pragma unroll
                            for (int i = 0; i < 4; ++i) { v0[i] = gelu_tanh(v0[i]); v1[i] = gelu_tanh(v1[i]); }
                        } else if (sec == 2) {
#pragma unroll
                            for (int i = 0; i < 4; ++i) { v0[i] = fast_sigmoid(v0[i]); v1[i] = fast_sigmoid(v1[i]); }
                        }
                    }
                    u32x4 w; w.x = cvt_pk_bf16(v0[0], v0[1]); w.y = cvt_pk_bf16(v0[2], v0[3]); w.z = cvt_pk_bf16(v1[0], v1[1]); w.w = cvt_pk_bf16(v1[2], v1[3]);
                    *(u32x4*)(rowp + bj * HALF) = w; } }
    }
};
struct EpiLru {
    const bf16_t* XC; const float *bx, *ba, *ap; bf16_t *LA, *BB;
    __device__ __forceinline__ void operator()(const f32x4 (&acc)[2][2][4][2], const Unit& u, int wr, int wc, int fr, int fq) const {
        const int row0 = u.pm * BM + wr * 64 + fr, c0 = (u.pn >> 1) * 256 + (u.pn & 1) * 128 + wc * 32 + 8 * fq;
        float vbx[8], vba[8], vsp[8];
#pragma unroll
        for (int j = 0; j < 8; ++j) { vbx[j] = bx[c0 + j]; vba[j] = ba[c0 + j]; const float nap = -ap[c0 + j]; vsp[j] = -8.f * ((nap > 20.f) ? nap : log1pf(expf(nap))); }
#pragma unroll
        for (int ai = 0; ai < 2; ++ai)
#pragma unroll
            for (int m = 0; m < 4; ++m) { const int row = row0 + ai * HALF + m * 16; const size_t off = (size_t)row * DM + c0;
                const u32x4 xw = *(const u32x4*)(XC + off); float xv[8] = {bflo(xw.x), bfhi(xw.x), bflo(xw.y), bfhi(xw.y), bflo(xw.z), bfhi(xw.z), bflo(xw.w), bfhi(xw.w)};
                float la[8], bb[8];
#pragma unroll
                for (int n = 0; n < 2; ++n)
#pragma unroll
                    for (int i = 0; i < 4; ++i) { const int j = n * 4 + i; const float gx = fast_sigmoid(acc[ai][0][m][n][i] + vbx[j]), ga = fast_sigmoid(acc[ai][1][m][n][i] + vba[j]);
                        const float l = ga * vsp[j]; la[j] = l; const float x2 = 2.f * l;
                        const float om = (x2 > -0.25f) ? -x2 * (1.f + x2 * (0.5f + x2 * (0.16666667f + x2 * (0.041666668f + x2 * (0.0083333333f + x2 * 0.0013888889f))))) : 1.f - __expf(x2);
                        bb[j] = sqrtf(om) * gx * xv[j]; }
                u32x4 w; w.x = cvt_pk_bf16(la[0], la[1]); w.y = cvt_pk_bf16(la[2], la[3]); w.z = cvt_pk_bf16(la[4], la[5]); w.w = cvt_pk_bf16(la[6], la[7]); *(u32x4*)(LA + off) = w;
                u32x4 v; v.x = cvt_pk_bf16(bb[0], bb[1]); v.y = cvt_pk_bf16(bb[2], bb[3]); v.z = cvt_pk_bf16(bb[4], bb[5]); v.w = cvt_pk_bf16(bb[6], bb[7]); *(u32x4*)(BB + off) = v; }
    }
};
struct EpiGate {
    int mode; const bf16_t* GT; bf16_t* MG;
    __device__ __forceinline__ void operator()(const f32x4 (&acc)[2][2][4][2], const Unit& u, int wr, int wc, int fr, int fq) const {
        const int row0 = u.pm * BM + wr * 64 + fr, col0 = u.pn * BM + wc * 32 + 8 * fq;
#pragma unroll
        for (int ai = 0; ai < 2; ++ai)
#pragma unroll
            for (int m = 0; m < 4; ++m) { const int row = row0 + ai * HALF + m * 16;
#pragma unroll
                for (int bj = 0; bj < 2; ++bj) { const int col = col0 + bj * HALF;
                    const u32x4 gw = *(const u32x4*)(GT + (size_t)row * (2 * DM) + mode * DM + col);
                    const float gv[8] = {bflo(gw.x), bfhi(gw.x), bflo(gw.y), bfhi(gw.y), bflo(gw.z), bfhi(gw.z), bflo(gw.w), bfhi(gw.w)};
                    float o[8];
#pragma unroll
                    for (int n = 0; n < 2; ++n)
#pragma unroll
                        for (int i = 0; i < 4; ++i) o[n * 4 + i] = acc[ai][bj][m][n][i] * gv[n * 4 + i];
                    bf16_t* p = MG + (size_t)row * DM + col;
                    if (mode == 1) { const u32x4 pw = *(const u32x4*)p; o[0] += bflo(pw.x); o[1] += bfhi(pw.x); o[2] += bflo(pw.y); o[3] += bfhi(pw.y); o[4] += bflo(pw.z); o[5] += bfhi(pw.z); o[6] += bflo(pw.w); o[7] += bfhi(pw.w); }
                    u32x4 w; w.x = cvt_pk_bf16(o[0], o[1]); w.y = cvt_pk_bf16(o[2], o[3]); w.z = cvt_pk_bf16(o[4], o[5]); w.w = cvt_pk_bf16(o[6], o[7]);
                    *(u32x4*)p = w; } }
    }
};
}

struct Args {
    const float* in[25];
    float* out;
    unsigned char* ws;
};

__device__ __forceinline__ void p0_item(const float* W, int ldw, int k0, int n0, const float* gain, bf16_t* WT, int ldt, int drow0, LAS float* scr, int lane) {
#pragma unroll 8
    for (int i = 0; i < 32; ++i) { const int kk = 2 * i + (lane >> 5); float v = W[(size_t)(k0 + kk) * ldw + n0 + (lane & 31)]; if (gain) v *= gain[k0 + kk]; scr[kk * 33 + (lane & 31)] = v; }
    asm volatile("s_waitcnt lgkmcnt(0)" ::: "memory");
    const int c = lane & 7;
#pragma unroll
    for (int j = 0; j < 4; ++j) { const int n = (lane >> 3) + 8 * j; const LAS float* s = scr + (8 * c) * 33 + n;
        u32x4 o; o.x = cvt_pk_bf16(s[0 * 33], s[1 * 33]); o.y = cvt_pk_bf16(s[2 * 33], s[3 * 33]); o.z = cvt_pk_bf16(s[4 * 33], s[5 * 33]); o.w = cvt_pk_bf16(s[6 * 33], s[7 * 33]);
        *(u32x4*)(WT + (size_t)(drow0 + n) * ldt + k0 + 8 * c) = o; }
    asm volatile("s_waitcnt lgkmcnt(0)" ::: "memory");
}
template <int MAP>
__device__ __forceinline__ bool p0_job(int& r, const float* W, int ldw, int Ksrc, int Nsrc, const float* gain, bf16_t* WT, int ldt, int rowbase, LAS float* scr, int lane) {
    const int nblk = Nsrc / 32, items = (Ksrc / 64) * nblk;
    if (r >= items) { r -= items; return false; }
    const int kb = r / nblk, nb = r % nblk, n0 = nb * 32;
    int drow0 = rowbase + n0;
    if (MAP == 1 || MAP == 3) drow0 = rowbase + (n0 / 128) * 256 + (n0 % 128);
    if (MAP == 2) drow0 = rowbase + (n0 / 128) * 256 + 128 + (n0 % 128);
    p0_item(W, ldw, kb * 64, n0, gain, WT, ldt, drow0, scr, lane);
    return true;
}

__device__ __forceinline__ int t5_bucket(int dist) {
    if (dist < 16) return dist;
    const double v = log((double)dist / 16.0) / log(128.0) * 16.0;
    const int b = 16 + (int)v; return b < 31 ? b : 31;
}

__device__ __forceinline__ void norm_pass(const bf16_t* Fb, bf16_t* AB, const float* res, const float* gpost, float coef, float* hout, float* rsq_out, bool final_, int gw, int NGW, int lane) {
        for (int row = gw; row < M; row += NGW) {
            const bf16_t* fr_ = Fb + (size_t)row * DM; float fv[2][8]; float s = 0.f;
#pragma unroll
            for (int j = 0; j < 2; ++j) { const int c = 8 * lane + 512 * j; const u32x4 w = *(const u32x4*)(fr_ + c);
                fv[j][0] = bflo(w.x); fv[j][1] = bfhi(w.x); fv[j][2] = bflo(w.y); fv[j][3] = bfhi(w.y); fv[j][4] = bflo(w.z); fv[j][5] = bfhi(w.z); fv[j][6] = bflo(w.w); fv[j][7] = bfhi(w.w);
#pragma unroll
                for (int i = 0; i < 8; ++i) s += fv[j][i] * fv[j][i]; }
            s = wave_sum(s);
            const float rs = rsqrtf(s * (1.f / DM) + EPS) * coef; float s2 = 0.f;
#pragma unroll
            for (int j = 0; j < 2; ++j) { const int c = 8 * lane + 512 * j; const f32x4 r0 = *(const f32x4*)(res + (size_t)row * DM + c), r1 = *(const f32x4*)(res + (size_t)row * DM + c + 4);
                const f32x4 g0 = *(const f32x4*)(gpost + c), g1 = *(const f32x4*)(gpost + c + 4);
                f32x4 o0, o1;
#pragma unroll
                for (int i = 0; i < 4; ++i) { o0[i] = r0[i] + fv[j][i] * rs * g0[i]; o1[i] = r1[i] + fv[j][4 + i] * rs * g1[i]; s2 += o0[i] * o0[i] + o1[i] * o1[i]; }
                *(f32x4*)(hout + (size_t)row * DM + c) = o0; *(f32x4*)(hout + (size_t)row * DM + c + 4) = o1;
                if (!final_) { u32x4 w; w.x = cvt_pk_bf16(o0[0], o0[1]); w.y = cvt_pk_bf16(o0[2], o0[3]); w.z = cvt_pk_bf16(o1[0], o1[1]); w.w = cvt_pk_bf16(o1[2], o1[3]); *(u32x4*)(AB + (size_t)row * DM + c) = w; } }
            if (!final_) { s2 = wave_sum(s2); if (lane == 0) rsq_out[row] = s2; }
        }
    }

#define XB_TMO      128
#define XB_XCNT(j)  (256  + 64 * (j))
#define XB_XSUB(j)  (1280 + 64 * (j))
#define XB_XGEN(j)  (2304 + 64 * (j))
#define XB_TOP      3328
#define XB_TOPGEN   3392
#define XCD_BAR_WORDS 3456
#define XB_SPIN_CAP (1u << 18)

__device__ __forceinline__ unsigned xb_ld(unsigned* p)              { return __hip_atomic_load(p, __ATOMIC_RELAXED, __HIP_MEMORY_SCOPE_AGENT); }
__device__ __forceinline__ unsigned xb_add(unsigned* p, unsigned v) { return __hip_atomic_fetch_add(p, v, __ATOMIC_RELAXED, __HIP_MEMORY_SCOPE_AGENT); }
__device__ __forceinline__ unsigned xb_xcc_id() { return (unsigned)__builtin_amdgcn_s_getreg((3 << 11) | 20) & 0xFu; }
#define XB_SPIN(cond, bar) do { unsigned _sp = 0; while (cond) { __builtin_amdgcn_s_sleep(1); \
    if ((++_sp & 255u) == 0u) { if (xb_ld(&(bar)[XB_TMO])) break; if (_sp > XB_SPIN_CAP) { atomicAdd(&(bar)[XB_TMO], 1u); break; } } } } while (0)

struct XcdBarrier {
    unsigned* bar; unsigned x;
    volatile LAS unsigned* st;
};

__device__ __forceinline__ XcdBarrier xcd_barrier_post(unsigned* bar, volatile LAS unsigned* st) {
    XcdBarrier b; b.bar = bar; b.x = xb_xcc_id(); b.st = st;
    if (threadIdx.x == 0) (void)xb_add(&bar[XB_XCNT(b.x)], 1u);
    return b;
}
__device__ __forceinline__ void xcd_barrier_complete(unsigned* bar, unsigned x, unsigned& nloc, unsigned& nx) {
    const unsigned G = gridDim.x * gridDim.y * gridDim.z;
    unsigned sum, cnt, mine, sp = 0u;
    for (;;) {
        sum = 0u; cnt = 0u; mine = 0u;
#pragma unroll
        for (unsigned j = 0; j < 16; ++j) { const unsigned c = xb_ld(&bar[XB_XCNT(j)]); sum += c; cnt += (c > 0u) ? 1u : 0u; mine = (j == x) ? c : mine; }
        if (sum == G) break;
        __builtin_amdgcn_s_sleep(1);
        if ((++sp & 255u) == 0u) { if (xb_ld(&bar[XB_TMO])) break; if (sp > XB_SPIN_CAP) { atomicAdd(&bar[XB_TMO], 1u); break; } }
    }
    nloc = mine > 0u ? mine : 1u; nx = cnt > 0u ? cnt : 1u;
}

__device__ __forceinline__ void xcd_barrier(const XcdBarrier& b) {
    asm volatile("s_waitcnt vmcnt(0)" ::: "memory");
    __syncthreads();
    if (threadIdx.x == 0) {
        unsigned* bar = b.bar;
        __builtin_amdgcn_s_waitcnt(0);
        unsigned nloc = b.st[0], nx = b.st[1];
        if (nloc == 0u) { xcd_barrier_complete(bar, b.x, nloc, nx); b.st[0] = nloc; b.st[1] = nx; }
        const unsigned old = xb_add(&bar[XB_XSUB(b.x)], 1u);
        const unsigned gen = old / nloc;
        if (old + 1u == (gen + 1u) * nloc) {
            __builtin_amdgcn_fence(__ATOMIC_RELEASE, "agent");
            asm volatile("s_waitcnt vmcnt(0)" ::: "memory");
            const unsigned og = xb_add(&bar[XB_TOP], 1u);
            const unsigned tg = og / nx;
            if (og + 1u == (tg + 1u) * nx) xb_add(&bar[XB_TOPGEN], 1u);
            else XB_SPIN(xb_ld(&bar[XB_TOPGEN]) == tg, bar);
            __builtin_amdgcn_fence(__ATOMIC_ACQUIRE, "agent");
            xb_add(&bar[XB_XGEN(b.x)], 1u);
            asm volatile("s_waitcnt vmcnt(0)" ::: "memory");
        } else {
            XB_SPIN(xb_ld(&bar[XB_XGEN(b.x)]) == gen, bar);
            __builtin_amdgcn_fence(__ATOMIC_ACQUIRE, "agent");
            asm volatile("s_waitcnt vmcnt(0)" ::: "memory");
        }
    }
    __syncthreads();
}


#ifndef PHMASK
#define PHMASK 0x1FFFF
#endif
#define PH(n) ((PHMASK >> (n)) & 1)
constexpr int LDS_BYTES = 144 * 1024;
constexpr int BAR_LDS_OFF = 128 * 1024 + 256;
constexpr int VSTRIDE = 320;
constexpr int ATT_V_BYTES = 32 * VSTRIDE;
constexpr int ATT_BIAS_OFF = NWAVES * ATT_V_BYTES;

#define P_x INP(0)
#define P_n1pre INP(1)
#define P_n1post INP(2)
#define P_w1g INP(3)
#define P_w1u INP(4)
#define P_w1d INP(5)
#define P_mpre INP(6)
#define P_mpost INP(7)
#define P_win INP(8)
#define P_btab INP(9)
#define P_cw INP(10)
#define P_cb INP(11)
#define P_wx INP(12)
#define P_bxp INP(13)
#define P_wa INP(14)
#define P_bap INP(15)
#define P_app INP(16)
#define P_wab INP(17)
#define P_wrb INP(18)
#define P_wout INP(19)
#define P_n2pre INP(20)
#define P_n2post INP(21)
#define P_w2g INP(22)
#define P_w2u INP(23)
#define P_w2d INP(24)
#define P_RSQ0 WSP(float, WS_RSQ0)
#define P_RSQ1 WSP(float, WS_RSQ1)
#define P_RSQ2 WSP(float, WS_RSQ2)
#define P_WGU1 WSP(bf16_t, WS_WGU1)
#define P_WD1 WSP(bf16_t, WS_WD1)
#define P_WIN WSP(bf16_t, WS_WIN)
#define P_WLRU WSP(bf16_t, WS_WLRU)
#define P_WAB WSP(bf16_t, WS_WAB)
#define P_WRB WSP(bf16_t, WS_WRB)
#define P_WOUT WSP(bf16_t, WS_WOUT)
#define P_WGU2 WSP(bf16_t, WS_WGU2)
#define P_WD2 WSP(bf16_t, WS_WD2)
#define P_AB WSP(bf16_t, WS_AB)
#define P_Qb WSP(bf16_t, WS_Q)
#define P_Kb WSP(bf16_t, WS_K)
#define P_Vb WSP(bf16_t, WS_V)
#define P_OG WSP(bf16_t, WS_OG)
#define P_HID WSP(bf16_t, WS_HID)
#define P_Fb WSP(bf16_t, WS_F)
#define P_XR WSP(bf16_t, WS_XR)
#define P_YG WSP(bf16_t, WS_YG)
#define P_GT WSP(bf16_t, WS_GT)
#define P_ATT WSP(bf16_t, WS_ATT)
#define P_XC WSP(bf16_t, WS_XC)
#define P_LA WSP(bf16_t, WS_LA)
#define P_BB WSP(bf16_t, WS_BB)
#define P_REC WSP(bf16_t, WS_REC)
#define P_MG WSP(bf16_t, WS_MG)
#define P_LSE WSP(float, WS_LSE)
#define P_CA WSP(float, WS_CA)
#define P_CH WSP(float, WS_CH)
#define P_out (KARGS()->out)
__global__ void __launch_bounds__(NTHREADS, 2) mk_fwd(Args args) {
    extern __shared__ __attribute__((aligned(16))) unsigned char lds_raw[];
    LAS unsigned char* lds = (LAS unsigned char*)lds_raw;
    cg::grid_group grid = cg::this_grid();
#define KARGS_EARLY() ({ const Args __attribute__((address_space(4)))* p_ = (const Args __attribute__((address_space(4)))*)__builtin_amdgcn_kernarg_segment_ptr(); p_; })
    volatile LAS unsigned* bst = (volatile LAS unsigned*)(lds + BAR_LDS_OFF);
    if (threadIdx.x < 2) bst[threadIdx.x] = 0u;
    __syncthreads();
    (void)xcd_barrier_post((unsigned*)(KARGS_EARLY()->ws), bst);
#define GRID_BAR() do { XcdBarrier b_; b_.bar = (unsigned*)(KARGS()->ws); b_.x = xb_xcc_id(); b_.st = (volatile LAS unsigned*)(lds + BAR_LDS_OFF); xcd_barrier(b_); } while (0)
    const int G = gridDim.x, bx = blockIdx.x;
#define PHASE_IDS() int tid = threadIdx.x; asm volatile("" : "+v"(tid)); const int lane = tid & 63, wave = __builtin_amdgcn_readfirstlane(tid >> 6); \
    const int vcu = (G % 8 == 0) ? (bx % 8) * (G / 8) + bx / 8 : bx; const int gw = vcu * NWAVES + wave, NGW = G * NWAVES; (void)lane; (void)gw; (void)NGW; (void)vcu;
typedef const Args __attribute__((address_space(4)))* kargs_ptr_t;
#define KARGS() ({ kargs_ptr_t p_ = (kargs_ptr_t)__builtin_amdgcn_kernarg_segment_ptr(); asm volatile("" : "+s"(p_)); p_; })
#define INP(i) (KARGS()->in[i])
#define WSP(T, off) ((T*)(KARGS()->ws + (off)))
    if (PH(0)) { PHASE_IDS();
        LAS float* scr = (LAS float*)(lds + wave * 16384);
        constexpr int I_GU = 16 * 88, I_D = 44 * 32, I_IN = 16 * 272, I_L = 4 * 8, I_AB = 8 * 32, I_SQ = 16 * 32;
        constexpr int NITEMS = 6 * I_GU   + I_IN + 8 * I_L + I_AB + 2 * I_SQ;
        static_assert(I_D == I_GU, "item counts");
        for (int it = gw; it < NITEMS; it += NGW) {
            int r = it;
            if (p0_job<1>(r, P_w1g, FF, DM, FF, P_n1pre, P_WGU1, DM, 0, scr, lane)) continue;
            if (p0_job<2>(r, P_w1u, FF, DM, FF, P_n1pre, P_WGU1, DM, 0, scr, lane)) continue;
            if (p0_job<0>(r, P_w1d, DM, FF, DM, nullptr, P_WD1, FF, 0, scr, lane)) continue;
            if (p0_job<0>(r, P_win, WINC, DM, WINC, P_mpre, P_WIN, DM, 0, scr, lane)) continue;
            bool done = false;
#pragma unroll 1
            for (int h = 0; h < 4 && !done; ++h) {
                if (p0_job<1>(r, P_wx + (size_t)h * 65536, 256, 256, 256, nullptr, P_WLRU, 256, h * 512, scr, lane)) { done = true; break; }
                if (p0_job<2>(r, P_wa + (size_t)h * 65536, 256, 256, 256, nullptr, P_WLRU, 256, h * 512, scr, lane)) { done = true; break; }
            }
            if (done) continue;
            if (p0_job<0>(r, P_wab, DM, 512, DM, nullptr, P_WAB, 512, 0, scr, lane)) continue;
            if (p0_job<0>(r, P_wrb, DM, DM, DM, nullptr, P_WRB, DM, 0, scr, lane)) continue;
            if (p0_job<0>(r, P_wout, DM, DM, DM, nullptr, P_WOUT, DM, 0, scr, lane)) continue;
            if (p0_job<1>(r, P_w2g, FF, DM, FF, P_n2pre, P_WGU2, DM, 0, scr, lane)) continue;
            if (p0_job<2>(r, P_w2u, FF, DM, FF, P_n2pre, P_WGU2, DM, 0, scr, lane)) continue;
            p0_job<0>(r, P_w2d, DM, FF, DM, nullptr, P_WD2, FF, 0, scr, lane);
        }
        { const float* x_ = P_x; bf16_t* AB_ = P_AB; float* RSQ0_ = P_RSQ0;
        for (int row = gw; row < M; row += NGW) {
            const float* xr = x_ + (size_t)row * DM; float s = 0.f;
#pragma unroll
            for (int j = 0; j < 2; ++j) { const int c = 8 * lane + 512 * j; const f32x4 a = *(const f32x4*)(xr + c), b = *(const f32x4*)(xr + c + 4);
                s += (a[0] * a[0] + a[1] * a[1]) + (a[2] * a[2] + a[3] * a[3]) + (b[0] * b[0] + b[1] * b[1]) + (b[2] * b[2] + b[3] * b[3]);
                u32x4 w; w.x = cvt_pk_bf16(a[0], a[1]); w.y = cvt_pk_bf16(a[2], a[3]); w.z = cvt_pk_bf16(b[0], b[1]); w.w = cvt_pk_bf16(b[2], b[3]);
                *(u32x4*)(AB_ + (size_t)row * DM + c) = w; }
            s = wave_sum(s); if (lane == 0) RSQ0_[row] = s;
        } }
    }
    grid.sync();

    pg8::StaticOrder SO;
    if (PH(1)) { pg8::Gemm g{P_AB, DM, P_WGU1, DM, M, 2 * FF, DM, 0}; SO.init(M, 2 * FF, G, bx); pg8::EpiSwiGLU E{P_HID, FF, P_RSQ0}; pg8::gemm_phase(lds, g, SO, E); }
    GRID_BAR();
    if (PH(2)) { pg8::Gemm g{P_HID, FF, P_WD1, FF, M, DM, FF, 0}; SO.init(M, DM, G, bx); pg8::EpiBf16 E{P_Fb, DM}; pg8::gemm_phase(lds, g, SO, E); }
    GRID_BAR();
    if (PH(3)) { PHASE_IDS(); norm_pass(P_Fb, P_AB, P_x, P_n1post, 0.5f, P_out, P_RSQ1, false, gw, NGW, lane); }
    GRID_BAR();
    if (PH(4)) { pg8::Gemm g{P_AB, DM, P_WIN, DM, M, 3 * QW, DM, 0}; SO.init(M, 3 * QW, G, bx); pg8::EpiProj<0> E{P_Qb, (size_t)(WS_K - WS_Q) / 2, P_RSQ1}; pg8::gemm_phase(lds, g, SO, E); }
    GRID_BAR();
    if (PH(5)) { PHASE_IDS();
        LAS float* biasL = (LAS float*)(lds + ATT_BIAS_OFF);
        const float* btab_ = P_btab; const bf16_t *Qb_ = P_Qb, *Kb_ = P_Kb, *Vb_ = P_Vb; bf16_t* OG_ = P_OG; float* LSE_ = P_LSE;
        for (int i = tid; i < NH * 129; i += NTHREADS) { const int head = i / 129, st = i % 129, g_ = head >> 2; const int dil = g_ == 0 ? 1 : (g_ == 1 ? 4 : 16);
            biasL[head * 132 + st] = btab_[t5_bucket(st * dil) * NH + head] * LOG2E; }
        __syncthreads();
        LAS unsigned char* vl = lds + wave * ATT_V_BYTES;
        const int qq = lane & 31, hh2 = lane >> 5;
        const int tr_off = ((lane >> 4) >> 1) * 4 * VSTRIDE + (((lane & 15) >> 2)) * VSTRIDE + ((lane >> 4) & 1) * 32 + (lane & 3) * 8;
        for (int wu = vcu; wu < 1536; wu += G) {
            const int b = wu / 384, rem = wu % 384, head = rem >> 5, rem2 = rem & 31;
            const int g_ = head >> 2, hh = head & 3, dsh = 2 * g_;
            const int per = 32 >> dsh;
            const int p = rem2 / per, ub = rem2 % per;
            const int u0 = ub * 256 + wave * 32;
            const size_t rowb = (size_t)b * SEQ + p;
            const bf16_t* Qh = Qb_ + head * HD; const bf16_t* Kh = Kb_ + head * HD; const bf16_t* Vh = Vb_ + head * HD;
            bf16x8 Qf[8];
            { const bf16_t* qp = Qh + (rowb + ((size_t)(u0 + qq) << dsh)) * QW + hh2 * 8;
#pragma unroll
              for (int ks = 0; ks < 8; ++ks) Qf[ks] = *(const bf16x8*)(qp + ks * 16); }
            f32x16 O[4];
#pragma unroll
            for (int db = 0; db < 4; ++db)
#pragma unroll
                for (int i = 0; i < 16; ++i) O[db][i] = 0.f;
            float mrun = -INFINITY, lsum = 0.f;
            const int jstart = (u0 >= 128) ? 0 : (4 - (u0 >> 5));
            for (int j = jstart; j < 5; ++j) {
                const int kb_u = u0 - 128 + 32 * j;
                bf16x8 Kf[8];
                { const bf16_t* kp = Kh + (rowb + ((size_t)(kb_u + qq) << dsh)) * QW + hh2 * 8;
#pragma unroll
                  for (int ks = 0; ks < 8; ++ks) Kf[ks] = *(const bf16x8*)(kp + ks * 16); }
                u32x4 vst[8];
#pragma unroll
                for (int i = 0; i < 8; ++i) { const int rowi = i * 4 + (lane >> 4); vst[i] = *(const u32x4*)(Vh + (rowb + ((size_t)(kb_u + rowi) << dsh)) * QW + (lane & 15) * 8); }
#pragma unroll
                for (int i = 0; i < 8; ++i) { const int rowi = i * 4 + (lane >> 4); *(LAS u32x4*)(vl + rowi * VSTRIDE + (lane & 15) * 16) = vst[i]; }
                f32x16 Sx;
#pragma unroll
                for (int i = 0; i < 16; ++i) Sx[i] = 0.f;
#pragma unroll
                for (int ks = 0; ks < 8; ++ks) Sx = __builtin_amdgcn_mfma_f32_32x32x16_bf16(Kf[ks], Qf[ks], Sx, 0, 0, 0);
                float mx = -INFINITY;
                const LAS float* bh = biasL + head * 132;
#pragma unroll
                for (int i = 0; i < 16; ++i) { const int kk = (i & 3) + 8 * (i >> 2) + 4 * hh2; const int st = 128 - 32 * j + qq - kk;
                    const bool ok = (st >= 0) && (st <= 128); const float bv = bh[ok ? st : 0];
                    const float sc = ok ? Sx[i] + bv : -INFINITY; Sx[i] = sc; mx = fmaxf(mx, sc); }
                mx = fmaxf(mx, __shfl_xor(mx, 32));
                const float mnew = fmaxf(mrun, mx); const float alpha = __builtin_amdgcn_exp2f(mrun - mnew); mrun = mnew;
                float ps = 0.f;
#pragma unroll
                for (int i = 0; i < 16; ++i) { const float pv = __builtin_amdgcn_exp2f(Sx[i] - mnew); Sx[i] = pv; ps += pv; }
                lsum = lsum * alpha + ps;
#pragma unroll
                for (int db = 0; db < 4; ++db)
#pragma unroll
                    for (int i = 0; i < 16; ++i) O[db][i] *= alpha;
                bf16x8 Pf[2];
#pragma unroll
                for (int s = 0; s < 2; ++s) { u32x4 w; w.x = cvt_pk_bf16(Sx[8 * s + 0], Sx[8 * s + 1]); w.y = cvt_pk_bf16(Sx[8 * s + 2], Sx[8 * s + 3]); w.z = cvt_pk_bf16(Sx[8 * s + 4], Sx[8 * s + 5]); w.w = cvt_pk_bf16(Sx[8 * s + 6], Sx[8 * s + 7]);
                    Pf[s] = __builtin_bit_cast(bf16x8, w); }
                asm volatile("s_waitcnt lgkmcnt(0)" ::: "memory");
#pragma unroll
                for (int db = 0; db < 4; ++db)
#pragma unroll
                    for (int s = 0; s < 2; ++s) {
                        const LAS unsigned char* ap_ = vl + tr_off + (16 * s) * VSTRIDE + 64 * db;
                        const s16x4 lo = __builtin_bit_cast(s16x4, __builtin_amdgcn_ds_read_tr16_b64_v4i16((LAS s16x4*)ap_));
                        const s16x4 hi = __builtin_bit_cast(s16x4, __builtin_amdgcn_ds_read_tr16_b64_v4i16((LAS s16x4*)(ap_ + 8 * VSTRIDE)));
                        const bf16x8 Vf = (bf16x8){lo[0], lo[1], lo[2], lo[3], hi[0], hi[1], hi[2], hi[3]};
                        O[db] = __builtin_amdgcn_mfma_f32_32x32x16_bf16(Vf, Pf[s], O[db], 0, 0, 0);
                    }
                asm volatile("s_waitcnt lgkmcnt(0)" ::: "memory");
            }
            lsum += __shfl_xor(lsum, 32);
            const float inv = 1.f / lsum;
#pragma unroll
            for (int db = 0; db < 4; ++db)
#pragma unroll
                for (int a = 0; a < 4; ++a) { u32x2 w; w.x = cvt_pk_bf16(O[db][4 * a] * inv, O[db][4 * a + 1] * inv); w.y = cvt_pk_bf16(O[db][4 * a + 2] * inv, O[db][4 * a + 3] * inv);
                    *(LAS u32x2*)(vl + qq * VSTRIDE + (32 * db + 8 * a + 4 * hh2) * 2) = w; }
            asm volatile("s_waitcnt lgkmcnt(0)" ::: "memory");
            bf16_t* og = OG_ + (size_t)g_ * M * 512 + hh * HD;
#pragma unroll
            for (int i = 0; i < 8; ++i) { const int rowi = i * 4 + (lane >> 4); const u32x4 v = *(const LAS u32x4*)(vl + rowi * VSTRIDE + (lane & 15) * 16);
                *(u32x4*)(og + (rowb + ((size_t)(u0 + rowi) << dsh)) * 512 + (lane & 15) * 8) = v; }
            if (hh2 == 0) LSE_[((size_t)g_ * M + rowb + ((size_t)(u0 + qq) << dsh)) * 4 + hh] = mrun + __builtin_amdgcn_logf(lsum);
            asm volatile("s_waitcnt lgkmcnt(0)" ::: "memory");
        }
    }
    GRID_BAR();
    if (PH(6)) { pg8::Gemm g{P_AB, DM, P_WIN + (size_t)3 * QW * DM, DM, M, 4 * DM, DM, 0}; SO.init(M, 4 * DM, G, bx); pg8::EpiProj<1> E{P_XR, (size_t)(WS_YG - WS_XR) / 2, P_RSQ1}; pg8::gemm_phase(lds, g, SO, E); }
    GRID_BAR();
    if (PH(7)) { PHASE_IDS();
        const float *cw_ = P_cw, *cb_ = P_cb; const bf16_t* XR_ = P_XR; bf16_t* XC_ = P_XC; const float* LSE_ = P_LSE; const bf16_t* OG_ = P_OG; bf16_t* ATT_ = P_ATT;
        for (int it = gw; it < (M / 32) * 2; it += NGW) {
            const int rb = it >> 1, c0 = (it & 1) * 512 + lane * 8, r0 = rb * 32, t0 = r0 % SEQ;
            float w[4][8], bias[8];
#pragma unroll
            for (int j = 0; j < 4; ++j)
#pragma unroll
                for (int i = 0; i < 8; ++i) w[j][i] = cw_[j * DM + c0 + i];
#pragma unroll
            for (int i = 0; i < 8; ++i) bias[i] = cb_[c0 + i];
            float xw[3][8];
#pragma unroll
            for (int j = 0; j < 3; ++j) { const int tt = t0 - 3 + j;
                u32x4 v = (u32x4){0u, 0u, 0u, 0u}; if (tt >= 0) v = *(const u32x4*)(XR_ + (size_t)(r0 - 3 + j) * DM + c0);
                xw[j][0] = bflo(v.x); xw[j][1] = bfhi(v.x); xw[j][2] = bflo(v.y); xw[j][3] = bfhi(v.y); xw[j][4] = bflo(v.z); xw[j][5] = bfhi(v.z); xw[j][6] = bflo(v.w); xw[j][7] = bfhi(v.w); }
#pragma unroll 4
            for (int t = 0; t < 32; ++t) { const u32x4 v = *(const u32x4*)(XR_ + (size_t)(r0 + t) * DM + c0);
                const float x3[8] = {bflo(v.x), bfhi(v.x), bflo(v.y), bfhi(v.y), bflo(v.z), bfhi(v.z), bflo(v.w), bfhi(v.w)}; float o[8];
#pragma unroll
                for (int i = 0; i < 8; ++i) { o[i] = bias[i] + w[0][i] * xw[0][i] + w[1][i] * xw[1][i] + w[2][i] * xw[2][i] + w[3][i] * x3[i]; xw[0][i] = xw[1][i]; xw[1][i] = xw[2][i]; xw[2][i] = x3[i]; }
                u32x4 ov; ov.x = cvt_pk_bf16(o[0], o[1]); ov.y = cvt_pk_bf16(o[2], o[3]); ov.z = cvt_pk_bf16(o[4], o[5]); ov.w = cvt_pk_bf16(o[6], o[7]);
                *(u32x4*)(XC_ + (size_t)(r0 + t) * DM + c0) = ov; }
        }
        for (int row = gw; row < M; row += NGW) {
            const int hh = lane >> 4;
            const float l0 = LSE_[((size_t)0 * M + row) * 4 + hh], l1 = LSE_[((size_t)1 * M + row) * 4 + hh], l2 = LSE_[((size_t)2 * M + row) * 4 + hh];
            const float mx = fmaxf(l0, fmaxf(l1, l2)); const float e0 = __builtin_amdgcn_exp2f(l0 - mx), e1 = __builtin_amdgcn_exp2f(l1 - mx), e2 = __builtin_amdgcn_exp2f(l2 - mx);
            const float inv = 1.f / (e0 + e1 + e2); const float a0 = e0 * inv, a1 = e1 * inv, a2 = e2 * inv;
            const u32x4 v0 = *(const u32x4*)(OG_ + ((size_t)0 * M + row) * 512 + lane * 8), v1 = *(const u32x4*)(OG_ + ((size_t)1 * M + row) * 512 + lane * 8), v2 = *(const u32x4*)(OG_ + ((size_t)2 * M + row) * 512 + lane * 8);
            u32x4 o;
            o.x = cvt_pk_bf16(a0 * bflo(v0.x) + a1 * bflo(v1.x) + a2 * bflo(v2.x), a0 * bfhi(v0.x) + a1 * bfhi(v1.x) + a2 * bfhi(v2.x));
            o.y = cvt_pk_bf16(a0 * bflo(v0.y) + a1 * bflo(v1.y) + a2 * bflo(v2.y), a0 * bfhi(v0.y) + a1 * bfhi(v1.y) + a2 * bfhi(v2.y));
            o.z = cvt_pk_bf16(a0 * bflo(v0.z) + a1 * bflo(v1.z) + a2 * bflo(v2.z), a0 * bfhi(v0.z) + a1 * bfhi(v1.z) + a2 * bfhi(v2.z));
            o.w = cvt_pk_bf16(a0 * bflo(v0.w) + a1 * bflo(v1.w) + a2 * bflo(v2.w), a0 * bfhi(v0.w) + a1 * bfhi(v1.w) + a2 * bfhi(v2.w));
            *(u32x4*)(ATT_ + (size_t)row * 512 + lane * 8) = o;
        }
    }
    GRID_BAR();
    if (PH(8)) { pg8::Gemm g{P_XC, DM, P_WLRU, 256, M, 2 * DM, 256, 1}; SO.init(M, 2 * DM, G, bx); pg8::EpiLru E{P_XC, P_bxp, P_bap, P_app, P_LA, P_BB}; pg8::gemm_phase(lds, g, SO, E); }
    GRID_BAR();
    if (PH(9)) { PHASE_IDS(); const bf16_t *LA_ = P_LA, *BB_ = P_BB; float *CA_ = P_CA, *CH_ = P_CH;
    for (int it = gw; it < BATCH * 128 * 4; it += NGW) {
        const int qd = it & 3, ck = (it >> 2) & 127, b = it >> 9; const int c0 = qd * 256 + lane * 4; const size_t r0 = (size_t)b * SEQ + ck * 64;
        float h[4] = {0.f, 0.f, 0.f, 0.f}, sl[4] = {0.f, 0.f, 0.f, 0.f};
#pragma unroll 8
        for (int t = 0; t < 64; ++t) { const u32x2 lw = *(const u32x2*)(LA_ + (r0 + t) * DM + c0), bw = *(const u32x2*)(BB_ + (r0 + t) * DM + c0);
            const float l[4] = {bflo(lw.x), bfhi(lw.x), bflo(lw.y), bfhi(lw.y)}, bv[4] = {bflo(bw.x), bfhi(bw.x), bflo(bw.y), bfhi(bw.y)};
#pragma unroll
            for (int i = 0; i < 4; ++i) { sl[i] += l[i]; h[i] = __builtin_amdgcn_exp2f(l[i] * LOG2E) * h[i] + bv[i]; } }
        *(f32x4*)(CA_ + ((size_t)(b * 128 + ck)) * DM + c0) = (f32x4){sl[0], sl[1], sl[2], sl[3]};
        *(f32x4*)(CH_ + ((size_t)(b * 128 + ck)) * DM + c0) = (f32x4){h[0], h[1], h[2], h[3]};
    } }
    GRID_BAR();
    if (PH(10)) { PHASE_IDS(); const bf16_t *LA_ = P_LA, *BB_ = P_BB, *YG_ = P_YG; const float *CA_ = P_CA, *CH_ = P_CH; bf16_t* REC_ = P_REC;
    for (int it = gw; it < BATCH * 128 * 4; it += NGW) {
        const int qd = it & 3, ck = (it >> 2) & 127, b = it >> 9; const int c0 = qd * 256 + lane * 4; const size_t r0 = (size_t)b * SEQ + ck * 64;
        float h[4] = {0.f, 0.f, 0.f, 0.f};
        for (int k = 0; k < ck; ++k) { const f32x4 a = *(const f32x4*)(CA_ + ((size_t)(b * 128 + k)) * DM + c0), hv = *(const f32x4*)(CH_ + ((size_t)(b * 128 + k)) * DM + c0);
#pragma unroll
            for (int i = 0; i < 4; ++i) h[i] = __builtin_amdgcn_exp2f(a[i] * LOG2E) * h[i] + hv[i]; }
#pragma unroll 8
        for (int t = 0; t < 64; ++t) { const u32x2 lw = *(const u32x2*)(LA_ + (r0 + t) * DM + c0), bw = *(const u32x2*)(BB_ + (r0 + t) * DM + c0), yw = *(const u32x2*)(YG_ + (r0 + t) * DM + c0);
            const float l[4] = {bflo(lw.x), bfhi(lw.x), bflo(lw.y), bfhi(lw.y)}, bv[4] = {bflo(bw.x), bfhi(bw.x), bflo(bw.y), bfhi(bw.y)}, yv[4] = {bflo(yw.x), bfhi(yw.x), bflo(yw.y), bfhi(yw.y)};
            float o[4];
#pragma unroll
            for (int i = 0; i < 4; ++i) { h[i] = __builtin_amdgcn_exp2f(l[i] * LOG2E) * h[i] + bv[i]; o[i] = h[i] * yv[i]; }
            u32x2 w; w.x = cvt_pk_bf16(o[0], o[1]); w.y = cvt_pk_bf16(o[2], o[3]); *(u32x2*)(REC_ + (r0 + t) * DM + c0) = w; }
    } }
    GRID_BAR();
    if (PH(11)) { pg8::Gemm g{P_ATT, 512, P_WAB, 512, M, DM, 512, 0}; SO.init(M, DM, G, bx); pg8::EpiGate E{0, P_GT, P_MG}; pg8::gemm_phase(lds, g, SO, E); }
    if (PH(11)) { pg8::Gemm g{P_REC, DM, P_WRB, DM, M, DM, DM, 0}; SO.init(M, DM, G, bx); pg8::EpiGate E{1, P_GT, P_MG}; pg8::gemm_phase(lds, g, SO, E); }
    GRID_BAR();
    if (PH(12)) { pg8::Gemm g{P_MG, DM, P_WOUT, DM, M, DM, DM, 0}; SO.init(M, DM, G, bx); pg8::EpiBf16 E{P_Fb, DM}; pg8::gemm_phase(lds, g, SO, E); }
    GRID_BAR();
    if (PH(13)) { PHASE_IDS(); norm_pass(P_Fb, P_AB, P_out, P_mpost, 1.0f, P_out, P_RSQ2, false, gw, NGW, lane); }
    GRID_BAR();
    if (PH(14)) { pg8::Gemm g{P_AB, DM, P_WGU2, DM, M, 2 * FF, DM, 0}; SO.init(M, 2 * FF, G, bx); pg8::EpiSwiGLU E{P_HID, FF, P_RSQ2}; pg8::gemm_phase(lds, g, SO, E); }
    GRID_BAR();
    if (PH(15)) { pg8::Gemm g{P_HID, FF, P_WD2, FF, M, DM, FF, 0}; SO.init(M, DM, G, bx); pg8::EpiBf16 E{P_Fb, DM}; pg8::gemm_phase(lds, g, SO, E); }
    GRID_BAR();
    if (PH(16)) { PHASE_IDS(); norm_pass(P_Fb, P_AB, P_out, P_n2post, 0.5f, P_out, nullptr, true, gw, NGW, lane); }
}

extern "C" void kernel_launch(void* const* d_in, const int* in_sizes, int n_in, void* d_out, int out_size, void* d_ws, size_t ws_size, hipStream_t stream) {
    static int grid = 0;
    if (grid == 0) {
        if (n_in != 25 || out_size != M * DM || ws_size < WS_END) { fprintf(stderr, "kernel_launch: unexpected shapes (n_in %d out %d ws %zu)\n", n_in, out_size, ws_size); grid = -1; return; }
        int dev = 0, cus = 0, per_cu = 0;
        hipGetDevice(&dev); hipDeviceGetAttribute(&cus, hipDeviceAttributeMultiprocessorCount, dev);
        hipFuncSetAttribute((const void*)mk_fwd, hipFuncAttributeMaxDynamicSharedMemorySize, LDS_BYTES);
        hipOccupancyMaxActiveBlocksPerMultiprocessor(&per_cu, (const void*)mk_fwd, NTHREADS, LDS_BYTES);
        if (per_cu < 1) { fprintf(stderr, "kernel_launch: occupancy query says %d blocks per CU\n", per_cu); per_cu = 1; }
        grid = cus;
        fprintf(stderr, "kernel_launch: cus %d per_cu %d grid %d\n", cus, per_cu, grid);
    }
    if (grid < 0) return;
    if (hipMemsetAsync(d_ws, 0, 65536, stream) != hipSuccess) { fprintf(stderr, "kernel_launch: memset failed\n"); return; }
    Args a{};
    for (int i = 0; i < 25; ++i) a.in[i] = (const float*)d_in[i];
    a.out = (float*)d_out; a.ws = (unsigned char*)d_ws;
    void* kargs[] = {&a};
    hipError_t e = hipLaunchCooperativeKernel((const void*)mk_fwd, dim3(grid), dim3(NTHREADS), kargs, LDS_BYTES, stream);
    if (e != hipSuccess) fprintf(stderr, "cooperative launch failed: %s (grid %d)\n", hipGetErrorString(e), grid);
}
```

```cpp
#include <hip/hip_runtime.h>
#include <hip/hip_cooperative_groups.h>
#include <cstdio>
#include <cstdint>
#include <cmath>
namespace cg = cooperative_groups;

#define LAS __attribute__((address_space(3)))
typedef unsigned short bf16_t;
typedef short bf16x8 __attribute__((ext_vector_type(8)));
typedef float f32x4 __attribute__((ext_vector_type(4)));
typedef float f32x16 __attribute__((ext_vector_type(16)));
typedef unsigned u32x4 __attribute__((ext_vector_type(4)));
typedef unsigned u32x2 __attribute__((ext_vector_type(2)));
typedef short s16x4 __attribute__((ext_vector_type(4)));

#ifndef PHMASK
#define PHMASK 0x1FFFF
#endif
#define PH(n) ((PHMASK >> (n)) & 1)
#ifndef DUPMASK
#define DUPMASK 0
#endif
#define DUP(n) ((DUPMASK >> (n)) & 1)
#ifndef NTSTORE
#define NTSTORE 0
#endif
#define EPI_ST16(p, v) do { if (NTSTORE) __builtin_nontemporal_store((v), (u32x4*)(p)); else *(u32x4*)(p) = (v); } while (0)
#ifndef EREP_G1
#define EREP_G1 1
#endif
#ifndef EREP_G3A
#define EREP_G3A 1
#endif
#ifndef KREP_G1
#define KREP_G1 1
#endif

constexpr int BATCH = 4, SEQ = 8192, DM = 1024, M = BATCH * SEQ, FF = 2816, NH = 12, HD = 128, QW = 1536, WINC = 8704;
constexpr float EPS = 1e-6f;
constexpr float LOG2E = 1.4426950408889634f;
constexpr float C2 = 0.08838834764831845f * 1.4426950408889634f;
constexpr int NWAVES = 8, NTHREADS = 512;

constexpr size_t MiB = 1u << 20;
constexpr size_t WS_RSQ0 = 64 * 1024, WS_RSQ1 = WS_RSQ0 + 128 * 1024, WS_RSQ2 = WS_RSQ1 + 128 * 1024;
constexpr size_t WS_WGU1 = 1 * MiB, WS_WD1 = 12 * MiB, WS_WIN = 18 * MiB, WS_WLRU = 35 * MiB, WS_WAB = 36 * MiB, WS_WRB = 37 * MiB, WS_WOUT = 39 * MiB, WS_WGU2 = 41 * MiB, WS_WD2 = 52 * MiB;
constexpr size_t WS_LSE = 58 * MiB;
constexpr size_t WS_AB = 60 * MiB;
constexpr size_t WS_Q = 124 * MiB, WS_K = 220 * MiB, WS_V = 316 * MiB;
constexpr size_t WS_OG = 412 * MiB;
constexpr size_t WS_HID = 124 * MiB;
constexpr size_t WS_F = 300 * MiB;
constexpr size_t WS_XR = 124 * MiB, WS_YG = 188 * MiB, WS_GT = 252 * MiB, WS_ATT = 380 * MiB, WS_XC = 60 * MiB;
constexpr size_t WS_LA = 124 * MiB, WS_BB = 412 * MiB, WS_CA = 476 * MiB, WS_CH = 478 * MiB;
constexpr size_t WS_REC = 60 * MiB, WS_MG = 124 * MiB;
constexpr size_t WS_END = 508 * MiB;
static_assert(WS_V - WS_K == WS_K - WS_Q && WS_GT - WS_YG == WS_YG - WS_XR, "section strides");

__device__ __forceinline__ float bf2f(unsigned short h) { return __uint_as_float((unsigned)h << 16); }
__device__ __forceinline__ float bflo(unsigned w) { return __uint_as_float(w << 16); }
__device__ __forceinline__ float bfhi(unsigned w) { return __uint_as_float(w & 0xffff0000u); }
__device__ __forceinline__ unsigned cvt_pk_bf16(float lo, float hi) { unsigned r; asm volatile("v_cvt_pk_bf16_f32 %0, %1, %2" : "=v"(r) : "v"(lo), "v"(hi)); return r; }
__device__ __forceinline__ float wave_sum(float v) {
#pragma unroll
    for (int o = 1; o < 64; o <<= 1) v += __shfl_xor(v, o);
    return v;
}
__device__ __forceinline__ float fast_sigmoid(float x) { return __builtin_amdgcn_rcpf(1.f + __builtin_amdgcn_exp2f(-x * LOG2E)); }
__device__ __forceinline__ float gelu_tanh(float x) {
    const float u = 0.7978845608028654f * (x + 0.044715f * x * x * x);
    return x * fast_sigmoid(2.f * u);
}

namespace pg8 {
constexpr int BM = 256, BK = 64, HALF = 128, HTB = HALF * BK * 2, STAGE_BYTES = 8 * HTB, NXCD = 8, WGM = 8;
__host__ __device__ __forceinline__ int lds_byte(int r, int c) { const int st = (r >> 4) * 2 + (c >> 5), rr = r & 15, cc = c & 31, ob = rr * 64 + cc * 2; return st * 1024 + (ob ^ (((ob >> 9) & 1) << 5)); }
__host__ __device__ __forceinline__ void stage_rc(int b, int& R, int& C) { const int st = b / 1024, sb = b % 1024, swz = sb ^ (((sb >> 9) & 1) << 5); R = (st >> 1) * 16 + swz / 64; C = (st & 1) * 32 + (swz % 64) / 2; }
__host__ __device__ __forceinline__ int perm32(int rho) { const int n = rho >> 4, i = rho & 15; return 8 * (i >> 2) + 4 * n + (i & 3); }

struct Unit { int pm, pn; };
struct Gemm { const bf16_t* A; int lda; const bf16_t* Bt; int ldb; int M, N, K; int amode; int krep = 1; int erep = 1; };

struct StaticOrder {
    int nM, nN, nwg, G, c;
    __device__ void init(int M_, int N_, int G_, int c_) { nM = M_ / BM; nN = N_ / BM; nwg = nM * nN; G = G_; c = c_; }
    __device__ bool next(int i, Unit& u) const {
        const long L = (long)i * G + c; if (L >= nwg) return false;
        int wgid = (int)L; { const int q = nwg / NXCD, r = nwg % NXCD, xcd = wgid % NXCD, off = wgid / NXCD; wgid = (xcd < r ? xcd * (q + 1) : r * (q + 1) + (xcd - r) * q) + off; }
        const int nig = WGM * nN, gid = wgid / nig, fm = gid * WGM, gsz = (nM - fm) < WGM ? (nM - fm) : WGM;
        u.pm = fm + ((wgid % nig) % gsz); u.pn = (wgid % nig) / gsz; return true;
    }
};

template <class Epi>
__device__ __forceinline__ void gemm_phase(LAS unsigned char* lds, const Gemm g, const StaticOrder& S, const Epi& E) {
    int tid = threadIdx.x; asm volatile("" : "+v"(tid));
    const int wid = __builtin_amdgcn_readfirstlane(tid >> 6), lane = tid & 63, wr = wid >> 2, wc = wid & 3, fr = lane & 15, fq = lane >> 4;
    const int K = g.K, nt = K / BK;
    unsigned voffA[2], voffB[2];
#pragma unroll
    for (int i = 0; i < 2; ++i) { int R, C; stage_rc(tid * 16 + i * 8192, R, C); const int Rb = (R & ~31) + perm32(R & 31);
        voffA[i] = (unsigned)(R * g.lda + C) * 2u; voffB[i] = (unsigned)(Rb * g.ldb + C) * 2u; }
    const size_t kstep = (size_t)(BK * 2);
    const size_t hstepA = (size_t)HALF * g.lda * 2, hstepB = (size_t)HALF * g.ldb * 2;
    const unsigned ldsw = (unsigned)wid * 1024u;
    const int aoff = lds_byte(wr * 64 + fr, fq * 8), boff = lds_byte(wc * 32 + fr, fq * 8);
#define PG8_SA(b, h) (((b) * 2 + (h)) * HTB)
#define PG8_SB(b, h) ((4 + (b) * 2 + (h)) * HTB)
#define PG8_STAGE(bufoff, gbase, voff) do { _Pragma("unroll") for (int _i = 0; _i < 2; ++_i) \
        __builtin_amdgcn_global_load_lds((const unsigned*)((const char*)(gbase) + (voff)[_i]), (LAS unsigned*)(lds + (bufoff) + ldsw + _i * 8192), 16, 0, 0); } while (0)
#define PG8_LDA(dst, b, h) do { _Pragma("unroll") for (int m = 0; m < 4; ++m) _Pragma("unroll") for (int k = 0; k < 2; ++k) dst[m][k] = *(const LAS bf16x8*)(lds + PG8_SA(b, h) + aoff + m * 2048 + k * 1024); } while (0)
#define PG8_LDB(dst, b, h) do { _Pragma("unroll") for (int n = 0; n < 2; ++n) _Pragma("unroll") for (int k = 0; k < 2; ++k) dst[n][k] = *(const LAS bf16x8*)(lds + PG8_SB(b, h) + boff + n * 2048 + k * 1024); } while (0)
#define PG8_MMA(ai, bj, At, Bt) do { __builtin_amdgcn_s_setprio(1); _Pragma("unroll") for (int m = 0; m < 4; ++m) _Pragma("unroll") for (int n = 0; n < 2; ++n) _Pragma("unroll") for (int k = 0; k < 2; ++k) \
        acc[ai][bj][m][n] = __builtin_amdgcn_mfma_f32_16x16x32_bf16(Bt[n][k], At[m][k], acc[ai][bj][m][n], 0, 0, 0); __builtin_amdgcn_s_setprio(0); } while (0)
#define PG8_WAIT_V(n) asm volatile("s_waitcnt vmcnt(" #n ")" ::: "memory")
#define PG8_WAIT_L(n) asm volatile("s_waitcnt lgkmcnt(" #n ")" ::: "memory")
#define PG8_BAR __builtin_amdgcn_s_barrier()
#define PG8_SCHED __builtin_amdgcn_sched_barrier(0)
#define PG8_APTR(u) ((const char*)g.A + (size_t)(u).pm * 2 * hstepA + (g.amode == 1 ? (size_t)(((u).pn >> 1) * 256 * 2) : (size_t)0))
#define PG8_BPTR(u) ((const char*)g.Bt + (size_t)(u).pn * 2 * hstepB)
    Unit cur, nxt; int ui = 0;
    if (!S.next(0, cur)) return;
    f32x4 acc[2][2][4][2];
#pragma unroll
    for (int a = 0; a < 2; ++a)
#pragma unroll
        for (int b = 0; b < 2; ++b)
#pragma unroll
            for (int m = 0; m < 4; ++m)
#pragma unroll
                for (int n = 0; n < 2; ++n) acc[a][b][m][n] = (f32x4){0.f, 0.f, 0.f, 0.f};
    bf16x8 At[4][2], B0[2][2], B1[2][2];
    const char* cA = PG8_APTR(cur); const char* cB = PG8_BPTR(cur);
    PG8_STAGE(PG8_SB(0, 0), cB, voffB); PG8_STAGE(PG8_SB(0, 1), cB + hstepB, voffB); PG8_STAGE(PG8_SA(0, 0), cA, voffA); PG8_STAGE(PG8_SA(0, 1), cA + hstepA, voffA);
    if (wr == 1) PG8_BAR;
    PG8_WAIT_V(2); PG8_BAR;
    PG8_STAGE(PG8_SB(1, 0), cB + kstep, voffB); PG8_STAGE(PG8_SA(1, 0), cA + kstep, voffA); PG8_STAGE(PG8_SB(1, 1), cB + hstepB + kstep, voffB);
    PG8_WAIT_V(6); PG8_BAR;
    for (;;) {
        const bool has_next = S.next(ui + 1, nxt);
        const char* nA0 = has_next ? PG8_APTR(nxt) : cA; const char* nB0 = has_next ? PG8_BPTR(nxt) : cB;
        for (int kr = 0; kr < g.krep; ++kr) {
        const char* nA = (kr == g.krep - 1) ? nA0 : cA; const char* nB = (kr == g.krep - 1) ? nB0 : cB;
        for (int t = 0; t < nt; t += 2) {
            const bool last = (t == nt - 2);
            const char* a1 = cA + (size_t)(t + 1) * kstep;
            const char* a2 = last ? nA : cA + (size_t)(t + 2) * kstep; const char* b2 = last ? nB : cB + (size_t)(t + 2) * kstep;
            const char* a3 = a2 + kstep; const char* b3 = b2 + kstep;
            PG8_LDB(B0, 0, 0); PG8_LDB(B1, 0, 1); PG8_SCHED; PG8_LDA(At, 0, 0); PG8_STAGE(PG8_SA(1, 1), a1 + hstepA, voffA);
            PG8_WAIT_V(8); PG8_WAIT_L(0); PG8_BAR; PG8_MMA(0, 0, At, B0); PG8_MMA(0, 1, At, B1); PG8_BAR; PG8_SCHED;
            PG8_LDA(At, 0, 1); PG8_STAGE(PG8_SB(0, 0), b2, voffB); PG8_STAGE(PG8_SB(0, 1), b2 + hstepB, voffB); PG8_STAGE(PG8_SA(0, 0), a2, voffA);
            PG8_WAIT_V(8); PG8_WAIT_L(0); PG8_BAR; PG8_MMA(1, 0, At, B0); PG8_MMA(1, 1, At, B1); PG8_BAR; PG8_SCHED;
            PG8_LDB(B0, 1, 0); PG8_LDB(B1, 1, 1); PG8_SCHED; PG8_LDA(At, 1, 0); PG8_STAGE(PG8_SA(0, 1), a2 + hstepA, voffA);
            PG8_WAIT_V(8); PG8_WAIT_L(0); PG8_BAR; PG8_MMA(0, 0, At, B0); PG8_MMA(0, 1, At, B1); PG8_BAR; PG8_SCHED;
            PG8_LDA(At, 1, 1); PG8_STAGE(PG8_SB(1, 0), b3, voffB); PG8_STAGE(PG8_SB(1, 1), b3 + hstepB, voffB); PG8_STAGE(PG8_SA(1, 0), a3, voffA);
            PG8_WAIT_V(8); PG8_WAIT_L(0); PG8_BAR; PG8_MMA(1, 0, At, B0); PG8_MMA(1, 1, At, B1); PG8_BAR; PG8_SCHED;
        }
        }
        if (g.krep == 2) {
#pragma unroll
            for (int a = 0; a < 2; ++a)
#pragma unroll
                for (int b = 0; b < 2; ++b)
#pragma unroll
                    for (int m = 0; m < 4; ++m)
#pragma unroll
                        for (int n = 0; n < 2; ++n) acc[a][b][m][n] *= 0.5f;
        }
        const char* nA = nA0; const char* nB = nB0;
        if (wr == 0) PG8_BAR;
        for (int er = 0; er < g.erep; ++er) { E(acc, cur, wr, wc, fr, fq); asm volatile("" ::: "memory"); }
        if (!has_next) break;
#pragma unroll
        for (int a = 0; a < 2; ++a)
#pragma unroll
            for (int b = 0; b < 2; ++b)
#pragma unroll
                for (int m = 0; m < 4; ++m)
#pragma unroll
                    for (int n = 0; n < 2; ++n) acc[a][b][m][n] = (f32x4){0.f, 0.f, 0.f, 0.f};
        cur = nxt; cA = nA; cB = nB; ++ui;
        if (wr == 1) PG8_BAR;
    }
    PG8_WAIT_V(0);
    PG8_BAR;
#undef PG8_SA
#undef PG8_SB
#undef PG8_STAGE
#undef PG8_LDA
#undef PG8_LDB
#undef PG8_MMA
#undef PG8_WAIT_V
#undef PG8_WAIT_L
#undef PG8_BAR
#undef PG8_SCHED
#undef PG8_APTR
#undef PG8_BPTR
}

__device__ __forceinline__ float rowscale(const float* rsq, int row) { return rsqrtf(rsq[row] * (1.f / DM) + EPS); }

struct EpiSwiGLU {
    bf16_t* O; int ldc; const float* rsq;
    __device__ __forceinline__ void operator()(const f32x4 (&acc)[2][2][4][2], const Unit& u, int wr, int wc, int fr, int fq) const {
        const int row0 = u.pm * BM + wr * 64 + fr, col0 = u.pn * HALF + wc * 32 + 8 * fq;
#pragma unroll
        for (int ai = 0; ai < 2; ++ai)
#pragma unroll
            for (int m = 0; m < 4; ++m) { const int row = row0 + ai * HALF + m * 16; const float s = rowscale(rsq, row);
                float o[8];
#pragma unroll
                for (int n = 0; n < 2; ++n)
#pragma unroll
                    for (int i = 0; i < 4; ++i) { const float gt = acc[ai][0][m][n][i] * s, up = acc[ai][1][m][n][i] * s; o[n * 4 + i] = gt * fast_sigmoid(gt) * up; }
                u32x4 w; w.x = cvt_pk_bf16(o[0], o[1]); w.y = cvt_pk_bf16(o[2], o[3]); w.z = cvt_pk_bf16(o[4], o[5]); w.w = cvt_pk_bf16(o[6], o[7]);
                *(u32x4*)(O + (size_t)row * ldc + col0) = w; }
    }
};
struct EpiBf16 {
    bf16_t* O; int ldc;
    __device__ __forceinline__ void operator()(const f32x4 (&acc)[2][2][4][2], const Unit& u, int wr, int wc, int fr, int fq) const {
        const int row0 = u.pm * BM + wr * 64 + fr, col0 = u.pn * BM + wc * 32 + 8 * fq;
#pragma unroll
        for (int ai = 0; ai < 2; ++ai)
#pragma unroll
            for (int m = 0; m < 4; ++m) { bf16_t* rowp = O + (size_t)(row0 + ai * HALF + m * 16) * ldc + col0;
#pragma unroll
                for (int bj = 0; bj < 2; ++bj) { const f32x4 v0 = acc[ai][bj][m][0], v1 = acc[ai][bj][m][1];
                    u32x4 w; w.x = cvt_pk_bf16(v0[0], v0[1]); w.y = cvt_pk_bf16(v0[2], v0[3]); w.z = cvt_pk_bf16(v1[0], v1[1]); w.w = cvt_pk_bf16(v1[2], v1[3]);
                    EPI_ST16(rowp + bj * HALF, w); } }
    }
};
template <int MODE> struct EpiProj {
    bf16_t* o0; size_t sec_stride; const float* rsq;
    __device__ __forceinline__ void operator()(const f32x4 (&acc)[2][2][4][2], const Unit& u, int wr, int wc, int fr, int fq) const {
        const int row0 = u.pm * BM + wr * 64 + fr;
        int sec, ldc, colt; float sc = 1.f;
        if (MODE == 0) { sec = u.pn / 6; ldc = QW; colt = (u.pn % 6) * BM; if (sec == 0) sc = C2; }
        else { sec = u.pn < 8 ? (u.pn >> 2) : 2; ldc = u.pn < 8 ? DM : 2 * DM; colt = u.pn < 8 ? (u.pn & 3) * BM : (u.pn - 8) * BM; }
        bf16_t* base = o0 + (size_t)sec * sec_stride;
        const int col0 = colt + wc * 32 + 8 * fq;
#pragma unroll
        for (int ai = 0; ai < 2; ++ai)
#pragma unroll
            for (int m = 0; m < 4; ++m) { const int row = row0 + ai * HALF + m * 16; const float s = rowscale(rsq, row) * sc; bf16_t* rowp = base + (size_t)row * ldc + col0;
#pragma unroll
                for (int bj = 0; bj < 2; ++bj) { f32x4 v0 = acc[ai][bj][m][0] * s, v1 = acc[ai][bj][m][1] * s;
                    if (MODE == 1) {
                        if (sec == 1) {
#pragma unroll
                            for (int i = 0; i < 4; ++i) { v0[i] = gelu_tanh(v0[i]); v1[i] = gelu_tanh(v1[i]); }
                        } else if (sec == 2) {
#pragma unroll
                            for (int i = 0; i < 4; ++i) { v0[i] = fast_sigmoid(v0[i]); v1[i] = fast_sigmoid(v1[i]); }
                        }
                    }
                    u32x4 w; w.x = cvt_pk_bf16(v0[0], v0[1]); w.y = cvt_pk_bf16(v0[2], v0[3]); w.z = cvt_pk_bf16(v1[0], v1[1]); w.w = cvt_pk_bf16(v1[2], v1[3]);
                    EPI_ST16(rowp + bj * HALF, w); } }
    }
};
struct EpiLru {
    const bf16_t* XC; const float *bx, *ba, *ap; bf16_t *LA, *BB;
    __device__ __forceinline__ void operator()(const f32x4 (&acc)[2][2][4][2], const Unit& u, int wr, int wc, int fr, int fq) const {
        const int row0 = u.pm * BM + wr * 64 + fr, c0 = (u.pn >> 1) * 256 + (u.pn & 1) * 128 + wc * 32 + 8 * fq;
        float vbx[8], vba[8], vsp[8];
#pragma unroll
        for (int j = 0; j < 8; ++j) { vbx[j] = bx[c0 + j]; vba[j] = ba[c0 + j]; const float nap = -ap[c0 + j]; vsp[j] = -8.f * ((nap > 20.f) ? nap : log1pf(expf(nap))); }
#pragma unroll
        for (int ai = 0; ai < 2; ++ai)
#pragma unroll
            for (int m = 0; m < 4; ++m) { const int row = row0 + ai * HALF + m * 16; const size_t off = (size_t)row * DM + c0;
                const u32x4 xw = *(const u32x4*)(XC + off); float xv[8] = {bflo(xw.x), bfhi(xw.x), bflo(xw.y), bfhi(xw.y), bflo(xw.z), bfhi(xw.z), bflo(xw.w), bfhi(xw.w)};
                float la[8], bb[8];
#pragma unroll
                for (int n = 0; n < 2; ++n)
#pragma unroll
                    for (int i = 0; i < 4; ++i) { const int j = n * 4 + i; const float gx = fast_sigmoid(acc[ai][0][m][n][i] + vbx[j]), ga = fast_sigmoid(acc[ai][1][m][n][i] + vba[j]);
                        const float l = ga * vsp[j]; la[j] = l; const float x2 = 2.f * l;
                        const float om = (x2 > -0.25f) ? -x2 * (1.f + x2 * (0.5f + x2 * (0.16666667f + x2 * (0.041666668f + x2 * (0.0083333333f + x2 * 0.0013888889f))))) : 1.f - __expf(x2);
                        bb[j] = sqrtf(om) * gx * xv[j]; }
                u32x4 w; w.x = cvt_pk_bf16(la[0], la[1]); w.y = cvt_pk_bf16(la[2], la[3]); w.z = cvt_pk_bf16(la[4], la[5]); w.w = cvt_pk_bf16(la[6], la[7]); *(u32x4*)(LA + off) = w;
                u32x4 v; v.x = cvt_pk_bf16(bb[0], bb[1]); v.y = cvt_pk_bf16(bb[2], bb[3]); v.z = cvt_pk_bf16(bb[4], bb[5]); v.w = cvt_pk_bf16(bb[6], bb[7]); *(u32x4*)(BB + off) = v; }
    }
};
struct EpiGate {
    int mode; const bf16_t* GT; bf16_t* MG;
    __device__ __forceinline__ void operator()(const f32x4 (&acc)[2][2][4][2], const Unit& u, int wr, int wc, int fr, int fq) const {
        const int row0 = u.pm * BM + wr * 64 + fr, col0 = u.pn * BM + wc * 32 + 8 * fq;
#pragma unroll
        for (int ai = 0; ai < 2; ++ai)
#pragma unroll
            for (int m = 0; m < 4; ++m) { const int row = row0 + ai * HALF + m * 16;
#pragma unroll
                for (int bj = 0; bj < 2; ++bj) { const int col = col0 + bj * HALF;
                    const u32x4 gw = *(const u32x4*)(GT + (size_t)row * (2 * DM) + mode * DM + col);
                    const float gv[8] = {bflo(gw.x), bfhi(gw.x), bflo(gw.y), bfhi(gw.y), bflo(gw.z), bfhi(gw.z), bflo(gw.w), bfhi(gw.w)};
                    float o[8];
#pragma unroll
                    for (int n = 0; n < 2; ++n)
#pragma unroll
                        for (int i = 0; i < 4; ++i) o[n * 4 + i] = acc[ai][bj][m][n][i] * gv[n * 4 + i];
                    bf16_t* p = MG + (size_t)row * DM + col;
                    if (mode == 1) { const u32x4 pw = *(const u32x4*)p; o[0] += bflo(pw.x); o[1] += bfhi(pw.x); o[2] += bflo(pw.y); o[3] += bfhi(pw.y); o[4] += bflo(pw.z); o[5] += bfhi(pw.z); o[6] += bflo(pw.w); o[7] += bfhi(pw.w); }
                    u32x4 w; w.x = cvt_pk_bf16(o[0], o[1]); w.y = cvt_pk_bf16(o[2], o[3]); w.z = cvt_pk_bf16(o[4], o[5]); w.w = cvt_pk_bf16(o[6], o[7]);
                    *(u32x4*)p = w; } }
    }
};
}

struct Args {
    const float* in[25];
    float* out;
    unsigned char* ws;
};

__device__ __forceinline__ void p0_item(const float* W, int ldw, int k0, int n0, const float* gain, bf16_t* WT, int ldt, int drow0, LAS float* scr, int lane) {
#pragma unroll 8
    for (int i = 0; i < 32; ++i) { const int kk = 2 * i + (lane >> 5); float v = W[(size_t)(k0 + kk) * ldw + n0 + (lane & 31)]; if (gain) v *= gain[k0 + kk]; scr[kk * 33 + (lane & 31)] = v; }
    asm volatile("s_waitcnt lgkmcnt(0)" ::: "memory");
    const int c = lane & 7;
#pragma unroll
    for (int j = 0; j < 4; ++j) { const int n = (lane >> 3) + 8 * j; const LAS float* s = scr + (8 * c) * 33 + n;
        u32x4 o; o.x = cvt_pk_bf16(s[0 * 33], s[1 * 33]); o.y = cvt_pk_bf16(s[2 * 33], s[3 * 33]); o.z = cvt_pk_bf16(s[4 * 33], s[5 * 33]); o.w = cvt_pk_bf16(s[6 * 33], s[7 * 33]);
        *(u32x4*)(WT + (size_t)(drow0 + n) * ldt + k0 + 8 * c) = o; }
    asm volatile("s_waitcnt lgkmcnt(0)" ::: "memory");
}
template <int MAP>
__device__ __forceinline__ bool p0_job(int& r, const float* W, int ldw, int Ksrc, int Nsrc, const float* gain, bf16_t* WT, int ldt, int rowbase, LAS float* scr, int lane) {
    const int nblk = Nsrc / 32, items = (Ksrc / 64) * nblk;
    if (r >= items) { r -= items; return false; }
    const int kb = r / nblk, nb = r % nblk, n0 = nb * 32;
    int drow0 = rowbase + n0;
    if (MAP == 1 || MAP == 3) drow0 = rowbase + (n0 / 128) * 256 + (n0 % 128);
    if (MAP == 2) drow0 = rowbase + (n0 / 128) * 256 + 128 + (n0 % 128);
    p0_item(W, ldw, kb * 64, n0, gain, WT, ldt, drow0, scr, lane);
    return true;
}

__device__ __forceinline__ int t5_bucket(int dist) {
    if (dist < 16) return dist;
    const double v = log((double)dist / 16.0) / log(128.0) * 16.0;
    const int b = 16 + (int)v; return b < 31 ? b : 31;
}

template <bool RES_F32, bool OUT_F32>
__device__ __forceinline__ void norm_pass(const bf16_t* Fb, bf16_t* AB, const float* resf, const float* gpost, float coef, float* outf, float* rsq_out, int gw, int NGW, int lane) {
    for (int row = gw; row < M; row += NGW) {
        const bf16_t* fr_ = Fb + (size_t)row * DM; float fv[2][8]; float rv[2][8]; float s = 0.f;
#pragma unroll
        for (int j = 0; j < 2; ++j) { const int c = 8 * lane + 512 * j; const u32x4 w = *(const u32x4*)(fr_ + c);
            fv[j][0] = bflo(w.x); fv[j][1] = bfhi(w.x); fv[j][2] = bflo(w.y); fv[j][3] = bfhi(w.y); fv[j][4] = bflo(w.z); fv[j][5] = bfhi(w.z); fv[j][6] = bflo(w.w); fv[j][7] = bfhi(w.w);
            if (RES_F32) { const f32x4 r0 = *(const f32x4*)(resf + (size_t)row * DM + c), r1 = *(const f32x4*)(resf + (size_t)row * DM + c + 4);
#pragma unroll
                for (int i = 0; i < 4; ++i) { rv[j][i] = r0[i]; rv[j][4 + i] = r1[i]; } }
            else { const u32x4 r = *(const u32x4*)(AB + (size_t)row * DM + c);
                rv[j][0] = bflo(r.x); rv[j][1] = bfhi(r.x); rv[j][2] = bflo(r.y); rv[j][3] = bfhi(r.y); rv[j][4] = bflo(r.z); rv[j][5] = bfhi(r.z); rv[j][6] = bflo(r.w); rv[j][7] = bfhi(r.w); }
#pragma unroll
            for (int i = 0; i < 8; ++i) s += fv[j][i] * fv[j][i]; }
        s = wave_sum(s);
        const float rs = rsqrtf(s * (1.f / DM) + EPS) * coef; float s2 = 0.f;
#pragma unroll
        for (int j = 0; j < 2; ++j) { const int c = 8 * lane + 512 * j;
            const f32x4 g0 = *(const f32x4*)(gpost + c), g1 = *(const f32x4*)(gpost + c + 4);
            f32x4 o0, o1;
#pragma unroll
            for (int i = 0; i < 4; ++i) { o0[i] = rv[j][i] + fv[j][i] * rs * g0[i]; o1[i] = rv[j][4 + i] + fv[j][4 + i] * rs * g1[i]; s2 += o0[i] * o0[i] + o1[i] * o1[i]; }
            if (OUT_F32) { *(f32x4*)(outf + (size_t)row * DM + c) = o0; *(f32x4*)(outf + (size_t)row * DM + c + 4) = o1; }
            else { u32x4 w; w.x = cvt_pk_bf16(o0[0], o0[1]); w.y = cvt_pk_bf16(o0[2], o0[3]); w.z = cvt_pk_bf16(o1[0], o1[1]); w.w = cvt_pk_bf16(o1[2], o1[3]); *(u32x4*)(AB + (size_t)row * DM + c) = w; } }
        if (!OUT_F32) { s2 = wave_sum(s2); if (lane == 0) rsq_out[row] = s2; }
    }
}

#define XB_TMO      128
#define XB_XCNT(j)  (256  + 64 * (j))
#define XB_XSUB(j)  (1280 + 64 * (j))
#define XB_XGEN(j)  (2304 + 64 * (j))
#define XB_TOP      3328
#define XB_TOPGEN   3392
#define XCD_BAR_WORDS 3456
#define XB_SPIN_CAP (1u << 18)

__device__ __forceinline__ unsigned xb_ld(unsigned* p)              { return __hip_atomic_load(p, __ATOMIC_RELAXED, __HIP_MEMORY_SCOPE_AGENT); }
__device__ __forceinline__ unsigned xb_add(unsigned* p, unsigned v) { return __hip_atomic_fetch_add(p, v, __ATOMIC_RELAXED, __HIP_MEMORY_SCOPE_AGENT); }
__device__ __forceinline__ unsigned xb_xcc_id() { return (unsigned)__builtin_amdgcn_s_getreg((3 << 11) | 20) & 0xFu; }
#define XB_SPIN(cond, bar) do { unsigned _sp = 0; while (cond) { __builtin_amdgcn_s_sleep(1); \
    if ((++_sp & 255u) == 0u) { if (xb_ld(&(bar)[XB_TMO])) break; if (_sp > XB_SPIN_CAP) { atomicAdd(&(bar)[XB_TMO], 1u); break; } } } } while (0)

struct XcdBarrier {
    unsigned* bar; unsigned x;
    volatile LAS unsigned* st;
};

__device__ __forceinline__ XcdBarrier xcd_barrier_post(unsigned* bar, volatile LAS unsigned* st) {
    XcdBarrier b; b.bar = bar; b.x = xb_xcc_id(); b.st = st;
    if (threadIdx.x == 0) (void)xb_add(&bar[XB_XCNT(b.x)], 1u);
    return b;
}
__device__ __forceinline__ void xcd_barrier_complete(unsigned* bar, unsigned x, unsigned& nloc, unsigned& nx) {
    const unsigned G = gridDim.x * gridDim.y * gridDim.z;
    unsigned sum, cnt, mine, sp = 0u;
    for (;;) {
        sum = 0u; cnt = 0u; mine = 0u;
#pragma unroll
        for (unsigned j = 0; j < 16; ++j) { const unsigned c = xb_ld(&bar[XB_XCNT(j)]); sum += c; cnt += (c > 0u) ? 1u : 0u; mine = (j == x) ? c : mine; }
        if (sum == G) break;
        __builtin_amdgcn_s_sleep(1);
        if ((++sp & 255u) == 0u) { if (xb_ld(&bar[XB_TMO])) break; if (sp > XB_SPIN_CAP) { atomicAdd(&bar[XB_TMO], 1u); break; } }
    }
    nloc = mine > 0u ? mine : 1u; nx = cnt > 0u ? cnt : 1u;
}

__device__ __forceinline__ void xcd_barrier(const XcdBarrier& b) {
    asm volatile("s_waitcnt vmcnt(0)" ::: "memory");
    __syncthreads();
    if (threadIdx.x == 0) {
        unsigned* bar = b.bar;
        __builtin_amdgcn_s_waitcnt(0);
        unsigned nloc = b.st[0], nx = b.st[1];
        if (nloc == 0u) { xcd_barrier_complete(bar, b.x, nloc, nx); b.st[0] = nloc; b.st[1] = nx; }
        const unsigned old = xb_add(&bar[XB_XSUB(b.x)], 1u);
        const unsigned gen = old / nloc;
        if (old + 1u == (gen + 1u) * nloc) {
            __builtin_amdgcn_fence(__ATOMIC_RELEASE, "agent");
            asm volatile("s_waitcnt vmcnt(0)" ::: "memory");
            const unsigned og = xb_add(&bar[XB_TOP], 1u);
            const unsigned tg = og / nx;
            if (og + 1u == (tg + 1u) * nx) xb_add(&bar[XB_TOPGEN], 1u);
            else XB_SPIN(xb_ld(&bar[XB_TOPGEN]) == tg, bar);
            __builtin_amdgcn_fence(__ATOMIC_ACQUIRE, "agent");
            xb_add(&bar[XB_XGEN(b.x)], 1u);
            asm volatile("s_waitcnt vmcnt(0)" ::: "memory");
        } else {
            XB_SPIN(xb_ld(&bar[XB_XGEN(b.x)]) == gen, bar);
            __builtin_amdgcn_fence(__ATOMIC_ACQUIRE, "agent");
            asm volatile("s_waitcnt vmcnt(0)" ::: "memory");
        }
    }
    __syncthreads();
}


constexpr int LDS_BYTES = 144 * 1024;
constexpr int BAR_LDS_OFF = 128 * 1024 + 256;
constexpr int VSTRIDE = 320;
constexpr int ATT_V_BYTES = 32 * VSTRIDE;
constexpr int ATT_BIAS_OFF = NWAVES * ATT_V_BYTES;

#define P_x INP(0)
#define P_n1pre INP(1)
#define P_n1post INP(2)
#define P_w1g INP(3)
#define P_w1u INP(4)
#define P_w1d INP(5)
#define P_mpre INP(6)
#define P_mpost INP(7)
#define P_win INP(8)
#define P_btab INP(9)
#define P_cw INP(10)
#define P_cb INP(11)
#define P_wx INP(12)
#define P_bxp INP(13)
#define P_wa INP(14)
#define P_bap INP(15)
#define P_app INP(16)
#define P_wab INP(17)
#define P_wrb INP(18)
#define P_wout INP(19)
#define P_n2pre INP(20)
#define P_n2post INP(21)
#define P_w2g INP(22)
#define P_w2u INP(23)
#define P_w2d INP(24)
#define P_RSQ0 WSP(float, WS_RSQ0)
#define P_RSQ1 WSP(float, WS_RSQ1)
#define P_RSQ2 WSP(float, WS_RSQ2)
#define P_WGU1 WSP(bf16_t, WS_WGU1)
#define P_WD1 WSP(bf16_t, WS_WD1)
#define P_WIN WSP(bf16_t, WS_WIN)
#define P_WLRU WSP(bf16_t, WS_WLRU)
#define P_WAB WSP(bf16_t, WS_WAB)
#define P_WRB WSP(bf16_t, WS_WRB)
#define P_WOUT WSP(bf16_t, WS_WOUT)
#define P_WGU2 WSP(bf16_t, WS_WGU2)
#define P_WD2 WSP(bf16_t, WS_WD2)
#define P_AB WSP(bf16_t, WS_AB)
#define P_Qb WSP(bf16_t, WS_Q)
#define P_Kb WSP(bf16_t, WS_K)
#define P_Vb WSP(bf16_t, WS_V)
#define P_OG WSP(bf16_t, WS_OG)
#define P_HID WSP(bf16_t, WS_HID)
#define P_Fb WSP(bf16_t, WS_F)
#define P_XR WSP(bf16_t, WS_XR)
#define P_YG WSP(bf16_t, WS_YG)
#define P_GT WSP(bf16_t, WS_GT)
#define P_ATT WSP(bf16_t, WS_ATT)
#define P_XC ((bf16_t*)(KARGS()->out))
#define P_LA WSP(bf16_t, WS_LA)
#define P_BB WSP(bf16_t, WS_BB)
#define P_REC ((bf16_t*)((unsigned char*)(KARGS()->out) + 64 * MiB))
#define P_MG WSP(bf16_t, WS_MG)
#define P_LSE WSP(float, WS_LSE)
#define P_CA WSP(float, WS_CA)
#define P_CH WSP(float, WS_CH)
#define P_out (KARGS()->out)
__global__ void __launch_bounds__(NTHREADS, 2) mk_fwd(Args args) {
    extern __shared__ __attribute__((aligned(16))) unsigned char lds_raw[];
    LAS unsigned char* lds = (LAS unsigned char*)lds_raw;
    cg::grid_group grid = cg::this_grid();
#define KARGS_EARLY() ({ const Args __attribute__((address_space(4)))* p_ = (const Args __attribute__((address_space(4)))*)__builtin_amdgcn_kernarg_segment_ptr(); p_; })
    volatile LAS unsigned* bst = (volatile LAS unsigned*)(lds + BAR_LDS_OFF);
    if (threadIdx.x < 2) bst[threadIdx.x] = 0u;
    __syncthreads();
    (void)xcd_barrier_post((unsigned*)(KARGS_EARLY()->ws), bst);
#define GRID_BAR() do { XcdBarrier b_; b_.bar = (unsigned*)(KARGS()->ws); b_.x = xb_xcc_id(); b_.st = (volatile LAS unsigned*)(lds + BAR_LDS_OFF); xcd_barrier(b_); } while (0)
    const int G = gridDim.x, bx = blockIdx.x;
#define PHASE_IDS() int tid = threadIdx.x; asm volatile("" : "+v"(tid)); const int lane = tid & 63, wave = __builtin_amdgcn_readfirstlane(tid >> 6); \
    const int vcu = (G % 8 == 0) ? (bx % 8) * (G / 8) + bx / 8 : bx; const int gw = vcu * NWAVES + wave, NGW = G * NWAVES; (void)lane; (void)gw; (void)NGW; (void)vcu;
typedef const Args __attribute__((address_space(4)))* kargs_ptr_t;
#define KARGS() ({ kargs_ptr_t p_ = (kargs_ptr_t)__builtin_amdgcn_kernarg_segment_ptr(); asm volatile("" : "+s"(p_)); p_; })
#define INP(i) (KARGS()->in[i])
#define WSP(T, off) ((T*)(KARGS()->ws + (off)))
    for (int rep_ = 0; rep_ < 1 + DUP(0); ++rep_) if (PH(0)) { PHASE_IDS();
        LAS float* scr = (LAS float*)(lds + wave * 16384);
        constexpr int I_GU = 16 * 88, I_D = 44 * 32, I_IN = 16 * 272, I_L = 4 * 8, I_AB = 8 * 32, I_SQ = 16 * 32;
        constexpr int NITEMS = 6 * I_GU   + I_IN + 8 * I_L + I_AB + 2 * I_SQ;
        static_assert(I_D == I_GU, "item counts");
        for (int it = gw; it < NITEMS; it += NGW) {
            int r = it;
            if (p0_job<1>(r, P_w1g, FF, DM, FF, P_n1pre, P_WGU1, DM, 0, scr, lane)) continue;
            if (p0_job<2>(r, P_w1u, FF, DM, FF, P_n1pre, P_WGU1, DM, 0, scr, lane)) continue;
            if (p0_job<0>(r, P_w1d, DM, FF, DM, nullptr, P_WD1, FF, 0, scr, lane)) continue;
            if (p0_job<0>(r, P_win, WINC, DM, WINC, P_mpre, P_WIN, DM, 0, scr, lane)) continue;
            bool done = false;
#pragma unroll 1
            for (int h = 0; h < 4 && !done; ++h) {
                if (p0_job<1>(r, P_wx + (size_t)h * 65536, 256, 256, 256, nullptr, P_WLRU, 256, h * 512, scr, lane)) { done = true; break; }
                if (p0_job<2>(r, P_wa + (size_t)h * 65536, 256, 256, 256, nullptr, P_WLRU, 256, h * 512, scr, lane)) { done = true; break; }
            }
            if (done) continue;
            if (p0_job<0>(r, P_wab, DM, 512, DM, nullptr, P_WAB, 512, 0, scr, lane)) continue;
            if (p0_job<0>(r, P_wrb, DM, DM, DM, nullptr, P_WRB, DM, 0, scr, lane)) continue;
            if (p0_job<0>(r, P_wout, DM, DM, DM, nullptr, P_WOUT, DM, 0, scr, lane)) continue;
            if (p0_job<1>(r, P_w2g, FF, DM, FF, P_n2pre, P_WGU2, DM, 0, scr, lane)) continue;
            if (p0_job<2>(r, P_w2u, FF, DM, FF, P_n2pre, P_WGU2, DM, 0, scr, lane)) continue;
            p0_job<0>(r, P_w2d, DM, FF, DM, nullptr, P_WD2, FF, 0, scr, lane);
        }
        { const float* x_ = P_x; bf16_t* AB_ = P_AB; float* RSQ0_ = P_RSQ0;
        for (int row = gw; row < M; row += NGW) {
            const float* xr = x_ + (size_t)row * DM; float s = 0.f;
#pragma unroll
            for (int j = 0; j < 2; ++j) { const int c = 8 * lane + 512 * j; const f32x4 a = *(const f32x4*)(xr + c), b = *(const f32x4*)(xr + c + 4);
                s += (a[0] * a[0] + a[1] * a[1]) + (a[2] * a[2] + a[3] * a[3]) + (b[0] * b[0] + b[1] * b[1]) + (b[2] * b[2] + b[3] * b[3]);
                u32x4 w; w.x = cvt_pk_bf16(a[0], a[1]); w.y = cvt_pk_bf16(a[2], a[3]); w.z = cvt_pk_bf16(b[0], b[1]); w.w = cvt_pk_bf16(b[2], b[3]);
                *(u32x4*)(AB_ + (size_t)row * DM + c) = w; }
            s = wave_sum(s); if (lane == 0) RSQ0_[row] = s;
        } }
    }
    grid.sync();

    pg8::StaticOrder SO;
    for (int rep_ = 0; rep_ < 1 + DUP(1); ++rep_) if (PH(1)) { pg8::Gemm g{P_AB, DM, P_WGU1, DM, M, 2 * FF, DM, 0, KREP_G1, EREP_G1}; SO.init(M, 2 * FF, G, bx); pg8::EpiSwiGLU E{P_HID, FF, P_RSQ0}; pg8::gemm_phase(lds, g, SO, E); }
    GRID_BAR();
    for (int rep_ = 0; rep_ < 1 + DUP(2); ++rep_) if (PH(2)) { pg8::Gemm g{P_HID, FF, P_WD1, FF, M, DM, FF, 0}; SO.init(M, DM, G, bx); pg8::EpiBf16 E{P_Fb, DM}; pg8::gemm_phase(lds, g, SO, E); }
    GRID_BAR();
    for (int rep_ = 0; rep_ < 1 + DUP(3); ++rep_) if (PH(3)) { PHASE_IDS(); norm_pass<true, false>(P_Fb, P_AB, P_x, P_n1post, 0.5f, nullptr, P_RSQ1, gw, NGW, lane); }
    GRID_BAR();
    for (int rep_ = 0; rep_ < 1 + DUP(4); ++rep_) if (PH(4)) { pg8::Gemm g{P_AB, DM, P_WIN, DM, M, 3 * QW, DM, 0, 1, EREP_G3A}; SO.init(M, 3 * QW, G, bx); pg8::EpiProj<0> E{P_Qb, (size_t)(WS_K - WS_Q) / 2, P_RSQ1}; pg8::gemm_phase(lds, g, SO, E); }
    GRID_BAR();
    for (int rep_ = 0; rep_ < 1 + DUP(5); ++rep_) if (PH(5)) { PHASE_IDS();
        LAS float* biasL = (LAS float*)(lds + ATT_BIAS_OFF);
        const float* btab_ = P_btab; const bf16_t *Qb_ = P_Qb, *Kb_ = P_Kb, *Vb_ = P_Vb; bf16_t* OG_ = P_OG; float* LSE_ = P_LSE;
        for (int i = tid; i < NH * 129; i += NTHREADS) { const int head = i / 129, st = i % 129, g_ = head >> 2; const int dil = g_ == 0 ? 1 : (g_ == 1 ? 4 : 16);
            biasL[head * 132 + st] = btab_[t5_bucket(st * dil) * NH + head] * LOG2E; }
        __syncthreads();
        LAS unsigned char* vl = lds + wave * ATT_V_BYTES;
        const int qq = lane & 31, hh2 = lane >> 5;
        const int tr_off = ((lane >> 4) >> 1) * 4 * VSTRIDE + (((lane & 15) >> 2)) * VSTRIDE + ((lane >> 4) & 1) * 32 + (lane & 3) * 8;
        for (int wu = vcu; wu < 1536; wu += G) {
            const int b = wu / 384, rem = wu % 384, head = rem >> 5, rem2 = rem & 31;
            const int g_ = head >> 2, hh = head & 3, dsh = 2 * g_;
            const int per = 32 >> dsh;
            const int p = rem2 / per, ub = rem2 % per;
            const int u0 = ub * 256 + wave * 32;
            const size_t rowb = (size_t)b * SEQ + p;
            const bf16_t* Qh = Qb_ + head * HD; const bf16_t* Kh = Kb_ + head * HD; const bf16_t* Vh = Vb_ + head * HD;
            bf16x8 Qf[8];
            { const bf16_t* qp = Qh + (rowb + ((size_t)(u0 + qq) << dsh)) * QW + hh2 * 8;
#pragma unroll
              for (int ks = 0; ks < 8; ++ks) Qf[ks] = *(const bf16x8*)(qp + ks * 16); }
            f32x16 O[4];
#pragma unroll
            for (int db = 0; db < 4; ++db)
#pragma unroll
                for (int i = 0; i < 16; ++i) O[db][i] = 0.f;
            float mrun = -INFINITY, lsum = 0.f;
            const int jstart = (u0 >= 128) ? 0 : (4 - (u0 >> 5));
            for (int j = jstart; j < 5; ++j) {
                const int kb_u = u0 - 128 + 32 * j;
                bf16x8 Kf[8];
                { const bf16_t* kp = Kh + (rowb + ((size_t)(kb_u + qq) << dsh)) * QW + hh2 * 8;
#pragma unroll
                  for (int ks = 0; ks < 8; ++ks) Kf[ks] = *(const bf16x8*)(kp + ks * 16); }
                u32x4 vst[8];
#pragma unroll
                for (int i = 0; i < 8; ++i) { const int rowi = i * 4 + (lane >> 4); vst[i] = *(const u32x4*)(Vh + (rowb + ((size_t)(kb_u + rowi) << dsh)) * QW + (lane & 15) * 8); }
#pragma unroll
                for (int i = 0; i < 8; ++i) { const int rowi = i * 4 + (lane >> 4); *(LAS u32x4*)(vl + rowi * VSTRIDE + (lane & 15) * 16) = vst[i]; }
                f32x16 Sx;
#pragma unroll
                for (int i = 0; i < 16; ++i) Sx[i] = 0.f;
#pragma unroll
                for (int ks = 0; ks < 8; ++ks) Sx = __builtin_amdgcn_mfma_f32_32x32x16_bf16(Kf[ks], Qf[ks], Sx, 0, 0, 0);
                float mx = -INFINITY;
                const LAS float* bh = biasL + head * 132;
#pragma unroll
                for (int i = 0; i < 16; ++i) { const int kk = (i & 3) + 8 * (i >> 2) + 4 * hh2; const int st = 128 - 32 * j + qq - kk;
                    const bool ok = (st >= 0) && (st <= 128); const float bv = bh[ok ? st : 0];
                    const float sc = ok ? Sx[i] + bv : -INFINITY; Sx[i] = sc; mx = fmaxf(mx, sc); }
                mx = fmaxf(mx, __shfl_xor(mx, 32));
                const float mnew = fmaxf(mrun, mx); const float alpha = __builtin_amdgcn_exp2f(mrun - mnew); mrun = mnew;
                float ps = 0.f;
#pragma unroll
                for (int i = 0; i < 16; ++i) { const float pv = __builtin_amdgcn_exp2f(Sx[i] - mnew); Sx[i] = pv; ps += pv; }
                lsum = lsum * alpha + ps;
#pragma unroll
                for (int db = 0; db < 4; ++db)
#pragma unroll
                    for (int i = 0; i < 16; ++i) O[db][i] *= alpha;
                bf16x8 Pf[2];
#pragma unroll
                for (int s = 0; s < 2; ++s) { u32x4 w; w.x = cvt_pk_bf16(Sx[8 * s + 0], Sx[8 * s + 1]); w.y = cvt_pk_bf16(Sx[8 * s + 2], Sx[8 * s + 3]); w.z = cvt_pk_bf16(Sx[8 * s + 4], Sx[8 * s + 5]); w.w = cvt_pk_bf16(Sx[8 * s + 6], Sx[8 * s + 7]);
                    Pf[s] = __builtin_bit_cast(bf16x8, w); }
                asm volatile("s_waitcnt lgkmcnt(0)" ::: "memory");
#pragma unroll
                for (int db = 0; db < 4; ++db)
#pragma unroll
                    for (int s = 0; s < 2; ++s) {
                        const LAS unsigned char* ap_ = vl + tr_off + (16 * s) * VSTRIDE + 64 * db;
                        const s16x4 lo = __builtin_bit_cast(s16x4, __builtin_amdgcn_ds_read_tr16_b64_v4i16((LAS s16x4*)ap_));
                        const s16x4 hi = __builtin_bit_cast(s16x4, __builtin_amdgcn_ds_read_tr16_b64_v4i16((LAS s16x4*)(ap_ + 8 * VSTRIDE)));
                        const bf16x8 Vf = (bf16x8){lo[0], lo[1], lo[2], lo[3], hi[0], hi[1], hi[2], hi[3]};
                        O[db] = __builtin_amdgcn_mfma_f32_32x32x16_bf16(Vf, Pf[s], O[db], 0, 0, 0);
                    }
                asm volatile("s_waitcnt lgkmcnt(0)" ::: "memory");
            }
            lsum += __shfl_xor(lsum, 32);
            const float inv = 1.f / lsum;
#pragma unroll
            for (int db = 0; db < 4; ++db)
#pragma unroll
                for (int a = 0; a < 4; ++a) { u32x2 w; w.x = cvt_pk_bf16(O[db][4 * a] * inv, O[db][4 * a + 1] * inv); w.y = cvt_pk_bf16(O[db][4 * a + 2] * inv, O[db][4 * a + 3] * inv);
                    *(LAS u32x2*)(vl + qq * VSTRIDE + (32 * db + 8 * a + 4 * hh2) * 2) = w; }
            asm volatile("s_waitcnt lgkmcnt(0)" ::: "memory");
            bf16_t* og = OG_ + (size_t)g_ * M * 512 + hh * HD;
#pragma unroll
            for (int i = 0; i < 8; ++i) { const int rowi = i * 4 + (lane >> 4); const u32x4 v = *(const LAS u32x4*)(vl + rowi * VSTRIDE + (lane & 15) * 16);
                *(u32x4*)(og + (rowb + ((size_t)(u0 + rowi) << dsh)) * 512 + (lane & 15) * 8) = v; }
            if (hh2 == 0) LSE_[((size_t)g_ * M + rowb + ((size_t)(u0 + qq) << dsh)) * 4 + hh] = mrun + __builtin_amdgcn_logf(lsum);
            asm volatile("s_waitcnt lgkmcnt(0)" ::: "memory");
        }
    }
    GRID_BAR();
    for (int rep_ = 0; rep_ < 1 + DUP(6); ++rep_) if (PH(6)) { pg8::Gemm g{P_AB, DM, P_WIN + (size_t)3 * QW * DM, DM, M, 4 * DM, DM, 0}; SO.init(M, 4 * DM, G, bx); pg8::EpiProj<1> E{P_XR, (size_t)(WS_YG - WS_XR) / 2, P_RSQ1}; pg8::gemm_phase(lds, g, SO, E); }
    GRID_BAR();
    for (int rep_ = 0; rep_ < 1 + DUP(7); ++rep_) if (PH(7)) { PHASE_IDS();
        const float *cw_ = P_cw, *cb_ = P_cb; const bf16_t* XR_ = P_XR; bf16_t* XC_ = P_XC; const float* LSE_ = P_LSE; const bf16_t* OG_ = P_OG; bf16_t* ATT_ = P_ATT;
        for (int it = gw; it < (M / 32) * 2; it += NGW) {
            const int rb = it >> 1, c0 = (it & 1) * 512 + lane * 8, r0 = rb * 32, t0 = r0 % SEQ;
            float w[4][8], bias[8];
#pragma unroll
            for (int j = 0; j < 4; ++j)
#pragma unroll
                for (int i = 0; i < 8; ++i) w[j][i] = cw_[j * DM + c0 + i];
#pragma unroll
            for (int i = 0; i < 8; ++i) bias[i] = cb_[c0 + i];
            float xw[3][8];
#pragma unroll
            for (int j = 0; j < 3; ++j) { const int tt = t0 - 3 + j;
                u32x4 v = (u32x4){0u, 0u, 0u, 0u}; if (tt >= 0) v = *(const u32x4*)(XR_ + (size_t)(r0 - 3 + j) * DM + c0);
                xw[j][0] = bflo(v.x); xw[j][1] = bfhi(v.x); xw[j][2] = bflo(v.y); xw[j][3] = bfhi(v.y); xw[j][4] = bflo(v.z); xw[j][5] = bfhi(v.z); xw[j][6] = bflo(v.w); xw[j][7] = bfhi(v.w); }
#pragma unroll 4
            for (int t = 0; t < 32; ++t) { const u32x4 v = *(const u32x4*)(XR_ + (size_t)(r0 + t) * DM + c0);
                const float x3[8] = {bflo(v.x), bfhi(v.x), bflo(v.y), bfhi(v.y), bflo(v.z), bfhi(v.z), bflo(v.w), bfhi(v.w)}; float o[8];
#pragma unroll
                for (int i = 0; i < 8; ++i) { o[i] = bias[i] + w[0][i] * xw[0][i] + w[1][i] * xw[1][i] + w[2][i] * xw[2][i] + w[3][i] * x3[i]; xw[0][i] = xw[1][i]; xw[1][i] = xw[2][i]; xw[2][i] = x3[i]; }
                u32x4 ov; ov.x = cvt_pk_bf16(o[0], o[1]); ov.y = cvt_pk_bf16(o[2], o[3]); ov.z = cvt_pk_bf16(o[4], o[5]); ov.w = cvt_pk_bf16(o[6], o[7]);
                *(u32x4*)(XC_ + (size_t)(r0 + t) * DM + c0) = ov; }
        }
        for (int row = gw; row < M; row += NGW) {
            const int hh = lane >> 4;
            const float l0 = LSE_[((size_t)0 * M + row) * 4 + hh], l1 = LSE_[((size_t)1 * M + row) * 4 + hh], l2 = LSE_[((size_t)2 * M + row) * 4 + hh];
            const float mx = fmaxf(l0, fmaxf(l1, l2)); const float e0 = __builtin_amdgcn_exp2f(l0 - mx), e1 = __builtin_amdgcn_exp2f(l1 - mx), e2 = __builtin_amdgcn_exp2f(l2 - mx);
            const float inv = 1.f / (e0 + e1 + e2); const float a0 = e0 * inv, a1 = e1 * inv, a2 = e2 * inv;
            const u32x4 v0 = *(const u32x4*)(OG_ + ((size_t)0 * M + row) * 512 + lane * 8), v1 = *(const u32x4*)(OG_ + ((size_t)1 * M + row) * 512 + lane * 8), v2 = *(const u32x4*)(OG_ + ((size_t)2 * M + row) * 512 + lane * 8);
            u32x4 o;
            o.x = cvt_pk_bf16(a0 * bflo(v0.x) + a1 * bflo(v1.x) + a2 * bflo(v2.x), a0 * bfhi(v0.x) + a1 * bfhi(v1.x) + a2 * bfhi(v2.x));
            o.y = cvt_pk_bf16(a0 * bflo(v0.y) + a1 * bflo(v1.y) + a2 * bflo(v2.y), a0 * bfhi(v0.y) + a1 * bfhi(v1.y) + a2 * bfhi(v2.y));
            o.z = cvt_pk_bf16(a0 * bflo(v0.z) + a1 * bflo(v1.z) + a2 * bflo(v2.z), a0 * bfhi(v0.z) + a1 * bfhi(v1.z) + a2 * bfhi(v2.z));
            o.w = cvt_pk_bf16(a0 * bflo(v0.w) + a1 * bflo(v1.w) + a2 * bflo(v2.w), a0 * bfhi(v0.w) + a1 * bfhi(v1.w) + a2 * bfhi(v2.w));
            *(u32x4*)(ATT_ + (size_t)row * 512 + lane * 8) = o;
        }
    }
    GRID_BAR();
    for (int rep_ = 0; rep_ < 1 + DUP(8); ++rep_) if (PH(8)) { pg8::Gemm g{P_XC, DM, P_WLRU, 256, M, 2 * DM, 256, 1}; SO.init(M, 2 * DM, G, bx); pg8::EpiLru E{P_XC, P_bxp, P_bap, P_app, P_LA, P_BB}; pg8::gemm_phase(lds, g, SO, E); }
    GRID_BAR();
    for (int rep_ = 0; rep_ < 1 + DUP(9); ++rep_) if (PH(9)) { PHASE_IDS(); const bf16_t *LA_ = P_LA, *BB_ = P_BB; float *CA_ = P_CA, *CH_ = P_CH;
    for (int it = gw; it < BATCH * 128 * 4; it += NGW) {
        const int qd = it & 3, ck = (it >> 2) & 127, b = it >> 9; const int c0 = qd * 256 + lane * 4; const size_t r0 = (size_t)b * SEQ + ck * 64;
        float h[4] = {0.f, 0.f, 0.f, 0.f}, sl[4] = {0.f, 0.f, 0.f, 0.f};
#pragma unroll 8
        for (int t = 0; t < 64; ++t) { const u32x2 lw = *(const u32x2*)(LA_ + (r0 + t) * DM + c0), bw = *(const u32x2*)(BB_ + (r0 + t) * DM + c0);
            const float l[4] = {bflo(lw.x), bfhi(lw.x), bflo(lw.y), bfhi(lw.y)}, bv[4] = {bflo(bw.x), bfhi(bw.x), bflo(bw.y), bfhi(bw.y)};
#pragma unroll
            for (int i = 0; i < 4; ++i) { sl[i] += l[i]; h[i] = __builtin_amdgcn_exp2f(l[i] * LOG2E) * h[i] + bv[i]; } }
        *(f32x4*)(CA_ + ((size_t)(b * 128 + ck)) * DM + c0) = (f32x4){sl[0], sl[1], sl[2], sl[3]};
        *(f32x4*)(CH_ + ((size_t)(b * 128 + ck)) * DM + c0) = (f32x4){h[0], h[1], h[2], h[3]};
    } }
    GRID_BAR();
    for (int rep_ = 0; rep_ < 1 + DUP(10); ++rep_) if (PH(10)) { PHASE_IDS(); const bf16_t *LA_ = P_LA, *BB_ = P_BB, *YG_ = P_YG; const float *CA_ = P_CA, *CH_ = P_CH; bf16_t* REC_ = P_REC;
    for (int it = gw; it < BATCH * 128 * 4; it += NGW) {
        const int qd = it & 3, ck = (it >> 2) & 127, b = it >> 9; const int c0 = qd * 256 + lane * 4; const size_t r0 = (size_t)b * SEQ + ck * 64;
        float h[4] = {0.f, 0.f, 0.f, 0.f};
        for (int k = 0; k < ck; ++k) { const f32x4 a = *(const f32x4*)(CA_ + ((size_t)(b * 128 + k)) * DM + c0), hv = *(const f32x4*)(CH_ + ((size_t)(b * 128 + k)) * DM + c0);
#pragma unroll
            for (int i = 0; i < 4; ++i) h[i] = __builtin_amdgcn_exp2f(a[i] * LOG2E) * h[i] + hv[i]; }
#pragma unroll 8
        for (int t = 0; t < 64; ++t) { const u32x2 lw = *(const u32x2*)(LA_ + (r0 + t) * DM + c0), bw = *(const u32x2*)(BB_ + (r0 + t) * DM + c0), yw = *(const u32x2*)(YG_ + (r0 + t) * DM + c0);
            const float l[4] = {bflo(lw.x), bfhi(lw.x), bflo(lw.y), bfhi(lw.y)}, bv[4] = {bflo(bw.x), bfhi(bw.x), bflo(bw.y), bfhi(bw.y)}, yv[4] = {bflo(yw.x), bfhi(yw.x), bflo(yw.y), bfhi(yw.y)};
            float o[4];
#pragma unroll
            for (int i = 0; i < 4; ++i) { h[i] = __builtin_amdgcn_exp2f(l[i] * LOG2E) * h[i] + bv[i]; o[i] = h[i] * yv[i]; }
            u32x2 w; w.x = cvt_pk_bf16(o[0], o[1]); w.y = cvt_pk_bf16(o[2], o[3]); *(u32x2*)(REC_ + (r0 + t) * DM + c0) = w; }
    } }
    GRID_BAR();
    for (int rep_ = 0; rep_ < 1 + DUP(11); ++rep_) if (PH(11)) { pg8::Gemm g{P_ATT, 512, P_WAB, 512, M, DM, 512, 0}; SO.init(M, DM, G, bx); pg8::EpiGate E{0, P_GT, P_MG}; pg8::gemm_phase(lds, g, SO, E); }
    for (int rep_ = 0; rep_ < 1 + DUP(11); ++rep_) if (PH(11)) { pg8::Gemm g{P_REC, DM, P_WRB, DM, M, DM, DM, 0}; SO.init(M, DM, G, bx); pg8::EpiGate E{1, P_GT, P_MG}; pg8::gemm_phase(lds, g, SO, E); }
    GRID_BAR();
    for (int rep_ = 0; rep_ < 1 + DUP(12); ++rep_) if (PH(12)) { pg8::Gemm g{P_MG, DM, P_WOUT, DM, M, DM, DM, 0}; SO.init(M, DM, G, bx); pg8::EpiBf16 E{P_Fb, DM}; pg8::gemm_phase(lds, g, SO, E); }
    GRID_BAR();
    for (int rep_ = 0; rep_ < 1 + DUP(13); ++rep_) if (PH(13)) { PHASE_IDS(); norm_pass<false, false>(P_Fb, P_AB, nullptr, P_mpost, 1.0f, nullptr, P_RSQ2, gw, NGW, lane); }
    GRID_BAR();
    for (int rep_ = 0; rep_ < 1 + DUP(14); ++rep_) if (PH(14)) { pg8::Gemm g{P_AB, DM, P_WGU2, DM, M, 2 * FF, DM, 0}; SO.init(M, 2 * FF, G, bx); pg8::EpiSwiGLU E{P_HID, FF, P_RSQ2}; pg8::gemm_phase(lds, g, SO, E); }
    GRID_BAR();
    for (int rep_ = 0; rep_ < 1 + DUP(15); ++rep_) if (PH(15)) { pg8::Gemm g{P_HID, FF, P_WD2, FF, M, DM, FF, 0}; SO.init(M, DM, G, bx); pg8::EpiBf16 E{P_Fb, DM}; pg8::gemm_phase(lds, g, SO, E); }
    GRID_BAR();
    for (int rep_ = 0; rep_ < 1 + DUP(16); ++rep_) if (PH(16)) { PHASE_IDS(); norm_pass<false, true>(P_Fb, P_AB, nullptr, P_n2post, 0.5f, P_out, nullptr, gw, NGW, lane); }
}

extern "C" void kernel_launch(void* const* d_in, const int* in_sizes, int n_in, void* d_out, int out_size, void* d_ws, size_t ws_size, hipStream_t stream) {
    static int grid = 0;
    if (grid == 0) {
        if (n_in != 25 || out_size != M * DM || ws_size < WS_END) { fprintf(stderr, "kernel_launch: unexpected shapes (n_in %d out %d ws %zu)\n", n_in, out_size, ws_size); grid = -1; return; }
        int dev = 0, cus = 0, per_cu = 0;
        hipGetDevice(&dev); hipDeviceGetAttribute(&cus, hipDeviceAttributeMultiprocessorCount, dev);
        hipFuncSetAttribute((const void*)mk_fwd, hipFuncAttributeMaxDynamicSharedMemorySize, LDS_BYTES);
        hipOccupancyMaxActiveBlocksPerMultiprocessor(&per_cu, (const void*)mk_fwd, NTHREADS, LDS_BYTES);
        if (per_cu < 1) { fprintf(stderr, "kernel_launch: occupancy query says %d blocks per CU\n", per_cu); per_cu = 1; }
        grid = cus;
        fprintf(stderr, "kernel_launch: cus %d per_cu %d grid %d\n", cus, per_cu, grid);
    }
    if (grid < 0) return;
    if (hipMemsetAsync(d_ws, 0, 65536, stream) != hipSuccess) { fprintf(stderr, "kernel_launch: memset failed\n"); return; }
    Args a{};
    for (int i = 0; i < 25; ++i) a.in[i] = (const float*)d_in[i];
    a.out = (float*)d_out; a.ws = (unsigned char*)d_ws;
    void* kargs[] = {&a};
    hipError_t e = hipLaunchCooperativeKernel((const void*)mk_fwd, dim3(grid), dim3(NTHREADS), kargs, LDS_BYTES, stream);
    if (e != hipSuccess) fprintf(stderr, "cooperative launch failed: %s (grid %d)\n", hipGetErrorString(e), grid);
}
```

```cpp
#include <hip/hip_runtime.h>
#include <hip/hip_cooperative_groups.h>
#include <cstdio>
#include <cstdint>
#include <cmath>
namespace cg = cooperative_groups;

#define LAS __attribute__((address_space(3)))
typedef unsigned short bf16_t;
typedef short bf16x8 __attribute__((ext_vector_type(8)));
typedef float f32x4 __attribute__((ext_vector_type(4)));
typedef float f32x16 __attribute__((ext_vector_type(16)));
typedef unsigned u32x4 __attribute__((ext_vector_type(4)));
typedef unsigned u32x2 __attribute__((ext_vector_type(2)));
typedef short s16x4 __attribute__((ext_vector_type(4)));

#ifndef PHMASK
#define PHMASK 0x1FFFF
#endif
#define PH(n) ((PHMASK >> (n)) & 1)
#ifndef DUPMASK
#define DUPMASK 0
#endif
#define DUP(n) ((DUPMASK >> (n)) & 1)
#ifndef NTSTORE
#define NTSTORE 0
#endif
#define EPI_ST16(p, v) do { if (NTSTORE) __builtin_nontemporal_store((v), (u32x4*)(p)); else *(u32x4*)(p) = (v); } while (0)
#ifndef EREP_G1
#define EREP_G1 1
#endif
#ifndef EREP_G3A
#define EREP_G3A 1
#endif
#ifndef FUSED_NORM
#define FUSED_NORM 1
#endif
#ifndef ATTN_PROBE
#define ATTN_PROBE 0
#endif
#ifndef KREP_G1
#define KREP_G1 1
#endif

constexpr int BATCH = 4, SEQ = 8192, DM = 1024, M = BATCH * SEQ, FF = 2816, NH = 12, HD = 128, QW = 1536, WINC = 8704;
constexpr float EPS = 1e-6f;
constexpr float LOG2E = 1.4426950408889634f;
constexpr float C2 = 0.08838834764831845f * 1.4426950408889634f;
constexpr int NWAVES = 8, NTHREADS = 512;

constexpr size_t MiB = 1u << 20;
constexpr size_t WS_RSQ0 = 508 * MiB, WS_RSQ1 = WS_RSQ0 + 512 * 1024, WS_RSQ2 = WS_RSQ1 + 512 * 1024;
constexpr size_t WS_XS = 508 * MiB + 1536 * 1024;
constexpr size_t WS_WGU1 = 1 * MiB, WS_WD1 = 12 * MiB, WS_WIN = 18 * MiB, WS_WLRU = 35 * MiB, WS_WAB = 36 * MiB, WS_WRB = 37 * MiB, WS_WOUT = 39 * MiB, WS_WGU2 = 41 * MiB, WS_WD2 = 52 * MiB;
constexpr size_t WS_LSE = 58 * MiB;
constexpr size_t WS_AB = 60 * MiB;
constexpr size_t WS_Q = 124 * MiB, WS_K = 220 * MiB, WS_V = 316 * MiB;
constexpr size_t WS_OG = 412 * MiB;
constexpr size_t WS_HID = 124 * MiB;
constexpr size_t WS_F = 300 * MiB;
constexpr size_t WS_XR = 124 * MiB, WS_YG = 188 * MiB, WS_GT = 252 * MiB, WS_ATT = 380 * MiB, WS_XC = 60 * MiB;
constexpr size_t WS_LA = 124 * MiB, WS_BB = 412 * MiB, WS_CA = 476 * MiB, WS_CH = 478 * MiB;
constexpr size_t WS_REC = 60 * MiB, WS_MG = 124 * MiB;
constexpr size_t WS_END = 511 * MiB;
static_assert(WS_V - WS_K == WS_K - WS_Q && WS_GT - WS_YG == WS_YG - WS_XR, "section strides");

__device__ __forceinline__ float bf2f(unsigned short h) { return __uint_as_float((unsigned)h << 16); }
__device__ __forceinline__ float bflo(unsigned w) { return __uint_as_float(w << 16); }
__device__ __forceinline__ float bfhi(unsigned w) { return __uint_as_float(w & 0xffff0000u); }
__device__ __forceinline__ unsigned cvt_pk_bf16(float lo, float hi) { unsigned r; asm volatile("v_cvt_pk_bf16_f32 %0, %1, %2" : "=v"(r) : "v"(lo), "v"(hi)); return r; }
__device__ __forceinline__ float wave_sum(float v) {
#pragma unroll
    for (int o = 1; o < 64; o <<= 1) v += __shfl_xor(v, o);
    return v;
}
__device__ __forceinline__ float fast_sigmoid(float x) { return __builtin_amdgcn_rcpf(1.f + __builtin_amdgcn_exp2f(-x * LOG2E)); }
__device__ __forceinline__ float gelu_tanh(float x) {
    const float u = 0.7978845608028654f * (x + 0.044715f * x * x * x);
    return x * fast_sigmoid(2.f * u);
}

namespace pg8 {
constexpr int BM = 256, BK = 64, HALF = 128, HTB = HALF * BK * 2, STAGE_BYTES = 8 * HTB, NXCD = 8, WGM = 8;
__host__ __device__ __forceinline__ int lds_byte(int r, int c) { const int st = (r >> 4) * 2 + (c >> 5), rr = r & 15, cc = c & 31, ob = rr * 64 + cc * 2; return st * 1024 + (ob ^ (((ob >> 9) & 1) << 5)); }
__host__ __device__ __forceinline__ void stage_rc(int b, int& R, int& C) { const int st = b / 1024, sb = b % 1024, swz = sb ^ (((sb >> 9) & 1) << 5); R = (st >> 1) * 16 + swz / 64; C = (st & 1) * 32 + (swz % 64) / 2; }
__host__ __device__ __forceinline__ int perm32(int rho) { const int n = rho >> 4, i = rho & 15; return 8 * (i >> 2) + 4 * n + (i & 3); }

struct Unit { int pm, pn; };
struct Gemm { const bf16_t* A; int lda; const bf16_t* Bt; int ldb; int M, N, K; int amode; int krep = 1; int erep = 1; };

struct StaticOrder {
    int nM, nN, nwg, G, c;
    __device__ void init(int M_, int N_, int G_, int c_) { nM = M_ / BM; nN = N_ / BM; nwg = nM * nN; G = G_; c = c_; }
    __device__ bool next(int i, Unit& u) const {
        const long L = (long)i * G + c; if (L >= nwg) return false;
        int wgid = (int)L; { const int q = nwg / NXCD, r = nwg % NXCD, xcd = wgid % NXCD, off = wgid / NXCD; wgid = (xcd < r ? xcd * (q + 1) : r * (q + 1) + (xcd - r) * q) + off; }
        const int nig = WGM * nN, gid = wgid / nig, fm = gid * WGM, gsz = (nM - fm) < WGM ? (nM - fm) : WGM;
        u.pm = fm + ((wgid % nig) % gsz); u.pn = (wgid % nig) / gsz; return true;
    }
};

template <class Epi>
__device__ __forceinline__ void gemm_phase(LAS unsigned char* lds, const Gemm g, const StaticOrder& S, const Epi& E) {
    int tid = threadIdx.x; asm volatile("" : "+v"(tid));
    const int wid = __builtin_amdgcn_readfirstlane(tid >> 6), lane = tid & 63, wr = wid >> 2, wc = wid & 3, fr = lane & 15, fq = lane >> 4;
    const int K = g.K, nt = K / BK;
    unsigned voffA[2], voffB[2];
#pragma unroll
    for (int i = 0; i < 2; ++i) { int R, C; stage_rc(tid * 16 + i * 8192, R, C); const int Rb = (R & ~31) + perm32(R & 31);
        voffA[i] = (unsigned)(R * g.lda + C) * 2u; voffB[i] = (unsigned)(Rb * g.ldb + C) * 2u; }
    const size_t kstep = (size_t)(BK * 2);
    const size_t hstepA = (size_t)HALF * g.lda * 2, hstepB = (size_t)HALF * g.ldb * 2;
    const unsigned ldsw = (unsigned)wid * 1024u;
    const int aoff = lds_byte(wr * 64 + fr, fq * 8), boff = lds_byte(wc * 32 + fr, fq * 8);
#define PG8_SA(b, h) (((b) * 2 + (h)) * HTB)
#define PG8_SB(b, h) ((4 + (b) * 2 + (h)) * HTB)
#define PG8_STAGE(bufoff, gbase, voff) do { _Pragma("unroll") for (int _i = 0; _i < 2; ++_i) \
        __builtin_amdgcn_global_load_lds((const unsigned*)((const char*)(gbase) + (voff)[_i]), (LAS unsigned*)(lds + (bufoff) + ldsw + _i * 8192), 16, 0, 0); } while (0)
#define PG8_LDA(dst, b, h) do { _Pragma("unroll") for (int m = 0; m < 4; ++m) _Pragma("unroll") for (int k = 0; k < 2; ++k) dst[m][k] = *(const LAS bf16x8*)(lds + PG8_SA(b, h) + aoff + m * 2048 + k * 1024); } while (0)
#define PG8_LDB(dst, b, h) do { _Pragma("unroll") for (int n = 0; n < 2; ++n) _Pragma("unroll") for (int k = 0; k < 2; ++k) dst[n][k] = *(const LAS bf16x8*)(lds + PG8_SB(b, h) + boff + n * 2048 + k * 1024); } while (0)
#define PG8_MMA(ai, bj, At, Bt) do { __builtin_amdgcn_s_setprio(1); _Pragma("unroll") for (int m = 0; m < 4; ++m) _Pragma("unroll") for (int n = 0; n < 2; ++n) _Pragma("unroll") for (int k = 0; k < 2; ++k) \
        acc[ai][bj][m][n] = __builtin_amdgcn_mfma_f32_16x16x32_bf16(Bt[n][k], At[m][k], acc[ai][bj][m][n], 0, 0, 0); __builtin_amdgcn_s_setprio(0); } while (0)
#define PG8_WAIT_V(n) asm volatile("s_waitcnt vmcnt(" #n ")" ::: "memory")
#define PG8_WAIT_L(n) asm volatile("s_waitcnt lgkmcnt(" #n ")" ::: "memory")
#define PG8_BAR __builtin_amdgcn_s_barrier()
#define PG8_SCHED __builtin_amdgcn_sched_barrier(0)
#define PG8_APTR(u) ((const char*)g.A + (size_t)(u).pm * 2 * hstepA + (g.amode == 1 ? (size_t)(((u).pn >> 1) * 256 * 2) : (size_t)0))
#define PG8_BPTR(u) ((const char*)g.Bt + (size_t)(u).pn * 2 * hstepB)
    Unit cur, nxt; int ui = 0;
    if (!S.next(0, cur)) return;
    f32x4 acc[2][2][4][2];
#pragma unroll
    for (int a = 0; a < 2; ++a)
#pragma unroll
        for (int b = 0; b < 2; ++b)
#pragma unroll
            for (int m = 0; m < 4; ++m)
#pragma unroll
                for (int n = 0; n < 2; ++n) acc[a][b][m][n] = (f32x4){0.f, 0.f, 0.f, 0.f};
    bf16x8 At[4][2], B0[2][2], B1[2][2];
    const char* cA = PG8_APTR(cur); const char* cB = PG8_BPTR(cur);
    PG8_STAGE(PG8_SB(0, 0), cB, voffB); PG8_STAGE(PG8_SB(0, 1), cB + hstepB, voffB); PG8_STAGE(PG8_SA(0, 0), cA, voffA); PG8_STAGE(PG8_SA(0, 1), cA + hstepA, voffA);
    if (wr == 1) PG8_BAR;
    PG8_WAIT_V(2); PG8_BAR;
    PG8_STAGE(PG8_SB(1, 0), cB + kstep, voffB); PG8_STAGE(PG8_SA(1, 0), cA + kstep, voffA); PG8_STAGE(PG8_SB(1, 1), cB + hstepB + kstep, voffB);
    PG8_WAIT_V(6); PG8_BAR;
    for (;;) {
        const bool has_next = S.next(ui + 1, nxt);
        const char* nA0 = has_next ? PG8_APTR(nxt) : cA; const char* nB0 = has_next ? PG8_BPTR(nxt) : cB;
        for (int kr = 0; kr < g.krep; ++kr) {
        const char* nA = (kr == g.krep - 1) ? nA0 : cA; const char* nB = (kr == g.krep - 1) ? nB0 : cB;
        for (int t = 0; t < nt; t += 2) {
            const bool last = (t == nt - 2);
            const char* a1 = cA + (size_t)(t + 1) * kstep;
            const char* a2 = last ? nA : cA + (size_t)(t + 2) * kstep; const char* b2 = last ? nB : cB + (size_t)(t + 2) * kstep;
            const char* a3 = a2 + kstep; const char* b3 = b2 + kstep;
            PG8_LDB(B0, 0, 0); PG8_LDB(B1, 0, 1); PG8_SCHED; PG8_LDA(At, 0, 0); PG8_STAGE(PG8_SA(1, 1), a1 + hstepA, voffA);
            PG8_WAIT_V(8); PG8_WAIT_L(0); PG8_BAR; PG8_MMA(0, 0, At, B0); PG8_MMA(0, 1, At, B1); PG8_BAR; PG8_SCHED;
            PG8_LDA(At, 0, 1); PG8_STAGE(PG8_SB(0, 0), b2, voffB); PG8_STAGE(PG8_SB(0, 1), b2 + hstepB, voffB); PG8_STAGE(PG8_SA(0, 0), a2, voffA);
            PG8_WAIT_V(8); PG8_WAIT_L(0); PG8_BAR; PG8_MMA(1, 0, At, B0); PG8_MMA(1, 1, At, B1); PG8_BAR; PG8_SCHED;
            PG8_LDB(B0, 1, 0); PG8_LDB(B1, 1, 1); PG8_SCHED; PG8_LDA(At, 1, 0); PG8_STAGE(PG8_SA(0, 1), a2 + hstepA, voffA);
            PG8_WAIT_V(8); PG8_WAIT_L(0); PG8_BAR; PG8_MMA(0, 0, At, B0); PG8_MMA(0, 1, At, B1); PG8_BAR; PG8_SCHED;
            PG8_LDA(At, 1, 1); PG8_STAGE(PG8_SB(1, 0), b3, voffB); PG8_STAGE(PG8_SB(1, 1), b3 + hstepB, voffB); PG8_STAGE(PG8_SA(1, 0), a3, voffA);
            PG8_WAIT_V(8); PG8_WAIT_L(0); PG8_BAR; PG8_MMA(1, 0, At, B0); PG8_MMA(1, 1, At, B1); PG8_BAR; PG8_SCHED;
        }
        }
        if (g.krep == 2) {
#pragma unroll
            for (int a = 0; a < 2; ++a)
#pragma unroll
                for (int b = 0; b < 2; ++b)
#pragma unroll
                    for (int m = 0; m < 4; ++m)
#pragma unroll
                        for (int n = 0; n < 2; ++n) acc[a][b][m][n] *= 0.5f;
        }
        const char* nA = nA0; const char* nB = nB0;
        if (wr == 0) PG8_BAR;
        for (int er = 0; er < g.erep; ++er) { E(acc, cur, wr, wc, fr, fq); asm volatile("" ::: "memory"); }
        if (!has_next) break;
#pragma unroll
        for (int a = 0; a < 2; ++a)
#pragma unroll
            for (int b = 0; b < 2; ++b)
#pragma unroll
                for (int m = 0; m < 4; ++m)
#pragma unroll
                    for (int n = 0; n < 2; ++n) acc[a][b][m][n] = (f32x4){0.f, 0.f, 0.f, 0.f};
        cur = nxt; cA = nA; cB = nB; ++ui;
        if (wr == 1) PG8_BAR;
    }
    PG8_WAIT_V(0);
    PG8_BAR;
#undef PG8_SA
#undef PG8_SB
#undef PG8_STAGE
#undef PG8_LDA
#undef PG8_LDB
#undef PG8_MMA
#undef PG8_WAIT_V
#undef PG8_WAIT_L
#undef PG8_BAR
#undef PG8_SCHED
#undef PG8_APTR
#undef PG8_BPTR
}

__device__ __forceinline__ float rowscale(const float* rsq, int row) { const f32x4 p = *(const f32x4*)(rsq + 4 * (size_t)row); return rsqrtf(((p[0] + p[1]) + (p[2] + p[3])) * (1.f / DM) + EPS); }

struct EpiSwiGLU {
    bf16_t* O; int ldc; const float* rsq;
    __device__ __forceinline__ void operator()(const f32x4 (&acc)[2][2][4][2], const Unit& u, int wr, int wc, int fr, int fq) const {
        const int row0 = u.pm * BM + wr * 64 + fr, col0 = u.pn * HALF + wc * 32 + 8 * fq;
#pragma unroll
        for (int ai = 0; ai < 2; ++ai)
#pragma unroll
            for (int m = 0; m < 4; ++m) { const int row = row0 + ai * HALF + m * 16; const float s = rowscale(rsq, row);
                float o[8];
#pragma unroll
                for (int n = 0; n < 2; ++n)
#pragma unroll
                    for (int i = 0; i < 4; ++i) { const float gt = acc[ai][0][m][n][i] * s, up = acc[ai][1][m][n][i] * s; o[n * 4 + i] = gt * fast_sigmoid(gt) * up; }
                u32x4 w; w.x = cvt_pk_bf16(o[0], o[1]); w.y = cvt_pk_bf16(o[2], o[3]); w.z = cvt_pk_bf16(o[4], o[5]); w.w = cvt_pk_bf16(o[6], o[7]);
                *(u32x4*)(O + (size_t)row * ldc + col0) = w; }
    }
};
struct EpiBf16 {
    bf16_t* O; int ldc;
    __device__ __forceinline__ void operator()(const f32x4 (&acc)[2][2][4][2], const Unit& u, int wr, int wc, int fr, int fq) const {
        const int row0 = u.pm * BM + wr * 64 + fr, col0 = u.pn * BM + wc * 32 + 8 * fq;
#pragma unroll
        for (int ai = 0; ai < 2; ++ai)
#pragma unroll
            for (int m = 0; m < 4; ++m) { bf16_t* rowp = O + (size_t)(row0 + ai * HALF + m * 16) * ldc + col0;
#pragma unroll
                for (int bj = 0; bj < 2; ++bj) { const f32x4 v0 = acc[ai][bj][m][0], v1 = acc[ai][bj][m][1];
                    u32x4 w; w.x = cvt_pk_bf16(v0[0], v0[1]); w.y = cvt_pk_bf16(v0[2], v0[3]); w.z = cvt_pk_bf16(v1[0], v1[1]); w.w = cvt_pk_bf16(v1[2], v1[3]);
                    EPI_ST16(rowp + bj * HALF, w); } }
    }
};
template <int MODE> struct EpiProj {
    bf16_t* o0; size_t sec_stride; const float* rsq;
    __device__ __forceinline__ void operator()(const f32x4 (&acc)[2][2][4][2], const Unit& u, int wr, int wc, int fr, int fq) const {
        const int row0 = u.pm * BM + wr * 64 + fr;
        int sec, ldc, colt; float sc = 1.f;
        if (MODE == 0) { sec = u.pn / 6; ldc = QW; colt = (u.pn % 6) * BM; if (sec == 0) sc = C2; }
        else { sec = u.pn < 8 ? (u.pn >> 2) : 2; ldc = u.pn < 8 ? DM : 2 * DM; colt = u.pn < 8 ? (u.pn & 3) * BM : (u.pn - 8) * BM; }
        bf16_t* base = o0 + (size_t)sec * sec_stride;
        const int col0 = colt + wc * 32 + 8 * fq;
#pragma unroll
        for (int ai = 0; ai < 2; ++ai)
#pragma unroll
            for (int m = 0; m < 4; ++m) { const int row = row0 + ai * HALF + m * 16; const float s = rowscale(rsq, row) * sc; bf16_t* rowp = base + (size_t)row * ldc + col0;
#pragma unroll
                for (int bj = 0; bj < 2; ++bj) { f32x4 v0 = acc[ai][bj][m][0] * s, v1 = acc[ai][bj][m][1] * s;
                    if (MODE == 1) {
                        if (sec == 1) {
#pragma unroll
                            for (int i = 0; i < 4; ++i) { v0[i] = gelu_tanh(v0[i]); v1[i] = gelu_tanh(v1[i]); }
                        } else if (sec == 2) {
#pragma unroll
                            for (int i = 0; i < 4; ++i) { v0[i] = fast_sigmoid(v0[i]); v1[i] = fast_sigmoid(v1[i]); }
                        }
                    }
                    u32x4 w; w.x = cvt_pk_bf16(v0[0], v0[1]); w.y = cvt_pk_bf16(v0[2], v0[3]); w.z = cvt_pk_bf16(v1[0], v1[1]); w.w = cvt_pk_bf16(v1[2], v1[3]);
                    EPI_ST16(rowp + bj * HALF, w); } }
    }
};
struct EpiLru {
    const bf16_t* XC; const float *bx, *ba, *ap; bf16_t *LA, *BB;
    __device__ __forceinline__ void operator()(const f32x4 (&acc)[2][2][4][2], const Unit& u, int wr, int wc, int fr, int fq) const {
        const int row0 = u.pm * BM + wr * 64 + fr, c0 = (u.pn >> 1) * 256 + (u.pn & 1) * 128 + wc * 32 + 8 * fq;
        float vbx[8], vba[8], vsp[8];
#pragma unroll
        for (int j = 0; j < 8; ++j) { vbx[j] = bx[c0 + j]; vba[j] = ba[c0 + j]; const float nap = -ap[c0 + j]; vsp[j] = -8.f * ((nap > 20.f) ? nap : log1pf(expf(nap))); }
#pragma unroll
        for (int ai = 0; ai < 2; ++ai)
#pragma unroll
            for (int m = 0; m < 4; ++m) { const int row = row0 + ai * HALF + m * 16; const size_t off = (size_t)row * DM + c0;
                const u32x4 xw = *(const u32x4*)(XC + off); float xv[8] = {bflo(xw.x), bfhi(xw.x), bflo(xw.y), bfhi(xw.y), bflo(xw.z), bfhi(xw.z), bflo(xw.w), bfhi(xw.w)};
                float la[8], bb[8];
#pragma unroll
                for (int n = 0; n < 2; ++n)
#pragma unroll
                    for (int i = 0; i < 4; ++i) { const int j = n * 4 + i; const float gx = fast_sigmoid(acc[ai][0][m][n][i] + vbx[j]), ga = fast_sigmoid(acc[ai][1][m][n][i] + vba[j]);
                        const float l = ga * vsp[j]; la[j] = l; const float x2 = 2.f * l;
                        const float om = (x2 > -0.25f) ? -x2 * (1.f + x2 * (0.5f + x2 * (0.16666667f + x2 * (0.041666668f + x2 * (0.0083333333f + x2 * 0.0013888889f))))) : 1.f - __expf(x2);
                        bb[j] = sqrtf(om) * gx * xv[j]; }
                u32x4 w; w.x = cvt_pk_bf16(la[0], la[1]); w.y = cvt_pk_bf16(la[2], la[3]); w.z = cvt_pk_bf16(la[4], la[5]); w.w = cvt_pk_bf16(la[6], la[7]); *(u32x4*)(LA + off) = w;
                u32x4 v; v.x = cvt_pk_bf16(bb[0], bb[1]); v.y = cvt_pk_bf16(bb[2], bb[3]); v.z = cvt_pk_bf16(bb[4], bb[5]); v.w = cvt_pk_bf16(bb[6], bb[7]); *(u32x4*)(BB + off) = v; }
    }
};
struct EpiGate {
    int mode; const bf16_t* GT; bf16_t* MG;
    __device__ __forceinline__ void operator()(const f32x4 (&acc)[2][2][4][2], const Unit& u, int wr, int wc, int fr, int fq) const {
        const int row0 = u.pm * BM + wr * 64 + fr, col0 = u.pn * BM + wc * 32 + 8 * fq;
#pragma unroll
        for (int ai = 0; ai < 2; ++ai)
#pragma unroll
            for (int m = 0; m < 4; ++m) { const int row = row0 + ai * HALF + m * 16;
#pragma unroll
                for (int bj = 0; bj < 2; ++bj) { const int col = col0 + bj * HALF;
                    const u32x4 gw = *(const u32x4*)(GT + (size_t)row * (2 * DM) + mode * DM + col);
                    const float gv[8] = {bflo(gw.x), bfhi(gw.x), bflo(gw.y), bfhi(gw.y), bflo(gw.z), bfhi(gw.z), bflo(gw.w), bfhi(gw.w)};
                    float o[8];
#pragma unroll
                    for (int n = 0; n < 2; ++n)
#pragma unroll
                        for (int i = 0; i < 4; ++i) o[n * 4 + i] = acc[ai][bj][m][n][i] * gv[n * 4 + i];
                    bf16_t* p = MG + (size_t)row * DM + col;
                    if (mode == 1) { const u32x4 pw = *(const u32x4*)p; o[0] += bflo(pw.x); o[1] += bfhi(pw.x); o[2] += bflo(pw.y); o[3] += bfhi(pw.y); o[4] += bflo(pw.z); o[5] += bfhi(pw.z); o[6] += bflo(pw.w); o[7] += bfhi(pw.w); }
                    u32x4 w; w.x = cvt_pk_bf16(o[0], o[1]); w.y = cvt_pk_bf16(o[2], o[3]); w.z = cvt_pk_bf16(o[4], o[5]); w.w = cvt_pk_bf16(o[6], o[7]);
                    *(u32x4*)p = w; } }
    }
};
template <int MODE> struct EpiNormRes {
    const float* resf; bf16_t* AB; float* outf; const float* gpost; float coef; unsigned long long* xs; unsigned epoch; float* rsq_out; LAS unsigned char* sl;
    __device__ __forceinline__ void operator()(const f32x4 (&acc)[2][2][4][2], const Unit& u, int wr, int wc, int fr, int fq) const {
        LAS float* P = (LAS float*)sl;
        LAS float* S = (LAS float*)(sl + 4096);
        const int wid = wr * 4 + wc, lane = fq * 16 + fr;
        const int col0 = u.pn * BM + wc * 32 + 8 * fq;
        f32x4 gv[2][2];
#pragma unroll
        for (int bj = 0; bj < 2; ++bj) { gv[bj][0] = *(const f32x4*)(gpost + col0 + bj * HALF); gv[bj][1] = *(const f32x4*)(gpost + col0 + bj * HALF + 4); }
        u32x4 pre[4][2];
#pragma unroll
        for (int m = 0; m < 4; ++m) { const size_t off = (size_t)(u.pm * BM + wr * 64 + m * 16 + fr) * DM + col0;
            if (MODE == 0) { if (m < 2) { pre[2 * m][0] = *(const u32x4*)(resf + off); pre[2 * m][1] = *(const u32x4*)(resf + off + 4); pre[2 * m + 1][0] = *(const u32x4*)(resf + off + HALF); pre[2 * m + 1][1] = *(const u32x4*)(resf + off + HALF + 4); } }
            else { pre[m][0] = *(const u32x4*)(AB + off); pre[m][1] = *(const u32x4*)(AB + off + HALF); } }
#pragma unroll
        for (int ai = 0; ai < 2; ++ai)
#pragma unroll
            for (int m = 0; m < 4; ++m) { float s = 0.f;
#pragma unroll
                for (int bj = 0; bj < 2; ++bj)
#pragma unroll
                    for (int n = 0; n < 2; ++n) { const f32x4 v = acc[ai][bj][m][n]; s += (v[0] * v[0] + v[1] * v[1]) + (v[2] * v[2] + v[3] * v[3]); }
                s += __shfl_xor(s, 16); s += __shfl_xor(s, 32);
                if (fq == 0) P[(ai * HALF + wr * 64 + m * 16 + fr) * 4 + wc] = s; }
        asm volatile("s_waitcnt lgkmcnt(0)" ::: "memory"); __builtin_amdgcn_s_barrier(); asm volatile("" ::: "memory");
        if (lane < 32) { const int row = wid * 32 + lane; const f32x4 p = *(const LAS f32x4*)(P + row * 4); const float tot = (p[0] + p[1]) + (p[2] + p[3]);
            unsigned long long* slot = xs + ((size_t)(u.pm * BM + row) * 4);
            __hip_atomic_store(slot + u.pn, ((unsigned long long)epoch << 32) | (unsigned long long)__float_as_uint(tot), __ATOMIC_RELAXED, __HIP_MEMORY_SCOPE_AGENT);
            float sum = 0.f; unsigned spins = 0;
            for (;;) { bool ok = true; float t = 0.f;
#pragma unroll
                for (int k = 0; k < 4; ++k) { const unsigned long long g = __hip_atomic_load(slot + k, __ATOMIC_RELAXED, __HIP_MEMORY_SCOPE_AGENT); ok = ok && ((unsigned)(g >> 32) == epoch); t += __uint_as_float((unsigned)g); }
                sum = t; if (ok || ++spins > (1u << 16)) break; __builtin_amdgcn_s_sleep(1); }
            S[row] = rsqrtf(sum * (1.f / DM) + EPS) * coef; }
        asm volatile("s_waitcnt vmcnt(0) lgkmcnt(0)" ::: "memory"); __builtin_amdgcn_s_barrier(); asm volatile("" ::: "memory");
#pragma unroll
        for (int ai = 0; ai < 2; ++ai)
#pragma unroll
            for (int m = 0; m < 4; ++m) { const int rl = ai * HALF + wr * 64 + m * 16 + fr; const size_t off = (size_t)(u.pm * BM + rl) * DM + col0; const float rs = S[rl]; float s2 = 0.f;
#pragma unroll
                for (int bj = 0; bj < 2; ++bj) { f32x4 r0, r1;
                    if (MODE == 0) { if (ai == 0 && m < 2) { r0 = __builtin_bit_cast(f32x4, pre[2 * m + bj][0]); r1 = __builtin_bit_cast(f32x4, pre[2 * m + bj][1]); }
                                     else { r0 = *(const f32x4*)(resf + off + bj * HALF); r1 = *(const f32x4*)(resf + off + bj * HALF + 4); } }
                    else { u32x4 w; if (ai == 0) w = pre[m][bj]; else w = *(const u32x4*)(AB + off + bj * HALF); r0 = (f32x4){bflo(w.x), bfhi(w.x), bflo(w.y), bfhi(w.y)}; r1 = (f32x4){bflo(w.z), bfhi(w.z), bflo(w.w), bfhi(w.w)}; }
                    const f32x4 h0 = r0 + acc[ai][bj][m][0] * rs * gv[bj][0], h1 = r1 + acc[ai][bj][m][1] * rs * gv[bj][1];
                    if (MODE == 2) { *(f32x4*)(outf + off + bj * HALF) = h0; *(f32x4*)(outf + off + bj * HALF + 4) = h1; }
                    else { u32x4 w; w.x = cvt_pk_bf16(h0[0], h0[1]); w.y = cvt_pk_bf16(h0[2], h0[3]); w.z = cvt_pk_bf16(h1[0], h1[1]); w.w = cvt_pk_bf16(h1[2], h1[3]); *(u32x4*)(AB + off + bj * HALF) = w;
                        s2 += (h0[0] * h0[0] + h0[1] * h0[1]) + (h0[2] * h0[2] + h0[3] * h0[3]) + (h1[0] * h1[0] + h1[1] * h1[1]) + (h1[2] * h1[2] + h1[3] * h1[3]); } }
                if (MODE != 2) { s2 += __shfl_xor(s2, 16); s2 += __shfl_xor(s2, 32); if (fq == 0) P[rl * 4 + wc] = s2; }
                if (m & 1) asm volatile("" ::: "memory"); }
        if (MODE != 2) {
            asm volatile("s_waitcnt lgkmcnt(0)" ::: "memory"); __builtin_amdgcn_s_barrier(); asm volatile("" ::: "memory");
            if (lane < 32) { const int row = wid * 32 + lane; const f32x4 p = *(const LAS f32x4*)(P + row * 4); rsq_out[(size_t)(u.pm * BM + row) * 4 + u.pn] = (p[0] + p[1]) + (p[2] + p[3]); }
        }
        asm volatile("s_waitcnt lgkmcnt(0)" ::: "memory"); __builtin_amdgcn_s_barrier(); asm volatile("" ::: "memory");
    }
};
}

struct Args {
    const float* in[25];
    float* out;
    unsigned char* ws;
};

__device__ __forceinline__ void p0_item(const float* W, int ldw, int k0, int n0, const float* gain, bf16_t* WT, int ldt, int drow0, LAS float* scr, int lane) {
    float v[32];
    const float* wp = W + (size_t)(k0 + (lane >> 5)) * ldw + n0 + (lane & 31);
#pragma unroll
    for (int i = 0; i < 32; ++i) v[i] = wp[(size_t)(2 * i) * ldw];
    const int c = lane & 7;
    f32x4 g0 = (f32x4){1.f, 1.f, 1.f, 1.f}, g1 = g0;
    if (gain) { g0 = *(const f32x4*)(gain + k0 + 8 * c); g1 = *(const f32x4*)(gain + k0 + 8 * c + 4); }
#pragma unroll
    for (int i = 0; i < 32; ++i) scr[(2 * i + (lane >> 5)) * 33 + (lane & 31)] = v[i];
    asm volatile("s_waitcnt lgkmcnt(0)" ::: "memory");
#pragma unroll
    for (int j = 0; j < 4; ++j) { const int n = (lane >> 3) + 8 * j; const LAS float* s = scr + (8 * c) * 33 + n;
        u32x4 o; o.x = cvt_pk_bf16(s[0 * 33] * g0[0], s[1 * 33] * g0[1]); o.y = cvt_pk_bf16(s[2 * 33] * g0[2], s[3 * 33] * g0[3]); o.z = cvt_pk_bf16(s[4 * 33] * g1[0], s[5 * 33] * g1[1]); o.w = cvt_pk_bf16(s[6 * 33] * g1[2], s[7 * 33] * g1[3]);
        *(u32x4*)(WT + (size_t)(drow0 + n) * ldt + k0 + 8 * c) = o; }
    asm volatile("s_waitcnt lgkmcnt(0)" ::: "memory");
}
template <int MAP>
__device__ __forceinline__ bool p0_job(int& r, const float* W, int ldw, int Ksrc, int Nsrc, const float* gain, bf16_t* WT, int ldt, int rowbase, LAS float* scr, int lane) {
    const int nblk = Nsrc / 32, items = (Ksrc / 64) * nblk;
    if (r >= items) { r -= items; return false; }
    const int kb = r / nblk, nb = r % nblk, n0 = nb * 32;
    int drow0 = rowbase + n0;
    if (MAP == 1 || MAP == 3) drow0 = rowbase + (n0 / 128) * 256 + (n0 % 128);
    if (MAP == 2) drow0 = rowbase + (n0 / 128) * 256 + 128 + (n0 % 128);
    p0_item(W, ldw, kb * 64, n0, gain, WT, ldt, drow0, scr, lane);
    return true;
}

__device__ __forceinline__ int t5_bucket(int dist) {
    if (dist < 16) return dist;
    const double v = log((double)dist / 16.0) / log(128.0) * 16.0;
    const int b = 16 + (int)v; return b < 31 ? b : 31;
}

template <bool RES_F32, bool OUT_F32>
__device__ __forceinline__ void norm_pass(const bf16_t* Fb, bf16_t* AB, const float* resf, const float* gpost, float coef, float* outf, float* rsq_out, int gw, int NGW, int lane) {
    for (int row = gw; row < M; row += NGW) {
        const bf16_t* fr_ = Fb + (size_t)row * DM; float fv[2][8]; float rv[2][8]; float s = 0.f;
#pragma unroll
        for (int j = 0; j < 2; ++j) { const int c = 8 * lane + 512 * j; const u32x4 w = *(const u32x4*)(fr_ + c);
            fv[j][0] = bflo(w.x); fv[j][1] = bfhi(w.x); fv[j][2] = bflo(w.y); fv[j][3] = bfhi(w.y); fv[j][4] = bflo(w.z); fv[j][5] = bfhi(w.z); fv[j][6] = bflo(w.w); fv[j][7] = bfhi(w.w);
            if (RES_F32) { const f32x4 r0 = *(const f32x4*)(resf + (size_t)row * DM + c), r1 = *(const f32x4*)(resf + (size_t)row * DM + c + 4);
#pragma unroll
                for (int i = 0; i < 4; ++i) { rv[j][i] = r0[i]; rv[j][4 + i] = r1[i]; } }
            else { const u32x4 r = *(const u32x4*)(AB + (size_t)row * DM + c);
                rv[j][0] = bflo(r.x); rv[j][1] = bfhi(r.x); rv[j][2] = bflo(r.y); rv[j][3] = bfhi(r.y); rv[j][4] = bflo(r.z); rv[j][5] = bfhi(r.z); rv[j][6] = bflo(r.w); rv[j][7] = bfhi(r.w); }
#pragma unroll
            for (int i = 0; i < 8; ++i) s += fv[j][i] * fv[j][i]; }
        s = wave_sum(s);
        const float rs = rsqrtf(s * (1.f / DM) + EPS) * coef; float s2 = 0.f;
#pragma unroll
        for (int j = 0; j < 2; ++j) { const int c = 8 * lane + 512 * j;
            const f32x4 g0 = *(const f32x4*)(gpost + c), g1 = *(const f32x4*)(gpost + c + 4);
            f32x4 o0, o1;
#pragma unroll
            for (int i = 0; i < 4; ++i) { o0[i] = rv[j][i] + fv[j][i] * rs * g0[i]; o1[i] = rv[j][4 + i] + fv[j][4 + i] * rs * g1[i]; s2 += o0[i] * o0[i] + o1[i] * o1[i]; }
            if (OUT_F32) { *(f32x4*)(outf + (size_t)row * DM + c) = o0; *(f32x4*)(outf + (size_t)row * DM + c + 4) = o1; }
            else { u32x4 w; w.x = cvt_pk_bf16(o0[0], o0[1]); w.y = cvt_pk_bf16(o0[2], o0[3]); w.z = cvt_pk_bf16(o1[0], o1[1]); w.w = cvt_pk_bf16(o1[2], o1[3]); *(u32x4*)(AB + (size_t)row * DM + c) = w; } }
        if (!OUT_F32) { s2 = wave_sum(s2); if (lane == 0) *(f32x4*)(rsq_out + 4 * (size_t)row) = (f32x4){s2, 0.f, 0.f, 0.f}; }
    }
}

#define XB_TMO      128
#define XB_XCNT(j)  (256  + 64 * (j))
#define XB_XSUB(j)  (1280 + 64 * (j))
#define XB_XGEN(j)  (2304 + 64 * (j))
#define XB_TOP      3328
#define XB_TOPGEN   3392
#define XCD_BAR_WORDS 3456
#define XB_SPIN_CAP (1u << 18)

__device__ __forceinline__ unsigned xb_ld(unsigned* p)              { return __hip_atomic_load(p, __ATOMIC_RELAXED, __HIP_MEMORY_SCOPE_AGENT); }
__device__ __forceinline__ unsigned xb_add(unsigned* p, unsigned v) { return __hip_atomic_fetch_add(p, v, __ATOMIC_RELAXED, __HIP_MEMORY_SCOPE_AGENT); }
__device__ __forceinline__ unsigned xb_xcc_id() { return (unsigned)__builtin_amdgcn_s_getreg((3 << 11) | 20) & 0xFu; }
#define XB_SPIN(cond, bar) do { unsigned _sp = 0; while (cond) { __builtin_amdgcn_s_sleep(1); \
    if ((++_sp & 255u) == 0u) { if (xb_ld(&(bar)[XB_TMO])) break; if (_sp > XB_SPIN_CAP) { atomicAdd(&(bar)[XB_TMO], 1u); break; } } } } while (0)

struct XcdBarrier {
    unsigned* bar; unsigned x;
    volatile LAS unsigned* st;
};

__device__ __forceinline__ XcdBarrier xcd_barrier_post(unsigned* bar, volatile LAS unsigned* st) {
    XcdBarrier b; b.bar = bar; b.x = xb_xcc_id(); b.st = st;
    if (threadIdx.x == 0) (void)xb_add(&bar[XB_XCNT(b.x)], 1u);
    return b;
}
__device__ __forceinline__ void xcd_barrier_complete(unsigned* bar, unsigned x, unsigned& nloc, unsigned& nx) {
    const unsigned G = gridDim.x * gridDim.y * gridDim.z;
    unsigned sum, cnt, mine, sp = 0u;
    for (;;) {
        sum = 0u; cnt = 0u; mine = 0u;
#pragma unroll
        for (unsigned j = 0; j < 16; ++j) { const unsigned c = xb_ld(&bar[XB_XCNT(j)]); sum += c; cnt += (c > 0u) ? 1u : 0u; mine = (j == x) ? c : mine; }
        if (sum == G) break;
        __builtin_amdgcn_s_sleep(1);
        if ((++sp & 255u) == 0u) { if (xb_ld(&bar[XB_TMO])) break; if (sp > XB_SPIN_CAP) { atomicAdd(&bar[XB_TMO], 1u); break; } }
    }
    nloc = mine > 0u ? mine : 1u; nx = cnt > 0u ? cnt : 1u;
}

__device__ __forceinline__ void xcd_barrier(const XcdBarrier& b) {
    asm volatile("s_waitcnt vmcnt(0)" ::: "memory");
    __syncthreads();
    if (threadIdx.x == 0) {
        unsigned* bar = b.bar;
        __builtin_amdgcn_s_waitcnt(0);
        unsigned nloc = b.st[0], nx = b.st[1];
        if (nloc == 0u) { xcd_barrier_complete(bar, b.x, nloc, nx); b.st[0] = nloc; b.st[1] = nx; }
        const unsigned old = xb_add(&bar[XB_XSUB(b.x)], 1u);
        const unsigned gen = old / nloc;
        if (old + 1u == (gen + 1u) * nloc) {
            __builtin_amdgcn_fence(__ATOMIC_RELEASE, "agent");
            asm volatile("s_waitcnt vmcnt(0)" ::: "memory");
            const unsigned og = xb_add(&bar[XB_TOP], 1u);
            const unsigned tg = og / nx;
            if (og + 1u == (tg + 1u) * nx) xb_add(&bar[XB_TOPGEN], 1u);
            else XB_SPIN(xb_ld(&bar[XB_TOPGEN]) == tg, bar);
            __builtin_amdgcn_fence(__ATOMIC_ACQUIRE, "agent");
            xb_add(&bar[XB_XGEN(b.x)], 1u);
            asm volatile("s_waitcnt vmcnt(0)" ::: "memory");
        } else {
            XB_SPIN(xb_ld(&bar[XB_XGEN(b.x)]) == gen, bar);
            __builtin_amdgcn_fence(__ATOMIC_ACQUIRE, "agent");
            asm volatile("s_waitcnt vmcnt(0)" ::: "memory");
        }
    }
    __syncthreads();
}


constexpr int LDS_BYTES = 144 * 1024;
constexpr int BAR_LDS_OFF = 128 * 1024 + 256;
constexpr int NORM_LDS_OFF = 128 * 1024 + 1024;
constexpr int VSTRIDE = 320;
constexpr int ATT_V_BYTES = 32 * VSTRIDE;
constexpr int ATT_BIAS_OFF = NWAVES * ATT_V_BYTES;

#define P_x INP(0)
#define P_n1pre INP(1)
#define P_n1post INP(2)
#define P_w1g INP(3)
#define P_w1u INP(4)
#define P_w1d INP(5)
#define P_mpre INP(6)
#define P_mpost INP(7)
#define P_win INP(8)
#define P_btab INP(9)
#define P_cw INP(10)
#define P_cb INP(11)
#define P_wx INP(12)
#define P_bxp INP(13)
#define P_wa INP(14)
#define P_bap INP(15)
#define P_app INP(16)
#define P_wab INP(17)
#define P_wrb INP(18)
#define P_wout INP(19)
#define P_n2pre INP(20)
#define P_n2post INP(21)
#define P_w2g INP(22)
#define P_w2u INP(23)
#define P_w2d INP(24)
#define P_XS WSP(unsigned long long, WS_XS)
#define P_RSQ0 WSP(float, WS_RSQ0)
#define P_RSQ1 WSP(float, WS_RSQ1)
#define P_RSQ2 WSP(float, WS_RSQ2)
#define P_WGU1 WSP(bf16_t, WS_WGU1)
#define P_WD1 WSP(bf16_t, WS_WD1)
#define P_WIN WSP(bf16_t, WS_WIN)
#define P_WLRU WSP(bf16_t, WS_WLRU)
#define P_WAB WSP(bf16_t, WS_WAB)
#define P_WRB WSP(bf16_t, WS_WRB)
#define P_WOUT WSP(bf16_t, WS_WOUT)
#define P_WGU2 WSP(bf16_t, WS_WGU2)
#define P_WD2 WSP(bf16_t, WS_WD2)
#define P_AB WSP(bf16_t, WS_AB)
#define P_Qb WSP(bf16_t, WS_Q)
#define P_Kb WSP(bf16_t, WS_K)
#define P_Vb WSP(bf16_t, WS_V)
#define P_OG WSP(bf16_t, WS_OG)
#define P_HID WSP(bf16_t, WS_HID)
#define P_Fb WSP(bf16_t, WS_F)
#define P_XR WSP(bf16_t, WS_XR)
#define P_YG WSP(bf16_t, WS_YG)
#define P_GT WSP(bf16_t, WS_GT)
#define P_ATT WSP(bf16_t, WS_ATT)
#define P_XC ((bf16_t*)(KARGS()->out))
#define P_LA WSP(bf16_t, WS_LA)
#define P_BB WSP(bf16_t, WS_BB)
#define P_REC ((bf16_t*)((unsigned char*)(KARGS()->out) + 64 * MiB))
#define P_MG WSP(bf16_t, WS_MG)
#define P_LSE WSP(float, WS_LSE)
#define P_CA WSP(float, WS_CA)
#define P_CH WSP(float, WS_CH)
#define P_out (KARGS()->out)
template <int VAR>
__device__ __forceinline__ void attn_phase(LAS unsigned char* lds, const float* btab_, const bf16_t* Qb_, const bf16_t* Kb_, const bf16_t* Vb_, bf16_t* OG_, float* LSE_, int tid, int lane, int wave, int vcu, int G) {
        LAS float* biasL = (LAS float*)(lds + ATT_BIAS_OFF);
        for (int i = tid; i < NH * 129; i += NTHREADS) { const int head = i / 129, st = i % 129, g_ = head >> 2; const int dil = g_ == 0 ? 1 : (g_ == 1 ? 4 : 16);
            biasL[head * 132 + st] = btab_[t5_bucket(st * dil) * NH + head] * LOG2E; }
        __syncthreads();
        LAS unsigned char* vl = lds + wave * ATT_V_BYTES;
        const int qq = lane & 31, hh2 = lane >> 5;
        const int tr_off = ((lane >> 4) >> 1) * 4 * VSTRIDE + (((lane & 15) >> 2)) * VSTRIDE + ((lane >> 4) & 1) * 32 + (lane & 3) * 8;
        for (int wu = vcu; wu < 1536; wu += G) {
            const int b = wu / 384, rem = wu % 384, head = rem >> 5, rem2 = rem & 31;
            const int g_ = head >> 2, hh = head & 3, dsh = 2 * g_;
            const int per = 32 >> dsh;
            const int p = rem2 / per, ub = rem2 % per;
            const int u0 = ub * 256 + wave * 32;
            const size_t rowb = (size_t)b * SEQ + p;
            const bf16_t* Qh = Qb_ + head * HD; const bf16_t* Kh = Kb_ + head * HD; const bf16_t* Vh = Vb_ + head * HD;
            bf16x8 Qf[8];
            { const bf16_t* qp = Qh + (rowb + ((size_t)(u0 + qq) << dsh)) * QW + hh2 * 8;
#pragma unroll
              for (int ks = 0; ks < 8; ++ks) Qf[ks] = *(const bf16x8*)(qp + ks * 16); }
            f32x16 O[4];
#pragma unroll
            for (int db = 0; db < 4; ++db)
#pragma unroll
                for (int i = 0; i < 16; ++i) O[db][i] = 0.f;
            float mrun = -INFINITY, lsum = 0.f;
            const int jstart = (u0 >= 128) ? 0 : (4 - (u0 >> 5));
            bf16x8 Kf[8]; u32x4 vst[8];
            const LAS float* bh = biasL + head * 132;
#define ATT_LOADK(jj) do { const bf16_t* kp = Kh + (rowb + ((size_t)(u0 - 128 + 32 * (jj) + qq) << dsh)) * QW + hh2 * 8; \
    _Pragma("unroll") for (int ks = 0; ks < 8; ++ks) Kf[ks] = *(const bf16x8*)(kp + ks * 16); } while (0)
#define ATT_LOADV(jj) do { _Pragma("unroll") for (int i = 0; i < 8; ++i) { const int rowi = i * 4 + (lane >> 4); \
    vst[i] = *(const u32x4*)(Vh + (rowb + ((size_t)(u0 - 128 + 32 * (jj) + rowi) << dsh)) * QW + (lane & 15) * 8); } } while (0)
            if (!(VAR & 1)) ATT_LOADK(jstart); else { _Pragma("unroll") for (int ks = 0; ks < 8; ++ks) Kf[ks] = Qf[ks]; }
            if (!(VAR & 2)) ATT_LOADV(jstart); else { _Pragma("unroll") for (int i = 0; i < 8; ++i) vst[i] = (u32x4){0x3c003c00u, 0x3c003c00u, 0x3c003c00u, 0x3c003c00u}; }
            for (int j = jstart; j < 5; ++j) {
#pragma unroll
                for (int i = 0; i < 8; ++i) { const int rowi = i * 4 + (lane >> 4); *(LAS u32x4*)(vl + rowi * VSTRIDE + (lane & 15) * 16) = vst[i]; }
                if (j < 4 && !(VAR & 2)) ATT_LOADV(j + 1);
                f32x16 Sx;
#pragma unroll
                for (int i = 0; i < 16; ++i) Sx[i] = 0.f;
#pragma unroll
                for (int ks = 0; ks < 8; ++ks) Sx = __builtin_amdgcn_mfma_f32_32x32x16_bf16(Kf[ks], Qf[ks], Sx, 0, 0, 0);
                if (j < 4 && !(VAR & 1)) ATT_LOADK(j + 1);
                float mx = -INFINITY;
                {
                    const int stb = 128 - 32 * j + qq - 4 * hh2;
#pragma unroll
                    for (int hf = 0; hf < 2; ++hf) {
                        float bv[8];
#pragma unroll
                        for (int e = 0; e < 8; ++e) { const int i = 8 * hf + e; int st = stb - ((i & 3) + 8 * (i >> 2)); st = st < 0 ? 0 : (st > 128 ? 128 : st); bv[e] = bh[st]; }
                        if (j == 0 || j == 4) {
#pragma unroll
                            for (int e = 0; e < 8; ++e) { const int i = 8 * hf + e; const int st = stb - ((i & 3) + 8 * (i >> 2)); const bool ok = (st >= 0) && (st <= 128);
                                const float sc = ok ? Sx[i] + bv[e] : -INFINITY; Sx[i] = sc; mx = fmaxf(mx, sc); }
                        } else {
#pragma unroll
                            for (int e = 0; e < 8; ++e) { const int i = 8 * hf + e; const float sc = Sx[i] + bv[e]; Sx[i] = sc; mx = fmaxf(mx, sc); }
                        }
                        asm volatile("" ::: "memory");
                    }
                }
                mx = fmaxf(mx, __shfl_xor(mx, 32));
                if (j == jstart) mrun = mx;
                else if (__any(mx > mrun + 8.0f)) {
                    const float mnew = fmaxf(mrun, mx); const float alpha = __builtin_amdgcn_exp2f(mrun - mnew); mrun = mnew; lsum *= alpha;
#pragma unroll
                    for (int db = 0; db < 4; ++db)
#pragma unroll
                        for (int i = 0; i < 16; ++i) O[db][i] *= alpha;
                }
                float ps = 0.f;
#pragma unroll
                for (int i = 0; i < 16; ++i) { const float pv = __builtin_amdgcn_exp2f(Sx[i] - mrun); Sx[i] = pv; ps += pv; }
                lsum += ps;
                bf16x8 Pf[2];
#pragma unroll
                for (int s = 0; s < 2; ++s) { u32x4 w; w.x = cvt_pk_bf16(Sx[8 * s + 0], Sx[8 * s + 1]); w.y = cvt_pk_bf16(Sx[8 * s + 2], Sx[8 * s + 3]); w.z = cvt_pk_bf16(Sx[8 * s + 4], Sx[8 * s + 5]); w.w = cvt_pk_bf16(Sx[8 * s + 6], Sx[8 * s + 7]);
                    Pf[s] = __builtin_bit_cast(bf16x8, w); }
                asm volatile("s_waitcnt lgkmcnt(0)" ::: "memory");
                if (VAR & 4) { asm volatile("" :: "v"(Pf[0]), "v"(Pf[1])); } else
#pragma unroll
                for (int db = 0; db < 4; ++db)
#pragma unroll
                    for (int s = 0; s < 2; ++s) {
                        const LAS unsigned char* ap_ = vl + tr_off + (16 * s) * VSTRIDE + 64 * db;
                        const s16x4 lo = __builtin_bit_cast(s16x4, __builtin_amdgcn_ds_read_tr16_b64_v4i16((LAS s16x4*)ap_));
                        const s16x4 hi = __builtin_bit_cast(s16x4, __builtin_amdgcn_ds_read_tr16_b64_v4i16((LAS s16x4*)(ap_ + 8 * VSTRIDE)));
                        const bf16x8 Vf = (bf16x8){lo[0], lo[1], lo[2], lo[3], hi[0], hi[1], hi[2], hi[3]};
                        O[db] = __builtin_amdgcn_mfma_f32_32x32x16_bf16(Vf, Pf[s], O[db], 0, 0, 0);
                    }
                asm volatile("s_waitcnt lgkmcnt(0)" ::: "memory");
            }
#undef ATT_LOADK
#undef ATT_LOADV
            lsum += __shfl_xor(lsum, 32);
            const float inv = 1.f / lsum;
#pragma unroll
            for (int db = 0; db < 4; ++db)
#pragma unroll
                for (int a = 0; a < 4; ++a) { u32x2 w; w.x = cvt_pk_bf16(O[db][4 * a] * inv, O[db][4 * a + 1] * inv); w.y = cvt_pk_bf16(O[db][4 * a + 2] * inv, O[db][4 * a + 3] * inv);
                    *(LAS u32x2*)(vl + qq * VSTRIDE + (32 * db + 8 * a + 4 * hh2) * 2) = w; }
            asm volatile("s_waitcnt lgkmcnt(0)" ::: "memory");
            bf16_t* og = OG_ + (size_t)g_ * M * 512 + hh * HD;
#pragma unroll
            for (int i = 0; i < 8; ++i) { const int rowi = i * 4 + (lane >> 4); const u32x4 v = *(const LAS u32x4*)(vl + rowi * VSTRIDE + (lane & 15) * 16);
                *(u32x4*)(og + (rowb + ((size_t)(u0 + rowi) << dsh)) * 512 + (lane & 15) * 8) = v; }
            if (hh2 == 0) LSE_[((size_t)g_ * M + rowb + ((size_t)(u0 + qq) << dsh)) * 4 + hh] = mrun + __builtin_amdgcn_logf(lsum);
            asm volatile("s_waitcnt lgkmcnt(0)" ::: "memory");
        }
    }

__global__ void __launch_bounds__(NTHREADS, 2) mk_fwd(Args args) {
    extern __shared__ __attribute__((aligned(16))) unsigned char lds_raw[];
    LAS unsigned char* lds = (LAS unsigned char*)lds_raw;
    cg::grid_group grid = cg::this_grid();
#define KARGS_EARLY() ({ const Args __attribute__((address_space(4)))* p_ = (const Args __attribute__((address_space(4)))*)__builtin_amdgcn_kernarg_segment_ptr(); p_; })
    volatile LAS unsigned* bst = (volatile LAS unsigned*)(lds + BAR_LDS_OFF);
    if (threadIdx.x < 2) bst[threadIdx.x] = 0u;
    __syncthreads();
    (void)xcd_barrier_post((unsigned*)(KARGS_EARLY()->ws), bst);
#define GRID_BAR() do { XcdBarrier b_; b_.bar = (unsigned*)(KARGS()->ws); b_.x = xb_xcc_id(); b_.st = (volatile LAS unsigned*)(lds + BAR_LDS_OFF); xcd_barrier(b_); } while (0)
    const int G = gridDim.x, bx = blockIdx.x;
#define PHASE_IDS() int tid = threadIdx.x; asm volatile("" : "+v"(tid)); const int lane = tid & 63, wave = __builtin_amdgcn_readfirstlane(tid >> 6); \
    const int vcu = (G % 8 == 0) ? (bx % 8) * (G / 8) + bx / 8 : bx; const int gw = vcu * NWAVES + wave, NGW = G * NWAVES; (void)lane; (void)gw; (void)NGW; (void)vcu;
typedef const Args __attribute__((address_space(4)))* kargs_ptr_t;
#define KARGS() ({ kargs_ptr_t p_ = (kargs_ptr_t)__builtin_amdgcn_kernarg_segment_ptr(); asm volatile("" : "+s"(p_)); p_; })
#define INP(i) (KARGS()->in[i])
#define WSP(T, off) ((T*)(KARGS()->ws + (off)))
    for (int rep_ = 0; rep_ < 1 + DUP(0); ++rep_) if (PH(0)) { PHASE_IDS();
        LAS float* scr = (LAS float*)(lds + wave * 16384);
        constexpr int I_GU = 16 * 88, I_D = 44 * 32, I_IN = 16 * 272, I_L = 4 * 8, I_AB = 8 * 32, I_SQ = 16 * 32;
        constexpr int NITEMS = 6 * I_GU   + I_IN + 8 * I_L + I_AB + 2 * I_SQ;
        static_assert(I_D == I_GU, "item counts");
        for (int it = gw; it < NITEMS; it += NGW) {
            int r = it;
            if (p0_job<1>(r, P_w1g, FF, DM, FF, P_n1pre, P_WGU1, DM, 0, scr, lane)) continue;
            if (p0_job<2>(r, P_w1u, FF, DM, FF, P_n1pre, P_WGU1, DM, 0, scr, lane)) continue;
            if (p0_job<0>(r, P_w1d, DM, FF, DM, nullptr, P_WD1, FF, 0, scr, lane)) continue;
            if (p0_job<0>(r, P_win, WINC, DM, WINC, P_mpre, P_WIN, DM, 0, scr, lane)) continue;
            bool done = false;
#pragma unroll 1
            for (int h = 0; h < 4 && !done; ++h) {
                if (p0_job<1>(r, P_wx + (size_t)h * 65536, 256, 256, 256, nullptr, P_WLRU, 256, h * 512, scr, lane)) { done = true; break; }
                if (p0_job<2>(r, P_wa + (size_t)h * 65536, 256, 256, 256, nullptr, P_WLRU, 256, h * 512, scr, lane)) { done = true; break; }
            }
            if (done) continue;
            if (p0_job<0>(r, P_wab, DM, 512, DM, nullptr, P_WAB, 512, 0, scr, lane)) continue;
            if (p0_job<0>(r, P_wrb, DM, DM, DM, nullptr, P_WRB, DM, 0, scr, lane)) continue;
            if (p0_job<0>(r, P_wout, DM, DM, DM, nullptr, P_WOUT, DM, 0, scr, lane)) continue;
            if (p0_job<1>(r, P_w2g, FF, DM, FF, P_n2pre, P_WGU2, DM, 0, scr, lane)) continue;
            if (p0_job<2>(r, P_w2u, FF, DM, FF, P_n2pre, P_WGU2, DM, 0, scr, lane)) continue;
            p0_job<0>(r, P_w2d, DM, FF, DM, nullptr, P_WD2, FF, 0, scr, lane);
        }
        { const float* x_ = P_x; bf16_t* AB_ = P_AB; float* RSQ0_ = P_RSQ0;
        for (int row0 = gw; row0 < M; row0 += 4 * NGW) {
            f32x4 a[4][2][2];
#pragma unroll
            for (int q = 0; q < 4; ++q)
#pragma unroll
                for (int j = 0; j < 2; ++j) { const float* xr = x_ + (size_t)(row0 + q * NGW) * DM + 8 * lane + 512 * j; a[q][j][0] = *(const f32x4*)xr; a[q][j][1] = *(const f32x4*)(xr + 4); }
#pragma unroll
            for (int q = 0; q < 4; ++q) { const int row = row0 + q * NGW; float s = 0.f;
#pragma unroll
                for (int j = 0; j < 2; ++j) { const f32x4 u = a[q][j][0], v = a[q][j][1];
                    s += (u[0] * u[0] + u[1] * u[1]) + (u[2] * u[2] + u[3] * u[3]) + (v[0] * v[0] + v[1] * v[1]) + (v[2] * v[2] + v[3] * v[3]);
                    u32x4 w; w.x = cvt_pk_bf16(u[0], u[1]); w.y = cvt_pk_bf16(u[2], u[3]); w.z = cvt_pk_bf16(v[0], v[1]); w.w = cvt_pk_bf16(v[2], v[3]);
                    *(u32x4*)(AB_ + (size_t)row * DM + 8 * lane + 512 * j) = w; }
                s = wave_sum(s); if (lane == 0) *(f32x4*)(RSQ0_ + 4 * (size_t)row) = (f32x4){s, 0.f, 0.f, 0.f}; }
        } }
    }
    grid.sync();

    pg8::StaticOrder SO;
    for (int rep_ = 0; rep_ < 1 + DUP(1); ++rep_) if (PH(1)) { pg8::Gemm g{P_AB, DM, P_WGU1, DM, M, 2 * FF, DM, 0, KREP_G1, EREP_G1}; SO.init(M, 2 * FF, G, bx); pg8::EpiSwiGLU E{P_HID, FF, P_RSQ0}; pg8::gemm_phase(lds, g, SO, E); }
    GRID_BAR();
    for (int rep_ = 0; rep_ < 1 + DUP(2); ++rep_) if (PH(2)) { pg8::Gemm g{P_HID, FF, P_WD1, FF, M, DM, FF, 0}; SO.init(M, DM, G, bx);
        if (FUSED_NORM) { pg8::EpiNormRes<0> E{P_x, P_AB, nullptr, P_n1post, 0.5f, P_XS, 1u, P_RSQ1, lds + NORM_LDS_OFF}; pg8::gemm_phase(lds, g, SO, E); }
        else { pg8::EpiBf16 E{P_Fb, DM}; pg8::gemm_phase(lds, g, SO, E); } }
    if (!FUSED_NORM) GRID_BAR();
    for (int rep_ = 0; rep_ < 1 + DUP(3); ++rep_) if (PH(3) && !FUSED_NORM) { PHASE_IDS(); norm_pass<true, false>(P_Fb, P_AB, P_x, P_n1post, 0.5f, nullptr, P_RSQ1, gw, NGW, lane); }
    GRID_BAR();
    for (int rep_ = 0; rep_ < 1 + DUP(4); ++rep_) if (PH(4)) { pg8::Gemm g{P_AB, DM, P_WIN, DM, M, 3 * QW, DM, 0, 1, EREP_G3A}; SO.init(M, 3 * QW, G, bx); pg8::EpiProj<0> E{P_Qb, (size_t)(WS_K - WS_Q) / 2, P_RSQ1}; pg8::gemm_phase(lds, g, SO, E); }
    GRID_BAR();
    for (int rep_ = 0; rep_ < 1 + DUP(5); ++rep_) if (PH(5)) { PHASE_IDS();
        attn_phase<0>(lds, P_btab, P_Qb, P_Kb, P_Vb, P_OG, P_LSE, tid, lane, wave, vcu, G);
        if (ATTN_PROBE) attn_phase<ATTN_PROBE>(lds, P_btab, P_Qb, P_Kb, P_Vb, (bf16_t*)(KARGS()->out), (float*)((unsigned char*)(KARGS()->out) + 96 * MiB), tid, lane, wave, vcu, G);
    }
    GRID_BAR();
    for (int rep_ = 0; rep_ < 1 + DUP(6); ++rep_) if (PH(6)) { pg8::Gemm g{P_AB, DM, P_WIN + (size_t)3 * QW * DM, DM, M, 4 * DM, DM, 0}; SO.init(M, 4 * DM, G, bx); pg8::EpiProj<1> E{P_XR, (size_t)(WS_YG - WS_XR) / 2, P_RSQ1}; pg8::gemm_phase(lds, g, SO, E); }
    GRID_BAR();
    for (int rep_ = 0; rep_ < 1 + DUP(7); ++rep_) if (PH(7)) { PHASE_IDS();
        const float *cw_ = P_cw, *cb_ = P_cb; const bf16_t* XR_ = P_XR; bf16_t* XC_ = P_XC; const float* LSE_ = P_LSE; const bf16_t* OG_ = P_OG; bf16_t* ATT_ = P_ATT;
        for (int it = gw; it < (M / 32) * 2; it += NGW) {
            const int rb = it >> 1, c0 = (it & 1) * 512 + lane * 8, r0 = rb * 32, t0 = r0 % SEQ;
            float w[4][8], bias[8];
#pragma unroll
            for (int j = 0; j < 4; ++j)
#pragma unroll
                for (int i = 0; i < 8; ++i) w[j][i] = cw_[j * DM + c0 + i];
#pragma unroll
            for (int i = 0; i < 8; ++i) bias[i] = cb_[c0 + i];
            float xw[3][8];
#pragma unroll
            for (int j = 0; j < 3; ++j) { const int tt = t0 - 3 + j;
                u32x4 v = (u32x4){0u, 0u, 0u, 0u}; if (tt >= 0) v = *(const u32x4*)(XR_ + (size_t)(r0 - 3 + j) * DM + c0);
                xw[j][0] = bflo(v.x); xw[j][1] = bfhi(v.x); xw[j][2] = bflo(v.y); xw[j][3] = bfhi(v.y); xw[j][4] = bflo(v.z); xw[j][5] = bfhi(v.z); xw[j][6] = bflo(v.w); xw[j][7] = bfhi(v.w); }
#pragma unroll 4
            for (int t = 0; t < 32; ++t) { const u32x4 v = *(const u32x4*)(XR_ + (size_t)(r0 + t) * DM + c0);
                const float x3[8] = {bflo(v.x), bfhi(v.x), bflo(v.y), bfhi(v.y), bflo(v.z), bfhi(v.z), bflo(v.w), bfhi(v.w)}; float o[8];
#pragma unroll
                for (int i = 0; i < 8; ++i) { o[i] = bias[i] + w[0][i] * xw[0][i] + w[1][i] * xw[1][i] + w[2][i] * xw[2][i] + w[3][i] * x3[i]; xw[0][i] = xw[1][i]; xw[1][i] = xw[2][i]; xw[2][i] = x3[i]; }
                u32x4 ov; ov.x = cvt_pk_bf16(o[0], o[1]); ov.y = cvt_pk_bf16(o[2], o[3]); ov.z = cvt_pk_bf16(o[4], o[5]); ov.w = cvt_pk_bf16(o[6], o[7]);
                *(u32x4*)(XC_ + (size_t)(r0 + t) * DM + c0) = ov; }
        }
        for (int row = gw; row < M; row += NGW) {
            const int hh = lane >> 4;
            const float l0 = LSE_[((size_t)0 * M + row) * 4 + hh], l1 = LSE_[((size_t)1 * M + row) * 4 + hh], l2 = LSE_[((size_t)2 * M + row) * 4 + hh];
            const float mx = fmaxf(l0, fmaxf(l1, l2)); const float e0 = __builtin_amdgcn_exp2f(l0 - mx), e1 = __builtin_amdgcn_exp2f(l1 - mx), e2 = __builtin_amdgcn_exp2f(l2 - mx);
            const float inv = 1.f / (e0 + e1 + e2); const float a0 = e0 * inv, a1 = e1 * inv, a2 = e2 * inv;
            const u32x4 v0 = *(const u32x4*)(OG_ + ((size_t)0 * M + row) * 512 + lane * 8), v1 = *(const u32x4*)(OG_ + ((size_t)1 * M + row) * 512 + lane * 8), v2 = *(const u32x4*)(OG_ + ((size_t)2 * M + row) * 512 + lane * 8);
            u32x4 o;
            o.x = cvt_pk_bf16(a0 * bflo(v0.x) + a1 * bflo(v1.x) + a2 * bflo(v2.x), a0 * bfhi(v0.x) + a1 * bfhi(v1.x) + a2 * bfhi(v2.x));
            o.y = cvt_pk_bf16(a0 * bflo(v0.y) + a1 * bflo(v1.y) + a2 * bflo(v2.y), a0 * bfhi(v0.y) + a1 * bfhi(v1.y) + a2 * bfhi(v2.y));
            o.z = cvt_pk_bf16(a0 * bflo(v0.z) + a1 * bflo(v1.z) + a2 * bflo(v2.z), a0 * bfhi(v0.z) + a1 * bfhi(v1.z) + a2 * bfhi(v2.z));
            o.w = cvt_pk_bf16(a0 * bflo(v0.w) + a1 * bflo(v1.w) + a2 * bflo(v2.w), a0 * bfhi(v0.w) + a1 * bfhi(v1.w) + a2 * bfhi(v2.w));
            *(u32x4*)(ATT_ + (size_t)row * 512 + lane * 8) = o;
        }
    }
    GRID_BAR();
    for (int rep_ = 0; rep_ < 1 + DUP(8); ++rep_) if (PH(8)) { pg8::Gemm g{P_XC, DM, P_WLRU, 256, M, 2 * DM, 256, 1}; SO.init(M, 2 * DM, G, bx); pg8::EpiLru E{P_XC, P_bxp, P_bap, P_app, P_LA, P_BB}; pg8::gemm_phase(lds, g, SO, E); }
    GRID_BAR();
    for (int rep_ = 0; rep_ < 1 + DUP(9); ++rep_) if (PH(9)) { PHASE_IDS(); const bf16_t *LA_ = P_LA, *BB_ = P_BB; float *CA_ = P_CA, *CH_ = P_CH;
    for (int it = gw; it < BATCH * 128 * 4; it += NGW) {
        const int qd = it & 3, ck = (it >> 2) & 127, b = it >> 9; const int c0 = qd * 256 + lane * 4; const size_t r0 = (size_t)b * SEQ + ck * 64;
        float h[4] = {0.f, 0.f, 0.f, 0.f}, sl[4] = {0.f, 0.f, 0.f, 0.f};
#pragma unroll 8
        for (int t = 0; t < 64; ++t) { const u32x2 lw = *(const u32x2*)(LA_ + (r0 + t) * DM + c0), bw = *(const u32x2*)(BB_ + (r0 + t) * DM + c0);
            const float l[4] = {bflo(lw.x), bfhi(lw.x), bflo(lw.y), bfhi(lw.y)}, bv[4] = {bflo(bw.x), bfhi(bw.x), bflo(bw.y), bfhi(bw.y)};
#pragma unroll
            for (int i = 0; i < 4; ++i) { sl[i] += l[i]; h[i] = __builtin_amdgcn_exp2f(l[i] * LOG2E) * h[i] + bv[i]; } }
        *(f32x4*)(CA_ + ((size_t)(b * 128 + ck)) * DM + c0) = (f32x4){sl[0], sl[1], sl[2], sl[3]};
        *(f32x4*)(CH_ + ((size_t)(b * 128 + ck)) * DM + c0) = (f32x4){h[0], h[1], h[2], h[3]};
    } }
    GRID_BAR();
    for (int rep_ = 0; rep_ < 1 + DUP(10); ++rep_) if (PH(10)) { PHASE_IDS(); const bf16_t *LA_ = P_LA, *BB_ = P_BB, *YG_ = P_YG; const float *CA_ = P_CA, *CH_ = P_CH; bf16_t* REC_ = P_REC;
    for (int it = gw; it < BATCH * 128 * 4; it += NGW) {
        const int qd = it & 3, ck = (it >> 2) & 127, b = it >> 9; const int c0 = qd * 256 + lane * 4; const size_t r0 = (size_t)b * SEQ + ck * 64;
        float h[4] = {0.f, 0.f, 0.f, 0.f};
        for (int k = 0; k < ck; ++k) { const f32x4 a = *(const f32x4*)(CA_ + ((size_t)(b * 128 + k)) * DM + c0), hv = *(const f32x4*)(CH_ + ((size_t)(b * 128 + k)) * DM + c0);
#pragma unroll
            for (int i = 0; i < 4; ++i) h[i] = __builtin_amdgcn_exp2f(a[i] * LOG2E) * h[i] + hv[i]; }
#pragma unroll 8
        for (int t = 0; t < 64; ++t) { const u32x2 lw = *(const u32x2*)(LA_ + (r0 + t) * DM + c0), bw = *(const u32x2*)(BB_ + (r0 + t) * DM + c0), yw = *(const u32x2*)(YG_ + (r0 + t) * DM + c0);
            const float l[4] = {bflo(lw.x), bfhi(lw.x), bflo(lw.y), bfhi(lw.y)}, bv[4] = {bflo(bw.x), bfhi(bw.x), bflo(bw.y), bfhi(bw.y)}, yv[4] = {bflo(yw.x), bfhi(yw.x), bflo(yw.y), bfhi(yw.y)};
            float o[4];
#pragma unroll
            for (int i = 0; i < 4; ++i) { h[i] = __builtin_amdgcn_exp2f(l[i] * LOG2E) * h[i] + bv[i]; o[i] = h[i] * yv[i]; }
            u32x2 w; w.x = cvt_pk_bf16(o[0], o[1]); w.y = cvt_pk_bf16(o[2], o[3]); *(u32x2*)(REC_ + (r0 + t) * DM + c0) = w; }
    } }
    GRID_BAR();
    for (int rep_ = 0; rep_ < 1 + DUP(11); ++rep_) if (PH(11)) { pg8::Gemm g{P_ATT, 512, P_WAB, 512, M, DM, 512, 0}; SO.init(M, DM, G, bx); pg8::EpiGate E{0, P_GT, P_MG}; pg8::gemm_phase(lds, g, SO, E); }
    for (int rep_ = 0; rep_ < 1 + DUP(11); ++rep_) if (PH(11)) { pg8::Gemm g{P_REC, DM, P_WRB, DM, M, DM, DM, 0}; SO.init(M, DM, G, bx); pg8::EpiGate E{1, P_GT, P_MG}; pg8::gemm_phase(lds, g, SO, E); }
    GRID_BAR();
    for (int rep_ = 0; rep_ < 1 + DUP(12); ++rep_) if (PH(12)) { pg8::Gemm g{P_MG, DM, P_WOUT, DM, M, DM, DM, 0}; SO.init(M, DM, G, bx);
        if (FUSED_NORM) { pg8::EpiNormRes<1> E{nullptr, P_AB, nullptr, P_mpost, 1.0f, P_XS, 2u, P_RSQ2, lds + NORM_LDS_OFF}; pg8::gemm_phase(lds, g, SO, E); }
        else { pg8::EpiBf16 E{P_Fb, DM}; pg8::gemm_phase(lds, g, SO, E); } }
    if (!FUSED_NORM) GRID_BAR();
    for (int rep_ = 0; rep_ < 1 + DUP(13); ++rep_) if (PH(13) && !FUSED_NORM) { PHASE_IDS(); norm_pass<false, false>(P_Fb, P_AB, nullptr, P_mpost, 1.0f, nullptr, P_RSQ2, gw, NGW, lane); }
    GRID_BAR();
    for (int rep_ = 0; rep_ < 1 + DUP(14); ++rep_) if (PH(14)) { pg8::Gemm g{P_AB, DM, P_WGU2, DM, M, 2 * FF, DM, 0}; SO.init(M, 2 * FF, G, bx); pg8::EpiSwiGLU E{P_HID, FF, P_RSQ2}; pg8::gemm_phase(lds, g, SO, E); }
    GRID_BAR();
    for (int rep_ = 0; rep_ < 1 + DUP(15); ++rep_) if (PH(15)) { pg8::Gemm g{P_HID, FF, P_WD2, FF, M, DM, FF, 0}; SO.init(M, DM, G, bx);
        if (FUSED_NORM) { pg8::EpiNormRes<2> E{nullptr, P_AB, P_out, P_n2post, 0.5f, P_XS, 3u, nullptr, lds + NORM_LDS_OFF}; pg8::gemm_phase(lds, g, SO, E); }
        else { pg8::EpiBf16 E{P_Fb, DM}; pg8::gemm_phase(lds, g, SO, E); } }
    if (!FUSED_NORM) GRID_BAR();
    for (int rep_ = 0; rep_ < 1 + DUP(16); ++rep_) if (PH(16) && !FUSED_NORM) { PHASE_IDS(); norm_pass<false, true>(P_Fb, P_AB, nullptr, P_n2post, 0.5f, P_out, nullptr, gw, NGW, lane); }
}

extern "C" void kernel_launch(void* const* d_in, const int* in_sizes, int n_in, void* d_out, int out_size, void* d_ws, size_t ws_size, hipStream_t stream) {
    static int grid = 0;
    if (grid == 0) {
        if (n_in != 25 || out_size != M * DM || ws_size < WS_END) { fprintf(stderr, "kernel_launch: unexpected shapes (n_in %d out %d ws %zu)\n", n_in, out_size, ws_size); grid = -1; return; }
        int dev = 0, cus = 0, per_cu = 0;
        hipGetDevice(&dev); hipDeviceGetAttribute(&cus, hipDeviceAttributeMultiprocessorCount, dev);
        hipFuncSetAttribute((const void*)mk_fwd, hipFuncAttributeMaxDynamicSharedMemorySize, LDS_BYTES);
        hipOccupancyMaxActiveBlocksPerMultiprocessor(&per_cu, (const void*)mk_fwd, NTHREADS, LDS_BYTES);
        if (per_cu < 1) { fprintf(stderr, "kernel_launch: occupancy query says %d blocks per CU\n", per_cu); per_cu = 1; }
        grid = cus;
        fprintf(stderr, "kernel_launch: cus %d per_cu %d grid %d\n", cus, per_cu, grid);
    }
    if (grid < 0) return;
    if (hipMemsetAsync(d_ws, 0, 65536, stream) != hipSuccess) { fprintf(stderr, "kernel_launch: memset failed\n"); return; }
    Args a{};
    for (int i = 0; i < 25; ++i) a.in[i] = (const float*)d_in[i];
    a.out = (float*)d_out; a.ws = (unsigned char*)d_ws;
    void* kargs[] = {&a};
    hipError_t e = hipLaunchCooperativeKernel((const void*)mk_fwd, dim3(grid), dim3(NTHREADS), kargs, LDS_BYTES, stream);
    if (e != hipSuccess) fprintf(stderr, "cooperative launch failed: %s (grid %d)\n", hipGetErrorString(e), grid);
}
```

```cpp
#include <hip/hip_runtime.h>
#include <hip/hip_cooperative_groups.h>
#include <cstdio>
#include <cstdint>
#include <cmath>
namespace cg = cooperative_groups;

#define LAS __attribute__((address_space(3)))
typedef unsigned short bf16_t;
typedef short bf16x8 __attribute__((ext_vector_type(8)));
typedef float f32x4 __attribute__((ext_vector_type(4)));
typedef float f32x16 __attribute__((ext_vector_type(16)));
typedef unsigned u32x4 __attribute__((ext_vector_type(4)));
typedef unsigned u32x2 __attribute__((ext_vector_type(2)));
typedef short s16x4 __attribute__((ext_vector_type(4)));

#ifndef PHMASK
#define PHMASK 0x1FFFF
#endif
#define PH(n) ((PHMASK >> (n)) & 1)
#ifndef DUPMASK
#define DUPMASK 0
#endif
#define DUP(n) ((DUPMASK >> (n)) & 1)
#ifndef NTSTORE
#define NTSTORE 2
#endif
#ifndef NT_NORM
#define NT_NORM 0
#endif
#ifndef NT_LOADS
#define NT_LOADS 1
#endif
#define NTLD(p) (NT_LOADS ? __builtin_nontemporal_load(p) : *(p))
#ifndef NT_STORES
#define NT_STORES 1
#endif
#define NTST(p, v) do { if (NT_STORES) __builtin_nontemporal_store((v), (p)); else *(p) = (v); } while (0)
#define ST16_WT(p, v) asm volatile("global_store_dwordx4 %0, %1, off sc1\n\ts_nop 1" :: "v"(p), "v"(v) : "memory")
#define EPI_ST16(p, v) do { if (NTSTORE == 2) { asm volatile("global_store_dwordx4 %0, %1, off sc1\n\ts_nop 1" :: "v"((u32x4*)(p)), "v"(v) : "memory"); } else if (NTSTORE == 1) __builtin_nontemporal_store((v), (u32x4*)(p)); else *(u32x4*)(p) = (v); } while (0)
#ifndef EREP_G1
#define EREP_G1 1
#endif
#ifndef EREP_G3A
#define EREP_G3A 1
#endif
#ifndef BARSTAT
#define BARSTAT 0
#endif
#ifndef TS_MODE
#define TS_MODE 0
#define BAROFF 0
#define BARSCL 1
#define BARQ 0
#define AR_SKEW 0
#define AR_PRIO 0
#define SPLIT_P7 1
#define SPLIT_GG 1
#define SPLIT_LA 1
#define SPLIT_S3 1
#define SPLIT_GN 1
#define SPLIT_ATT 1
#define SPLIT_G3B 1
#define SPLIT_G4 1
#define SPLIT_P0 1
#define ZACC 3
#define STAG_G3A 0
#define AR_KPIN 0
#endif
#ifndef ATTN_RING
#define ATTN_RING 1
#endif
#ifndef RELAX_VM
#define RELAX_VM 1
#endif
#ifndef FUSED_NORM
#define FUSED_NORM 1
#endif
#ifndef ATTN_PROBE
#define ATTN_PROBE 0
#endif
#ifndef KREP_G1
#define KREP_G1 1
#endif

constexpr int BATCH = 4, SEQ = 8192, DM = 1024, M = BATCH * SEQ, FF = 2816, NH = 12, HD = 128, QW = 1536, WINC = 8704;
constexpr float EPS = 1e-6f;
constexpr float LOG2E = 1.4426950408889634f;
constexpr float C2 = 0.08838834764831845f * 1.4426950408889634f;
constexpr int NWAVES = 8, NTHREADS = 512;

constexpr size_t MiB = 1u << 20;
constexpr size_t WS_RSQ0 = 508 * MiB, WS_RSQ1 = WS_RSQ0 + 512 * 1024, WS_RSQ2 = WS_RSQ1 + 512 * 1024;
constexpr size_t WS_LC = 128 * 1024;
constexpr size_t WS_XS = 508 * MiB + 1536 * 1024;
constexpr size_t WS_WGU1 = 1 * MiB, WS_WD1 = 12 * MiB, WS_WIN = 18 * MiB, WS_WLRU = 35 * MiB, WS_WAB = 58 * MiB  , WS_WRB = 37 * MiB, WS_WOUT = 39 * MiB, WS_WGU2 = 41 * MiB, WS_WD2 = 52 * MiB;
constexpr size_t WS_LSE = 510 * MiB + 512 * 1024;
constexpr size_t WS_AB = 60 * MiB;
constexpr size_t WS_Q = 124 * MiB, WS_K = 220 * MiB, WS_V = 316 * MiB;
constexpr size_t WS_OG = 412 * MiB;
constexpr size_t WS_HID = 124 * MiB;
constexpr size_t WS_F = 300 * MiB;
constexpr size_t WS_XR = 124 * MiB, WS_YG = 188 * MiB, WS_GT = 252 * MiB, WS_ATT = 380 * MiB, WS_XC = 60 * MiB;
constexpr size_t WS_LA = 124 * MiB, WS_BB = 412 * MiB, WS_CA = 476 * MiB, WS_CH = 480 * MiB;
constexpr size_t WS_REC = 60 * MiB, WS_MG = 124 * MiB;
constexpr size_t WS_END = 512 * MiB;
static_assert(WS_V - WS_K == WS_K - WS_Q && WS_GT - WS_YG == WS_YG - WS_XR, "section strides");

__device__ __forceinline__ float bf2f(unsigned short h) { return __uint_as_float((unsigned)h << 16); }
__device__ __forceinline__ float bflo(unsigned w) { return __uint_as_float(w << 16); }
__device__ __forceinline__ float bfhi(unsigned w) { return __uint_as_float(w & 0xffff0000u); }
typedef float f32x2_t __attribute__((ext_vector_type(2))); typedef __bf16 bf16x2_t __attribute__((ext_vector_type(2)));
__device__ __forceinline__ unsigned cvt_pk_bf16(float lo, float hi) { const f32x2_t v = {lo, hi}; const bf16x2_t b = __builtin_convertvector(v, bf16x2_t); return __builtin_bit_cast(unsigned, b); }
__device__ __forceinline__ float wave_sum(float v) {
#pragma unroll
    for (int o = 1; o < 64; o <<= 1) v += __shfl_xor(v, o);
    return v;
}
__device__ __forceinline__ float fast_sigmoid(float x) { return __builtin_amdgcn_rcpf(1.f + __builtin_amdgcn_exp2f(-x * LOG2E)); }
__device__ __forceinline__ float gelu_tanh(float x) {
    const float u = 0.7978845608028654f * (x + 0.044715f * x * x * x);
    return x * fast_sigmoid(2.f * u);
}

__device__ __forceinline__ int lane_id_now() { unsigned z_ = 0u; asm volatile("" : "+s"(z_)); return (int)__builtin_amdgcn_mbcnt_hi(~0u, __builtin_amdgcn_mbcnt_lo(~0u, z_)); }
__device__ __forceinline__ void dbg_stamp(int idx) { const unsigned long long __attribute__((address_space(4)))* ka = (const unsigned long long __attribute__((address_space(4)))*)__builtin_amdgcn_kernarg_segment_ptr(); unsigned long long* p_ = (unsigned long long*)((unsigned char*)ka[26] + 201 * 1024); p_[idx] = __builtin_amdgcn_s_memrealtime(); }
__device__ __forceinline__ void sb_arrive_lead(unsigned* bar, volatile LAS unsigned* st, unsigned k);
__device__ __forceinline__ void sb_arrive_raw(unsigned* bar, volatile LAS unsigned* st, bool lead, unsigned k);
__device__ __forceinline__ void sb_wait_raw(unsigned* bar, volatile LAS unsigned* st, bool lead, unsigned k);
namespace pg8 {
constexpr int BM = 256, BK = 64, HALF = 128, HTB = HALF * BK * 2, STAGE_BYTES = 8 * HTB, NXCD = 8, WGM = 8;
__host__ __device__ __forceinline__ int lds_byte(int r, int c) { const int st = (r >> 4) * 2 + (c >> 5), rr = r & 15, cc = c & 31, ob = rr * 64 + cc * 2; return st * 1024 + (ob ^ (((ob >> 9) & 1) << 5)); }
__host__ __device__ __forceinline__ void stage_rc(int b, int& R, int& C) { const int st = b / 1024, sb = b % 1024, swz = sb ^ (((sb >> 9) & 1) << 5); R = (st >> 1) * 16 + swz / 64; C = (st & 1) * 32 + (swz % 64) / 2; }
__host__ __device__ __forceinline__ int perm32(int rho) { const int n = rho >> 4, i = rho & 15; return 8 * (i >> 2) + 4 * n + (i & 3); }

struct Unit { int pm, pn; };
struct Gemm { const bf16_t* A; int lda; const bf16_t* Bt; int ldb; int M, N, K; int amode; int krep = 1; int erep = 1;
              const bf16_t* A2 = nullptr; const bf16_t* Bt2 = nullptr; int ksw = 1 << 20; unsigned long long* ts = nullptr; int stag = 0;
              unsigned* sb_bar = nullptr; volatile LAS unsigned* sb_st = nullptr; int sb_mode = 0; unsigned sb_k = 0; int sb_u = 0; int arr_u = -1; unsigned arr_k = 0; int prep_split = 0; };

static_assert((M / 256) % 8 == 0, "StaticOrder::next assumes full row groups");
struct StaticOrder {
    int nM, nN, nwg, G, c; int wv;
    __device__ void init(int M_, int N_, int G_, int c_) { nM = M_ / BM; nN = N_ / BM; nwg = nM * nN; G = G_; c = c_; }
    __device__ bool next(int i, Unit& u) const {
        const long L = (long)i * G + c; if (L >= nwg) return false;
        int wgid = (int)L; { const int q = nwg / NXCD, r = nwg % NXCD, xcd = wgid % NXCD, off = wgid / NXCD; wgid = (xcd < r ? xcd * (q + 1) : r * (q + 1) + (xcd - r) * q) + off; }
        const int nig = WGM * nN, gid = wgid / nig, fm = gid * WGM;
        u.pm = fm + ((wgid % nig) % WGM); u.pn = (wgid % nig) / WGM; return true;
    }
};

template <class Epi>
__device__ __forceinline__ void gemm_phase(LAS unsigned char* lds, const Gemm g, const StaticOrder& S, const Epi& E) {
    int tid = S.wv * 64 + lane_id_now(); asm volatile("" : "+v"(tid));
    const int wid = __builtin_amdgcn_readfirstlane(tid >> 6), lane = tid & 63, wr = wid >> 2, wc = wid & 3, fr = lane & 15, fq = lane >> 4;
    const int K = g.K, nt = K / BK;
    unsigned voffA[2], voffB[2];
#pragma unroll
    for (int i = 0; i < 2; ++i) { int R, C; stage_rc(tid * 16 + i * 8192, R, C); const int Rb = (R & ~31) + perm32(R & 31);
        voffA[i] = (unsigned)(R * g.lda + C) * 2u; voffB[i] = (unsigned)(Rb * g.ldb + C) * 2u; }
    const size_t kstep = (size_t)(BK * 2);
    const size_t hstepA = (size_t)HALF * g.lda * 2, hstepB = (size_t)HALF * g.ldb * 2;
    const unsigned ldsw = (unsigned)wid * 1024u;
    const int aoff = lds_byte(wr * 64 + fr, fq * 8), boff = lds_byte(wc * 32 + fr, fq * 8);
#define PG8_SA(b, h) (((b) * 2 + (h)) * HTB)
#define PG8_SB(b, h) ((4 + (b) * 2 + (h)) * HTB)
#define PG8_STAGE(bufoff, gbase, voff) do { _Pragma("unroll") for (int _i = 0; _i < 2; ++_i) \
        __builtin_amdgcn_global_load_lds((const unsigned*)((const char*)(gbase) + (voff)[_i]), (LAS unsigned*)(lds + (bufoff) + ldsw + _i * 8192), 16, 0, 0); } while (0)
#define PG8_LDA(dst, b, h) do { _Pragma("unroll") for (int m = 0; m < 4; ++m) _Pragma("unroll") for (int k = 0; k < 2; ++k) dst[m][k] = *(const LAS bf16x8*)(lds + PG8_SA(b, h) + aoff + m * 2048 + k * 1024); } while (0)
#define PG8_LDB(dst, b, h) do { _Pragma("unroll") for (int n = 0; n < 2; ++n) _Pragma("unroll") for (int k = 0; k < 2; ++k) dst[n][k] = *(const LAS bf16x8*)(lds + PG8_SB(b, h) + boff + n * 2048 + k * 1024); } while (0)
#define PG8_MMA(ai, bj, At, Bt) do { __builtin_amdgcn_s_setprio(1); _Pragma("unroll") for (int m = 0; m < 4; ++m) _Pragma("unroll") for (int n = 0; n < 2; ++n) _Pragma("unroll") for (int k = 0; k < 2; ++k) \
        acc[ai][bj][m][n] = __builtin_amdgcn_mfma_f32_16x16x32_bf16(Bt[n][k], At[m][k], acc[ai][bj][m][n], 0, 0, 0); __builtin_amdgcn_s_setprio(0); } while (0)
#define PG8_MMAZ(ai, bj, At, Bt) do { __builtin_amdgcn_s_setprio(1); _Pragma("unroll") for (int m = 0; m < 4; ++m) _Pragma("unroll") for (int n = 0; n < 2; ++n) { \
        acc[ai][bj][m][n] = __builtin_amdgcn_mfma_f32_16x16x32_bf16(Bt[n][0], At[m][0], (f32x4){0.f, 0.f, 0.f, 0.f}, 0, 0, 0); acc[ai][bj][m][n] = __builtin_amdgcn_mfma_f32_16x16x32_bf16(Bt[n][1], At[m][1], acc[ai][bj][m][n], 0, 0, 0); } __builtin_amdgcn_s_setprio(0); } while (0)
#define PG8_WAIT_V(n) asm volatile("s_waitcnt vmcnt(" #n ")" ::: "memory")
#define PG8_WAIT_V_SEL(sel, a, b) asm volatile("s_cmp_eq_u32 %0, 0\n\ts_cbranch_scc1 .Lwv_b%=\n\ts_waitcnt vmcnt(" #a ")\n\ts_branch .Lwv_e%=\n.Lwv_b%=:\n\ts_waitcnt vmcnt(" #b ")\n.Lwv_e%=:" :: "s"(sel) : "memory", "scc")
#define PG8_WAIT_L(n) asm volatile("s_waitcnt lgkmcnt(" #n ")" ::: "memory")
#define PG8_BAR __builtin_amdgcn_s_barrier()
#define PG8_SCHED __builtin_amdgcn_sched_barrier(0)
#define PG8_APTR(u) ((const char*)g.A + (size_t)(u).pm * 2 * hstepA + (g.amode == 1 ? (size_t)(((u).pn >> 1) * 256 * 2) : (size_t)0))
#define PG8_BPTR(u) ((const char*)g.Bt + (size_t)(u).pn * 2 * hstepB)
#define PG8_APTR2(u) ((const char*)g.A2 + (size_t)(u).pm * 2 * hstepA - (size_t)g.ksw * kstep)
#define PG8_BPTR2(u) ((const char*)g.Bt2 + (size_t)(u).pn * 2 * hstepB - (size_t)g.ksw * kstep)
    Unit cur, nxt; int ui = 0; bool after_epi = false;
    if (!S.next(0, cur)) return;
    f32x4 acc[2][2][4][2];
#pragma unroll
    for (int a = 0; a < 2; ++a)
#pragma unroll
        for (int b = 0; b < 2; ++b)
#pragma unroll
            for (int m = 0; m < 4; ++m)
#pragma unroll
                for (int n = 0; n < 2; ++n) acc[a][b][m][n] = (f32x4){0.f, 0.f, 0.f, 0.f};
    bf16x8 At[4][2], B0[2][2], B1[2][2];
    const char* cA = PG8_APTR(cur); const char* cB = PG8_BPTR(cur);
    if (BARSTAT >= 310 && g.ts && blockIdx.x == 0 && tid == 0) g.ts[0] = __builtin_amdgcn_s_memrealtime();
    const int pm_first = cur.pm;
    E.prep(cur.pm, tid, g.prep_split ? 1 : 0);
    if (g.stag > 0) { const int n_ = ((blockIdx.x >> 3) & 3) * g.stag; for (int i_ = 0; i_ < n_; ++i_) __builtin_amdgcn_s_sleep(8); }
    PG8_STAGE(PG8_SB(0, 0), cB, voffB); PG8_STAGE(PG8_SB(0, 1), cB + hstepB, voffB); PG8_STAGE(PG8_SA(0, 0), cA, voffA); PG8_STAGE(PG8_SA(0, 1), cA + hstepA, voffA);
    if (wr == 1) PG8_BAR;
    PG8_WAIT_V(2); PG8_BAR;
    PG8_STAGE(PG8_SB(1, 0), cB + kstep, voffB); PG8_STAGE(PG8_SA(1, 0), cA + kstep, voffA); PG8_STAGE(PG8_SB(1, 1), cB + hstepB + kstep, voffB);
    PG8_WAIT_V(6); PG8_BAR;
    if (BARSTAT >= 310 && g.ts && blockIdx.x == 0 && tid == 0) g.ts[1] = __builtin_amdgcn_s_memrealtime();
    for (;;) {
        const bool has_next = S.next(ui + 1, nxt);
        const char* nA0 = has_next ? PG8_APTR(nxt) : cA; const char* nB0 = has_next ? PG8_BPTR(nxt) : cB;
        const char* cA2 = g.A2 ? PG8_APTR2(cur) : cA; const char* cB2 = g.A2 ? PG8_BPTR2(cur) : cB;
        const char* nA = nA0; const char* nB = nB0;
#define PG8_PAIR(t, MMAF, WAIT12) do { \
            const bool last = ((t) == nt - 2); \
            const char* a1 = (((t) + 1) < g.ksw ? cA : cA2) + (size_t)((t) + 1) * kstep; \
            const char* a2 = last ? nA : (((t) + 2) < g.ksw ? cA : cA2) + (size_t)((t) + 2) * kstep; const char* b2 = last ? nB : (((t) + 2) < g.ksw ? cB : cB2) + (size_t)((t) + 2) * kstep; \
            const char* a3 = a2 + kstep; const char* b3 = b2 + kstep; \
            PG8_LDB(B0, 0, 0); PG8_LDB(B1, 0, 1); PG8_SCHED; PG8_LDA(At, 0, 0); PG8_STAGE(PG8_SA(1, 1), a1 + hstepA, voffA); \
            WAIT12; PG8_WAIT_L(0); PG8_BAR; MMAF(0, 0, At, B0); MMAF(0, 1, At, B1); PG8_BAR; PG8_SCHED; \
            PG8_LDA(At, 0, 1); PG8_STAGE(PG8_SB(0, 0), b2, voffB); PG8_STAGE(PG8_SB(0, 1), b2 + hstepB, voffB); PG8_STAGE(PG8_SA(0, 0), a2, voffA); \
            WAIT12; PG8_WAIT_L(0); PG8_BAR; MMAF(1, 0, At, B0); MMAF(1, 1, At, B1); PG8_BAR; PG8_SCHED; \
            PG8_LDB(B0, 1, 0); PG8_LDB(B1, 1, 1); PG8_SCHED; PG8_LDA(At, 1, 0); PG8_STAGE(PG8_SA(0, 1), a2 + hstepA, voffA); \
            PG8_WAIT_V(8); PG8_WAIT_L(0); PG8_BAR; PG8_MMA(0, 0, At, B0); PG8_MMA(0, 1, At, B1); PG8_BAR; PG8_SCHED; \
            PG8_LDA(At, 1, 1); PG8_STAGE(PG8_SB(1, 0), b3, voffB); PG8_STAGE(PG8_SB(1, 1), b3 + hstepB, voffB); PG8_STAGE(PG8_SA(1, 0), a3, voffA); \
            PG8_WAIT_V(8); PG8_WAIT_L(0); PG8_BAR; PG8_MMA(1, 0, At, B0); PG8_MMA(1, 1, At, B1); PG8_BAR; PG8_SCHED; \
        } while (0)
#define PG8_WAIT_FIRST do { if (RELAX_VM && Epi::NVM >= 16) PG8_WAIT_V_SEL(relax, 24, 8); else PG8_WAIT_V(8); } while (0)
        if (ZACC & Epi::ZBIT) {
            { const int relax = __builtin_amdgcn_readfirstlane((RELAX_VM && Epi::NVM >= 16 && after_epi) ? 1 : 0);
              PG8_PAIR(0, PG8_MMAZ, PG8_WAIT_FIRST); }
            for (int t = 2; t < nt; t += 2) {
                if (g.arr_u >= 0 && ui == g.arr_u + 1 && t == 2 && wid == 0 && lane_id_now() == 0) sb_arrive_lead(g.sb_bar, g.sb_st, g.arr_k);
                if (g.sb_mode == 3 && ui == g.sb_u && t == nt - 2) { sb_wait_raw(g.sb_bar, g.sb_st, wid == 0 && lane_id_now() == 0, g.sb_k); if (g.prep_split) E.prep(pm_first, wid * 64 + lane_id_now(), 2); }
                if (t == g.ksw) E.mid(acc, cur, wr, wc, fr, fq);
                PG8_PAIR(t, PG8_MMA, PG8_WAIT_V(8));
            }
        } else {
            for (int t = 0; t < nt; t += 2) {
                if (g.arr_u >= 0 && ui == g.arr_u + 1 && t == 2 && wid == 0 && lane_id_now() == 0) sb_arrive_lead(g.sb_bar, g.sb_st, g.arr_k);
                if (g.sb_mode == 3 && ui == g.sb_u && t == nt - 2) { sb_wait_raw(g.sb_bar, g.sb_st, wid == 0 && lane_id_now() == 0, g.sb_k); if (g.prep_split) E.prep(pm_first, wid * 64 + lane_id_now(), 2); }
                if (g.sb_mode == 2 && ui == 0 && t + 2 == g.ksw) sb_wait_raw(g.sb_bar, g.sb_st, wid == 0 && lane_id_now() == 0, g.sb_k);
                if (t == g.ksw) { if (BARSTAT == 340 && g.ts && blockIdx.x == 0 && tid == 0) g.ts[4] = __builtin_amdgcn_s_memrealtime(); E.mid(acc, cur, wr, wc, fr, fq); if (BARSTAT == 340 && g.ts && blockIdx.x == 0 && tid == 0) { asm volatile("" : "+v"(acc[0][0][0][0]), "+v"(acc[1][1][3][1])); g.ts[5] = __builtin_amdgcn_s_memrealtime(); } }
                const int relax = __builtin_amdgcn_readfirstlane((RELAX_VM && Epi::NVM >= 16 && after_epi && t == 0) ? 1 : 0);
                PG8_PAIR(t, PG8_MMA, PG8_WAIT_FIRST);
            }
        }
#undef PG8_WAIT_FIRST
#undef PG8_PAIR
        if (BARSTAT == 342 && g.ts && blockIdx.x == 0 && tid == 0) g.ts[4] = __builtin_amdgcn_s_memrealtime();
        if (wr == 0) PG8_BAR;
        if ((BARSTAT == 341 || BARSTAT == 343) && g.ts && blockIdx.x == 0 && tid == 0) g.ts[4] = __builtin_amdgcn_s_memrealtime();
        if (g.sb_mode == 1 && ui == g.sb_u) { sb_wait_raw(g.sb_bar, g.sb_st, wid == 0 && lane_id_now() == 0, g.sb_k); if (g.prep_split) E.prep(pm_first, wid * 64 + lane_id_now(), 2); }
        { int le_ = (int)__builtin_amdgcn_mbcnt_hi(~0u, __builtin_amdgcn_mbcnt_lo(~0u, 0u)); asm volatile("" : "+v"(le_)); const int fr_e = le_ & 15, fq_e = le_ >> 4;
          for (int er = 0; er < g.erep; ++er) { E(acc, cur, wr, wc, fr_e, fq_e); asm volatile("" ::: "memory"); } }
        if (BARSTAT >= 341 && BARSTAT <= 343 && g.ts && blockIdx.x == 0 && tid == 0) g.ts[5] = __builtin_amdgcn_s_memrealtime();
        if (BARSTAT == 344 && g.ts && blockIdx.x == 0 && tid == 0) g.ts[4] = __builtin_amdgcn_s_memrealtime();
        if (!has_next) break;
        if (BARSTAT == 346 && g.ts && blockIdx.x == 0 && tid == 0) dbg_stamp(6);
        if (!(ZACC & Epi::ZBIT)) {
#pragma unroll
        for (int a = 0; a < 2; ++a)
#pragma unroll
            for (int b = 0; b < 2; ++b)
#pragma unroll
                for (int m = 0; m < 4; ++m)
#pragma unroll
                    for (int n = 0; n < 2; ++n) acc[a][b][m][n] = (f32x4){0.f, 0.f, 0.f, 0.f};
        }
        cur = nxt; cA = nA; cB = nB; ++ui; after_epi = true;
        if (wr == 1) PG8_BAR;
    }
    if (BARSTAT >= 310 && g.ts && blockIdx.x == 0 && tid == 0) g.ts[2] = __builtin_amdgcn_s_memrealtime();
    PG8_WAIT_V(0);
    PG8_BAR;
    if (BARSTAT >= 310 && g.ts && blockIdx.x == 0 && tid == 0) g.ts[3] = __builtin_amdgcn_s_memrealtime();
#undef PG8_SA
#undef PG8_SB
#undef PG8_STAGE
#undef PG8_LDA
#undef PG8_LDB
#undef PG8_MMA
#undef PG8_MMAZ
#undef PG8_WAIT_V
#undef PG8_WAIT_V_SEL
#undef PG8_WAIT_L
#undef PG8_BAR
#undef PG8_SCHED
#undef PG8_APTR
#undef PG8_BPTR
#undef PG8_APTR2
#undef PG8_BPTR2
}

#define EPI_NO_MID __device__ __forceinline__ void mid(f32x4 (&)[2][2][4][2], const Unit&, int, int, int, int) const {}
__device__ __forceinline__ float rowscale(const float* rsq, int row) { const f32x4 p = *(const f32x4*)(rsq + 4 * (size_t)row); return rsqrtf(((p[0] + p[1]) + (p[2] + p[3])) * (1.f / DM) + EPS); }

__device__ __forceinline__ void rowscale8(const float* rsq, int row0, float (&sc)[8]) {
    f32x4 p[8];
#pragma unroll
    for (int k = 0; k < 8; ++k) p[k] = *(const f32x4*)(rsq + 4 * (size_t)(row0 + (k >> 2) * HALF + (k & 3) * 16));
#pragma unroll
    for (int k = 0; k < 8; ++k) sc[k] = rsqrtf(((p[k][0] + p[k][1]) + (p[k][2] + p[k][3])) * (1.f / DM) + EPS);
    asm volatile("" : "+v"(sc[0]), "+v"(sc[1]), "+v"(sc[2]), "+v"(sc[3]), "+v"(sc[4]), "+v"(sc[5]), "+v"(sc[6]), "+v"(sc[7]) :: "memory");
}
__device__ __forceinline__ void prep_rowscale(LAS float* tab, const float* rsq, int pm0, int tid, int part) {
    if (part == 1 && tid >= 256) return;
    if (part == 2) { if (tid >= 256) return; tid += 256; }
    const int slot = tid >> 8, rl = tid & 255; const int row = (((pm0 & ~8) + 8 * slot) * BM) + rl;
    const f32x4 p = *(const f32x4*)(rsq + 4 * (size_t)row);
    tab[slot * 256 + rl] = rsqrtf(((p[0] + p[1]) + (p[2] + p[3])) * (1.f / DM) + EPS);
}
__device__ __forceinline__ void rowscale8_tab(const LAS float* tab, int pm, int rl0, float (&sc)[8]) {
    const LAS float* t = tab + ((pm >> 3) & 1) * 256 + rl0;
#pragma unroll
    for (int k = 0; k < 8; ++k) sc[k] = t[(k >> 2) * HALF + (k & 3) * 16];
}
#define EPI_NO_PREP __device__ __forceinline__ void prep(int, int, int) const {}
struct EpiSwiGLU {
    EPI_NO_MID
    static constexpr int NVM = 8;
    static constexpr int ZBIT = 1;
    bf16_t* O; int ldc; const float* rsq; LAS float* rtab;
    __device__ __forceinline__ void prep(int pm0, int tid, int part) const { prep_rowscale(rtab, rsq, pm0, tid, part); }
    __device__ __forceinline__ void operator()(const f32x4 (&acc)[2][2][4][2], const Unit& u, int wr, int wc, int fr, int fq) const {
        const int row0 = u.pm * BM + wr * 64 + fr, col0 = u.pn * HALF + wc * 32 + 8 * fq;
        float sc8[8]; rowscale8_tab(rtab, u.pm, wr * 64 + fr, sc8);
#pragma unroll
        for (int ai = 0; ai < 2; ++ai)
#pragma unroll
            for (int m = 0; m < 4; ++m) { const int row = row0 + ai * HALF + m * 16; const float s = sc8[ai * 4 + m];
                float o[8];
#pragma unroll
                for (int n = 0; n < 2; ++n)
#pragma unroll
                    for (int i = 0; i < 4; ++i) { const float gt = acc[ai][0][m][n][i] * s, up = acc[ai][1][m][n][i] * s; o[n * 4 + i] = gt * fast_sigmoid(gt) * up; }
                u32x4 w; w.x = cvt_pk_bf16(o[0], o[1]); w.y = cvt_pk_bf16(o[2], o[3]); w.z = cvt_pk_bf16(o[4], o[5]); w.w = cvt_pk_bf16(o[6], o[7]);
                EPI_ST16(O + (size_t)row * ldc + col0, w); }
    }
};
struct EpiBf16 {
    EPI_NO_MID
    EPI_NO_PREP
    static constexpr int NVM = 16;
    static constexpr int ZBIT = 32;
    bf16_t* O; int ldc;
    __device__ __forceinline__ void operator()(const f32x4 (&acc)[2][2][4][2], const Unit& u, int wr, int wc, int fr, int fq) const {
        const int row0 = u.pm * BM + wr * 64 + fr, col0 = u.pn * BM + wc * 32 + 8 * fq;
#pragma unroll
        for (int ai = 0; ai < 2; ++ai)
#pragma unroll
            for (int m = 0; m < 4; ++m) { bf16_t* rowp = O + (size_t)(row0 + ai * HALF + m * 16) * ldc + col0;
#pragma unroll
                for (int bj = 0; bj < 2; ++bj) { const f32x4 v0 = acc[ai][bj][m][0], v1 = acc[ai][bj][m][1];
                    u32x4 w; w.x = cvt_pk_bf16(v0[0], v0[1]); w.y = cvt_pk_bf16(v0[2], v0[3]); w.z = cvt_pk_bf16(v1[0], v1[1]); w.w = cvt_pk_bf16(v1[2], v1[3]);
                    EPI_ST16(rowp + bj * HALF, w); } }
    }
};
template <int MODE> struct EpiProj {
    EPI_NO_MID
    static constexpr int NVM = 16;
    static constexpr int ZBIT = 2;
    bf16_t* o0; size_t sec_stride; const float* rsq; LAS float* rtab;
    __device__ __forceinline__ void prep(int pm0, int tid, int part) const { prep_rowscale(rtab, rsq, pm0, tid, part); }
    __device__ __forceinline__ void operator()(const f32x4 (&acc)[2][2][4][2], const Unit& u, int wr, int wc, int fr, int fq) const {
        const int row0 = u.pm * BM + wr * 64 + fr;
        int sec, ldc, colt; float sc = 1.f;
        if (MODE == 0) { sec = u.pn / 6; ldc = QW; colt = (u.pn % 6) * BM; if (sec == 0) sc = C2; }
        else { sec = u.pn < 8 ? (u.pn >> 2) : 2; ldc = u.pn < 8 ? DM : 2 * DM; colt = u.pn < 8 ? (u.pn & 3) * BM : (u.pn - 8) * HALF; }
        bf16_t* base = o0 + (size_t)sec * sec_stride;
        const int col0 = colt + wc * 32 + 8 * fq;
        float sc8[8]; rowscale8_tab(rtab, u.pm, wr * 64 + fr, sc8);
        if (MODE == 1 && sec == 2) {
#pragma unroll
            for (int ai = 0; ai < 2; ++ai)
#pragma unroll
                for (int m = 0; m < 4; ++m) { const int row = row0 + ai * HALF + m * 16; const float s = sc8[ai * 4 + m]; bf16_t* rowp = base + (size_t)row * ldc + col0;
                    float rr[8], gg[8];
#pragma unroll
                    for (int n = 0; n < 2; ++n)
#pragma unroll
                        for (int i = 0; i < 4; ++i) { const float ea = 1.f + __builtin_amdgcn_exp2f(acc[ai][0][m][n][i] * (-LOG2E * s)), eb = fminf(1.f + __builtin_amdgcn_exp2f(acc[ai][1][m][n][i] * (-LOG2E * s)), 1e30f);
                            rr[n * 4 + i] = __builtin_amdgcn_rcpf(ea) * eb; gg[n * 4 + i] = __builtin_amdgcn_rcpf(eb); }
                    u32x4 w; w.x = cvt_pk_bf16(rr[0], rr[1]); w.y = cvt_pk_bf16(rr[2], rr[3]); w.z = cvt_pk_bf16(rr[4], rr[5]); w.w = cvt_pk_bf16(rr[6], rr[7]); EPI_ST16(rowp, w);
                    u32x4 v; v.x = cvt_pk_bf16(gg[0], gg[1]); v.y = cvt_pk_bf16(gg[2], gg[3]); v.z = cvt_pk_bf16(gg[4], gg[5]); v.w = cvt_pk_bf16(gg[6], gg[7]); EPI_ST16(rowp + DM, v); }
        } else {
#pragma unroll
        for (int ai = 0; ai < 2; ++ai)
#pragma unroll
            for (int m = 0; m < 4; ++m) { const int row = row0 + ai * HALF + m * 16; const float s = sc8[ai * 4 + m] * sc; bf16_t* rowp = base + (size_t)row * ldc + col0;
#pragma unroll
                for (int bj = 0; bj < 2; ++bj) { const f32x4 v0 = acc[ai][bj][m][0] * s, v1 = acc[ai][bj][m][1] * s;
                    u32x4 w; w.x = cvt_pk_bf16(v0[0], v0[1]); w.y = cvt_pk_bf16(v0[2], v0[3]); w.z = cvt_pk_bf16(v1[0], v1[1]); w.w = cvt_pk_bf16(v1[2], v1[3]);
                    EPI_ST16(rowp + bj * HALF, w); } }
        }
    }
};
struct EpiLru {
    EPI_NO_MID
    EPI_NO_PREP
    static constexpr int NVM = 0;
    static constexpr int ZBIT = 4;
    const bf16_t* XC; const float* lc; bf16_t *LA, *BB;
    __device__ __forceinline__ void operator()(const f32x4 (&acc)[2][2][4][2], const Unit& u, int wr, int wc, int fr, int fq) const {
        const int row0 = u.pm * BM + wr * 64 + fr, c0 = (u.pn >> 1) * 256 + (u.pn & 1) * 128 + wc * 32 + 8 * fq;
        f32x4 cbx[2], cba[2], csp[2];
#pragma unroll
        for (int n = 0; n < 2; ++n) { cbx[n] = *(const f32x4*)(lc + c0 + 4 * n); cba[n] = *(const f32x4*)(lc + DM + c0 + 4 * n); csp[n] = *(const f32x4*)(lc + 2 * DM + c0 + 4 * n); }
        u32x4 xw8[8];
#pragma unroll
        for (int k = 0; k < 8; ++k) xw8[k] = *(const u32x4*)(XC + (size_t)(row0 + (k >> 2) * HALF + (k & 3) * 16) * DM + c0);
#pragma unroll
        for (int k = 0; k < 8; ++k) asm volatile("" : "+v"(xw8[k]) :: "memory");
#pragma unroll
        for (int ai = 0; ai < 2; ++ai)
#pragma unroll
            for (int m = 0; m < 4; ++m) { const int row = row0 + ai * HALF + m * 16; const size_t off = (size_t)row * DM + c0;
                const u32x4 xw = xw8[ai * 4 + m]; float xv[8] = {bflo(xw.x), bfhi(xw.x), bflo(xw.y), bfhi(xw.y), bflo(xw.z), bfhi(xw.z), bflo(xw.w), bfhi(xw.w)};
                float la[8], bb[8], x2v[8]; bool far_ = false;
#pragma unroll
                for (int n = 0; n < 2; ++n)
#pragma unroll
                    for (int i = 0; i < 4; ++i) { const int j = n * 4 + i;
                        const float gx = __builtin_amdgcn_rcpf(1.f + __builtin_amdgcn_exp2f(__builtin_fmaf(acc[ai][0][m][n][i], -LOG2E, cbx[n][i])));
                        const float ga = __builtin_amdgcn_rcpf(1.f + __builtin_amdgcn_exp2f(__builtin_fmaf(acc[ai][1][m][n][i], -LOG2E, cba[n][i])));
                        const float l = ga * csp[n][i]; la[j] = l; const float x2 = l + l; x2v[j] = x2; far_ = far_ || (x2 < -0.25f);
                        const float om = -x2 * (1.f + x2 * (0.5f + x2 * (0.16666667f + x2 * (0.041666668f + x2 * (0.0083333333f + x2 * 0.0013888889f)))));
                        bb[j] = __builtin_amdgcn_sqrtf(om) * (gx * xv[j]); }
                if (__any(far_)) {
#pragma unroll
                    for (int j = 0; j < 8; ++j) if (x2v[j] < -0.25f) { const int n = j >> 2, i = j & 3;
                        const float gx = __builtin_amdgcn_rcpf(1.f + __builtin_amdgcn_exp2f(__builtin_fmaf(acc[ai][0][m][n][i], -LOG2E, cbx[n][i])));
                        bb[j] = sqrtf(1.f - __builtin_amdgcn_exp2f(x2v[j] * LOG2E)) * (gx * xv[j]); }
                }
                u32x4 w; w.x = cvt_pk_bf16(la[0], la[1]); w.y = cvt_pk_bf16(la[2], la[3]); w.z = cvt_pk_bf16(la[4], la[5]); w.w = cvt_pk_bf16(la[6], la[7]); EPI_ST16(LA + off, w);
                u32x4 v; v.x = cvt_pk_bf16(bb[0], bb[1]); v.y = cvt_pk_bf16(bb[2], bb[3]); v.z = cvt_pk_bf16(bb[4], bb[5]); v.w = cvt_pk_bf16(bb[6], bb[7]); EPI_ST16(BB + off, v); }
    }
};
struct EpiGate {
    EPI_NO_PREP
    static constexpr int NVM = 0;
    static constexpr int ZBIT = 8;
    const bf16_t* GT; bf16_t* MG;
    __device__ __forceinline__ void scale(f32x4 (&acc)[2][2][4][2], const Unit& u, int wr, int wc, int fr, int fq, int goff) const {
        int row0 = u.pm * BM + wr * 64 + fr; const int col0 = u.pn * BM + wc * 32 + 8 * fq;
        asm volatile("" : "+v"(row0));
        u32x4 gw[8][2];
#pragma unroll
        for (int k = 0; k < 8; ++k)
#pragma unroll
            for (int bj = 0; bj < 2; ++bj) gw[k][bj] = NTLD((const u32x4*)(GT + (size_t)(row0 + (k >> 2) * HALF + (k & 3) * 16) * (2 * DM) + goff + col0 + bj * HALF));
#pragma unroll
        for (int k = 0; k < 8; ++k)
#pragma unroll
            for (int bj = 0; bj < 2; ++bj) { const u32x4 b = gw[k][bj];
                acc[k >> 2][bj][k & 3][0] *= (f32x4){bflo(b.x), bfhi(b.x), bflo(b.y), bfhi(b.y)}; acc[k >> 2][bj][k & 3][1] *= (f32x4){bflo(b.z), bfhi(b.z), bflo(b.w), bfhi(b.w)}; }
    }
    __device__ __forceinline__ void mid(f32x4 (&acc)[2][2][4][2], const Unit& u, int wr, int wc, int fr, int fq) const { scale(acc, u, wr, wc, fr, fq, 0); }
    __device__ __forceinline__ void operator()(f32x4 (&acc)[2][2][4][2], const Unit& u, int wr, int wc, int fr, int fq) const {
        scale(acc, u, wr, wc, fr, fq, DM);
        const int row0 = u.pm * BM + wr * 64 + fr, col0 = u.pn * BM + wc * 32 + 8 * fq;
#pragma unroll
        for (int ai = 0; ai < 2; ++ai)
#pragma unroll
            for (int m = 0; m < 4; ++m) { const int row = row0 + ai * HALF + m * 16;
#pragma unroll
                for (int bj = 0; bj < 2; ++bj) { const f32x4 v0 = acc[ai][bj][m][0], v1 = acc[ai][bj][m][1];
                    u32x4 w; w.x = cvt_pk_bf16(v0[0], v0[1]); w.y = cvt_pk_bf16(v0[2], v0[3]); w.z = cvt_pk_bf16(v1[0], v1[1]); w.w = cvt_pk_bf16(v1[2], v1[3]);
                    EPI_ST16(MG + (size_t)row * DM + col0 + bj * HALF, w); } }
    }
};
__device__ __forceinline__ float quad_sum(float v) {
    const auto a = __builtin_amdgcn_permlane16_swap(__float_as_uint(v), __float_as_uint(v), false, false); v = __uint_as_float(a[0]) + __uint_as_float(a[1]);
    const auto b = __builtin_amdgcn_permlane32_swap(__float_as_uint(v), __float_as_uint(v), false, false); return __uint_as_float(b[0]) + __uint_as_float(b[1]);
}
template <int MODE> struct EpiNormRes {
    EPI_NO_MID
    EPI_NO_PREP
    static constexpr int NVM = 0;
    static constexpr int ZBIT = 16;
    const float* resf; bf16_t* AB; float* outf; const float* gpost; float coef; unsigned long long* xs; unsigned epoch; float* rsq_out; LAS unsigned char* sl;
    static constexpr int DEPTH = (MODE == 0) ? 3 : 4;
    static constexpr int NPRE = (MODE == 0) ? 6 : 4;
    __device__ __forceinline__ void load_row(u32x4 (&pre)[NPRE][2], int k, size_t rowoff) const {
        if (MODE == 0) { const float* p = resf + rowoff; const int sl_ = (k % 3) * 2; pre[sl_][0] = NTLD((const u32x4*)p); pre[sl_][1] = NTLD((const u32x4*)(p + 4)); pre[sl_ + 1][0] = NTLD((const u32x4*)(p + HALF)); pre[sl_ + 1][1] = NTLD((const u32x4*)(p + HALF + 4)); }
        else { const bf16_t* p = AB + rowoff; pre[k & 3][0] = NTLD((const u32x4*)p); pre[k & 3][1] = NTLD((const u32x4*)(p + HALF)); }
    }
    __device__ __forceinline__ void operator()(const f32x4 (&acc)[2][2][4][2], const Unit& u, int wr, int wc, int fr, int fq) const {
        LAS float* P = (LAS float*)sl;
        LAS float* S = (LAS float*)(sl + 4096);
        const int wid = wr * 4 + wc, lane = fq * 16 + fr;
        const int col0 = u.pn * BM + wc * 32 + 8 * fq;
        const bool tsw_ = (BARSTAT >= 330 && BARSTAT < 340) && MODE == TS_MODE && blockIdx.x == 0 && wid == 0 && lane == 0; unsigned long long* tsp_ = (unsigned long long*)((unsigned char*)xs - 1536 * 1024 - 508 * MiB + 202 * 1024);
        if (tsw_) tsp_[0] = __builtin_amdgcn_s_memrealtime();
        const size_t off0 = (size_t)(u.pm * BM + wr * 64 + fr) * DM + col0;
        f32x4 gv[2][2];
#pragma unroll
        for (int bj = 0; bj < 2; ++bj) { gv[bj][0] = *(const f32x4*)(gpost + col0 + bj * HALF); gv[bj][1] = *(const f32x4*)(gpost + col0 + bj * HALF + 4); }
        u32x4 pre[NPRE][2];
#pragma unroll
        for (int k = 0; k < DEPTH; ++k) load_row(pre, k, off0 + (size_t)((k >> 2) * HALF + (k & 3) * 16) * DM);
#pragma unroll
        for (int ai = 0; ai < 2; ++ai)
#pragma unroll
            for (int m = 0; m < 4; ++m) { float s = 0.f;
#pragma unroll
                for (int bj = 0; bj < 2; ++bj)
#pragma unroll
                    for (int n = 0; n < 2; ++n) { const f32x4 v = acc[ai][bj][m][n]; s += (v[0] * v[0] + v[1] * v[1]) + (v[2] * v[2] + v[3] * v[3]); }
                s = quad_sum(s);
                if (fq == 0) P[(ai * HALF + wr * 64 + m * 16 + fr) * 4 + wc] = s; }
        asm volatile("s_waitcnt lgkmcnt(0)" ::: "memory"); __builtin_amdgcn_s_barrier(); asm volatile("" ::: "memory");
        if (tsw_) tsp_[1] = __builtin_amdgcn_s_memrealtime();
        if (lane < 32) { const int row = wid * 32 + lane; const f32x4 p = *(const LAS f32x4*)(P + row * 4); const float tot = (p[0] + p[1]) + (p[2] + p[3]);
            unsigned long long* slot = xs + ((size_t)(u.pm * BM + row) * 4);
            __hip_atomic_store(slot + u.pn, ((unsigned long long)epoch << 32) | (unsigned long long)__float_as_uint(tot), __ATOMIC_RELAXED, __HIP_MEMORY_SCOPE_AGENT);
            float sum = 0.f; unsigned spins = 0;
            for (;;) { bool ok = true; float t = 0.f;
#pragma unroll
                for (int k = 0; k < 4; ++k) { const unsigned long long g = __hip_atomic_load(slot + k, __ATOMIC_RELAXED, __HIP_MEMORY_SCOPE_AGENT); ok = ok && ((unsigned)(g >> 32) == epoch); t += __uint_as_float((unsigned)g); }
                sum = t; if (ok || ++spins > (1u << 16)) break; __builtin_amdgcn_s_sleep(1); }
            S[row] = rsqrtf(sum * (1.f / DM) + EPS) * coef; }
        if (tsw_) tsp_[2] = __builtin_amdgcn_s_memrealtime();
        asm volatile("s_waitcnt vmcnt(0) lgkmcnt(0)" ::: "memory"); __builtin_amdgcn_s_barrier(); asm volatile("" ::: "memory");
        if (tsw_) tsp_[3] = __builtin_amdgcn_s_memrealtime();
        float rsv[8];
#pragma unroll
        for (int k = 0; k < 8; ++k) rsv[k] = S[(k >> 2) * HALF + wr * 64 + (k & 3) * 16 + fr];
#pragma unroll
        for (int k = 0; k < 8; ++k) { const int ai = k >> 2, m = k & 3; const int rl = ai * HALF + wr * 64 + m * 16 + fr; const size_t off = off0 + (size_t)(ai * HALF + m * 16) * DM; const float rs = rsv[k];
            f32x4 h[2][2];
#pragma unroll
            for (int bj = 0; bj < 2; ++bj) { f32x4 r0, r1;
                if (MODE == 0) { r0 = __builtin_bit_cast(f32x4, pre[(k % 3) * 2 + bj][0]); r1 = __builtin_bit_cast(f32x4, pre[(k % 3) * 2 + bj][1]); }
                else { const u32x4 w = pre[k & 3][bj]; r0 = (f32x4){bflo(w.x), bfhi(w.x), bflo(w.y), bfhi(w.y)}; r1 = (f32x4){bflo(w.z), bfhi(w.z), bflo(w.w), bfhi(w.w)}; }
                h[bj][0] = r0 + acc[ai][bj][m][0] * rs * gv[bj][0]; h[bj][1] = r1 + acc[ai][bj][m][1] * rs * gv[bj][1]; }
            asm volatile("" : "+v"(h[0][0]), "+v"(h[0][1]), "+v"(h[1][0]), "+v"(h[1][1]) :: "memory");
            if (k + DEPTH < 8) load_row(pre, k + DEPTH, off0 + (size_t)((((k + DEPTH) >> 2)) * HALF + ((k + DEPTH) & 3) * 16) * DM);
            asm volatile("" ::: "memory");
            float s2 = 0.f;
#pragma unroll
            for (int bj = 0; bj < 2; ++bj) { const f32x4 h0 = h[bj][0], h1 = h[bj][1];
                if (MODE == 2) { if (NT_NORM == 1) { ST16_WT(outf + off + bj * HALF, h0); ST16_WT(outf + off + bj * HALF + 4, h1); } else if (NT_NORM == 2) { __builtin_nontemporal_store(h0, (f32x4*)(outf + off + bj * HALF)); __builtin_nontemporal_store(h1, (f32x4*)(outf + off + bj * HALF + 4)); } else { *(f32x4*)(outf + off + bj * HALF) = h0; *(f32x4*)(outf + off + bj * HALF + 4) = h1; } }
                else { u32x4 w; w.x = cvt_pk_bf16(h0[0], h0[1]); w.y = cvt_pk_bf16(h0[2], h0[3]); w.z = cvt_pk_bf16(h1[0], h1[1]); w.w = cvt_pk_bf16(h1[2], h1[3]); if (NT_NORM == 1) ST16_WT(AB + off + bj * HALF, w); else if (NT_NORM == 2) __builtin_nontemporal_store(w, (u32x4*)(AB + off + bj * HALF)); else *(u32x4*)(AB + off + bj * HALF) = w;
                    s2 += (h0[0] * h0[0] + h0[1] * h0[1]) + (h0[2] * h0[2] + h0[3] * h0[3]) + (h1[0] * h1[0] + h1[1] * h1[1]) + (h1[2] * h1[2] + h1[3] * h1[3]); } }
            if (MODE != 2) { s2 = quad_sum(s2); if (fq == 0) P[rl * 4 + wc] = s2; }
        }
        if (tsw_) tsp_[4] = __builtin_amdgcn_s_memrealtime();
        if (MODE != 2) {
            asm volatile("s_waitcnt lgkmcnt(0)" ::: "memory"); __builtin_amdgcn_s_barrier(); asm volatile("" ::: "memory");
            if (lane < 32) { const int row = wid * 32 + lane; const f32x4 p = *(const LAS f32x4*)(P + row * 4); rsq_out[(size_t)(u.pm * BM + row) * 4 + u.pn] = (p[0] + p[1]) + (p[2] + p[3]); }
        }
        asm volatile("s_waitcnt lgkmcnt(0)" ::: "memory"); __builtin_amdgcn_s_barrier(); asm volatile("" ::: "memory");
        if (tsw_) tsp_[5] = __builtin_amdgcn_s_memrealtime();
    }
};
}

struct Args {
    const float* in[25];
    float* out;
    unsigned char* ws;
};

struct P0D { const float* wp; const float* gp; bf16_t* dst; int ldw, ldt; };
__device__ __forceinline__ void p0_load(float (&v)[32], f32x4& g0, f32x4& g1, const P0D& d, int lane) {
#pragma unroll
    for (int i = 0; i < 32; ++i) v[i] = NTLD(d.wp + (size_t)(2 * i) * d.ldw);
    const int c = lane & 7;
    g0 = (f32x4){1.f, 1.f, 1.f, 1.f}; g1 = g0;
    if (d.gp) { g0 = *(const f32x4*)(d.gp + 8 * c); g1 = *(const f32x4*)(d.gp + 8 * c + 4); }
}
__device__ __forceinline__ void p0_finish(const float (&v)[32], const f32x4 g0, const f32x4 g1, const P0D& d, LAS float* scr, int lane) {
    const int c = lane & 7;
#pragma unroll
    for (int i = 0; i < 32; ++i) scr[(2 * i + (lane >> 5)) * 33 + (lane & 31)] = v[i];
    asm volatile("s_waitcnt lgkmcnt(0)" ::: "memory");
#pragma unroll
    for (int j = 0; j < 4; ++j) { const int n = (lane >> 3) + 8 * j; const LAS float* s = scr + (8 * c) * 33 + n;
        u32x4 o; o.x = cvt_pk_bf16(s[0 * 33] * g0[0], s[1 * 33] * g0[1]); o.y = cvt_pk_bf16(s[2 * 33] * g0[2], s[3 * 33] * g0[3]); o.z = cvt_pk_bf16(s[4 * 33] * g1[0], s[5 * 33] * g1[1]); o.w = cvt_pk_bf16(s[6 * 33] * g1[2], s[7 * 33] * g1[3]);
        *(u32x4*)(d.dst + (size_t)n * d.ldt + 8 * c) = o; }
    asm volatile("s_waitcnt lgkmcnt(0)" ::: "memory");
}
template <int MAP>
__device__ __forceinline__ bool p0_job(int& r, const float* W, int ldw, int Ksrc, int Nsrc, const float* gain, bf16_t* WT, int ldt, int rowbase, P0D& d, int lane) {
    const int nblk = Nsrc / 32, items = (Ksrc / 64) * nblk;
    if (r >= items) { r -= items; return false; }
    const int kb = r / nblk, nb = r % nblk, n0 = nb * 32, k0 = kb * 64;
    int drow0 = rowbase + n0;
    if (MAP == 1 || MAP == 3) drow0 = rowbase + (n0 / 128) * 256 + (n0 % 128);
    if (MAP == 2) drow0 = rowbase + (n0 / 128) * 256 + 128 + (n0 % 128);
    d.wp = W + (size_t)(k0 + (lane >> 5)) * ldw + n0 + (lane & 31); d.gp = gain ? gain + k0 : nullptr; d.dst = WT + (size_t)drow0 * ldt + k0; d.ldw = ldw; d.ldt = ldt;
    return true;
}

__device__ __forceinline__ int t5_bucket(int dist) {
    if (dist < 16) return dist;
    const double v = log((double)dist / 16.0) / log(128.0) * 16.0;
    const int b = 16 + (int)v; return b < 31 ? b : 31;
}

template <bool RES_F32, bool OUT_F32>
__device__ __forceinline__ void norm_pass(const bf16_t* Fb, bf16_t* AB, const float* resf, const float* gpost, float coef, float* outf, float* rsq_out, int gw, int NGW, int lane) {
    for (int row = gw; row < M; row += NGW) {
        const bf16_t* fr_ = Fb + (size_t)row * DM; float fv[2][8]; float rv[2][8]; float s = 0.f;
#pragma unroll
        for (int j = 0; j < 2; ++j) { const int c = 8 * lane + 512 * j; const u32x4 w = *(const u32x4*)(fr_ + c);
            fv[j][0] = bflo(w.x); fv[j][1] = bfhi(w.x); fv[j][2] = bflo(w.y); fv[j][3] = bfhi(w.y); fv[j][4] = bflo(w.z); fv[j][5] = bfhi(w.z); fv[j][6] = bflo(w.w); fv[j][7] = bfhi(w.w);
            if (RES_F32) { const f32x4 r0 = *(const f32x4*)(resf + (size_t)row * DM + c), r1 = *(const f32x4*)(resf + (size_t)row * DM + c + 4);
#pragma unroll
                for (int i = 0; i < 4; ++i) { rv[j][i] = r0[i]; rv[j][4 + i] = r1[i]; } }
            else { const u32x4 r = *(const u32x4*)(AB + (size_t)row * DM + c);
                rv[j][0] = bflo(r.x); rv[j][1] = bfhi(r.x); rv[j][2] = bflo(r.y); rv[j][3] = bfhi(r.y); rv[j][4] = bflo(r.z); rv[j][5] = bfhi(r.z); rv[j][6] = bflo(r.w); rv[j][7] = bfhi(r.w); }
#pragma unroll
            for (int i = 0; i < 8; ++i) s += fv[j][i] * fv[j][i]; }
        s = wave_sum(s);
        const float rs = rsqrtf(s * (1.f / DM) + EPS) * coef; float s2 = 0.f;
#pragma unroll
        for (int j = 0; j < 2; ++j) { const int c = 8 * lane + 512 * j;
            const f32x4 g0 = *(const f32x4*)(gpost + c), g1 = *(const f32x4*)(gpost + c + 4);
            f32x4 o0, o1;
#pragma unroll
            for (int i = 0; i < 4; ++i) { o0[i] = rv[j][i] + fv[j][i] * rs * g0[i]; o1[i] = rv[j][4 + i] + fv[j][4 + i] * rs * g1[i]; s2 += o0[i] * o0[i] + o1[i] * o1[i]; }
            if (OUT_F32) { *(f32x4*)(outf + (size_t)row * DM + c) = o0; *(f32x4*)(outf + (size_t)row * DM + c + 4) = o1; }
            else { u32x4 w; w.x = cvt_pk_bf16(o0[0], o0[1]); w.y = cvt_pk_bf16(o0[2], o0[3]); w.z = cvt_pk_bf16(o1[0], o1[1]); w.w = cvt_pk_bf16(o1[2], o1[3]); *(u32x4*)(AB + (size_t)row * DM + c) = w; } }
        if (!OUT_F32) { s2 = wave_sum(s2); if (lane == 0) *(f32x4*)(rsq_out + 4 * (size_t)row) = (f32x4){s2, 0.f, 0.f, 0.f}; }
    }
}

#define XB_TMO      128
#define XB_XCNT(j)  (256  + 64 * (j))
#define XB_XSUB(j)  (1280 + 64 * (j))
#define XB_XGEN(j)  (2304 + 64 * (j))
#define XB_TOP      3328
#define XB_TOPGEN   3392
#define XCD_BAR_WORDS 3456
#define XB_SPIN_CAP (1u << 18)

__device__ __forceinline__ unsigned xb_ld(unsigned* p)              { return __hip_atomic_load(p, __ATOMIC_RELAXED, __HIP_MEMORY_SCOPE_AGENT); }
__device__ __forceinline__ unsigned xb_add(unsigned* p, unsigned v) { return __hip_atomic_fetch_add(p, v, __ATOMIC_RELAXED, __HIP_MEMORY_SCOPE_AGENT); }
__device__ __forceinline__ unsigned xb_xcc_id() { return (unsigned)__builtin_amdgcn_s_getreg((3 << 11) | 20) & 0xFu; }
#define XB_SPIN(cond, bar) do { unsigned _sp = 0; while (cond) { __builtin_amdgcn_s_sleep(1); \
    if ((++_sp & 255u) == 0u) { if (xb_ld(&(bar)[XB_TMO])) break; if (_sp > XB_SPIN_CAP) { atomicAdd(&(bar)[XB_TMO], 1u); break; } } } } while (0)

struct XcdBarrier {
    unsigned* bar; unsigned x;
    volatile LAS unsigned* st;
    bool lead;
};

__device__ __forceinline__ XcdBarrier xcd_barrier_post(unsigned* bar, volatile LAS unsigned* st, bool lead) {
    XcdBarrier b; b.bar = bar; b.x = xb_xcc_id(); b.st = st; b.lead = lead;
    if (lead) (void)xb_add(&bar[XB_XCNT(b.x)], 1u);
    return b;
}
__device__ __forceinline__ void xcd_barrier_complete(unsigned* bar, unsigned x, unsigned& nloc, unsigned& nx) {
    const unsigned G = gridDim.x * gridDim.y * gridDim.z;
    unsigned sum, cnt, mine, sp = 0u;
    for (;;) {
        sum = 0u; cnt = 0u; mine = 0u;
#pragma unroll
        for (unsigned j = 0; j < 16; ++j) { const unsigned c = xb_ld(&bar[XB_XCNT(j)]); sum += c; cnt += (c > 0u) ? 1u : 0u; mine = (j == x) ? c : mine; }
        if (sum == G) break;
        __builtin_amdgcn_s_sleep(1);
        if ((++sp & 255u) == 0u) { if (xb_ld(&bar[XB_TMO])) break; if (sp > XB_SPIN_CAP) { atomicAdd(&bar[XB_TMO], 1u); break; } }
    }
    nloc = mine > 0u ? mine : 1u; nx = cnt > 0u ? cnt : 1u;
}

__device__ __forceinline__ void xcd_barrier(const XcdBarrier& b) {
    asm volatile("s_waitcnt vmcnt(0)" ::: "memory");
    __syncthreads();
    if (b.lead) {
        unsigned* bar = b.bar;
        __builtin_amdgcn_s_waitcnt(0);
        unsigned nloc = b.st[0], nx = b.st[1];
        if (nloc == 0u) { xcd_barrier_complete(bar, b.x, nloc, nx); b.st[0] = nloc; b.st[1] = nx; }
        const unsigned old = xb_add(&bar[XB_XSUB(b.x)], 1u);
        const unsigned gen = old / nloc;
        if (old + 1u == (gen + 1u) * nloc) {
            __builtin_amdgcn_fence(__ATOMIC_RELEASE, "agent");
            asm volatile("s_waitcnt vmcnt(0)" ::: "memory");
            const unsigned og = xb_add(&bar[XB_TOP], 1u);
            const unsigned tg = og / nx;
            if (og + 1u == (tg + 1u) * nx) xb_add(&bar[XB_TOPGEN], 1u);
            else XB_SPIN(xb_ld(&bar[XB_TOPGEN]) == tg, bar);
            __builtin_amdgcn_fence(__ATOMIC_ACQUIRE, "agent");
            xb_add(&bar[XB_XGEN(b.x)], 1u);
            asm volatile("s_waitcnt vmcnt(0)" ::: "memory");
        } else {
            XB_SPIN(xb_ld(&bar[XB_XGEN(b.x)]) == gen, bar);
            __builtin_amdgcn_fence(__ATOMIC_ACQUIRE, "agent");
            asm volatile("s_waitcnt vmcnt(0)" ::: "memory");
        }
    }
    __syncthreads();
}


#define SB_XSUB(j, s)  (4096 + 2048 * (s) + 64 * (j))
#define SB_TOP(s)      (4096 + 2048 * (s) + 64 * 17)
__device__ __forceinline__ void sb_arrive(unsigned* bar, volatile LAS unsigned* st, bool lead, unsigned k) {
    asm volatile("s_waitcnt vmcnt(0)" ::: "memory");
    __syncthreads();
    if (lead) {
        __builtin_amdgcn_s_waitcnt(0);
        const unsigned x = xb_xcc_id();
        unsigned nloc = st[0], nx = st[1];
        if (nloc == 0u) { xcd_barrier_complete(bar, x, nloc, nx); st[0] = nloc; st[1] = nx; }
        const unsigned old = xb_add(&bar[SB_XSUB(x, k & 3u)], 1u);
        if (old + 1u == ((k >> 2) + 1u) * nloc) {
            __builtin_amdgcn_fence(__ATOMIC_RELEASE, "agent");
            asm volatile("s_waitcnt vmcnt(0)" ::: "memory");
            xb_add(&bar[SB_TOP(k & 3u)], 1u);
        }
    }
}
__device__ __forceinline__ void sb_wait(unsigned* bar, volatile LAS unsigned* st, bool lead, unsigned k) {
    if (lead) {
        const unsigned nx = st[1];
        XB_SPIN(xb_ld(&bar[SB_TOP(k & 3u)]) < ((k >> 2) + 1u) * nx, bar);
        __builtin_amdgcn_fence(__ATOMIC_ACQUIRE, "agent");
        asm volatile("s_waitcnt vmcnt(0)" ::: "memory");
    }
    __syncthreads();
}

__device__ __forceinline__ void sb_arrive_lead(unsigned* bar, volatile LAS unsigned* st, unsigned k) {
    const unsigned x = xb_xcc_id();
    const unsigned nloc = st[0];
    const unsigned old = xb_add(&bar[SB_XSUB(x, k & 3u)], 1u);
    if (old + 1u == ((k >> 2) + 1u) * nloc) {
        __builtin_amdgcn_fence(__ATOMIC_RELEASE, "agent");
        asm volatile("s_waitcnt vmcnt(0)" ::: "memory");
        xb_add(&bar[SB_TOP(k & 3u)], 1u);
    }
}
__device__ __forceinline__ void sb_arrive_raw(unsigned* bar, volatile LAS unsigned* st, bool lead, unsigned k) {
    asm volatile("s_waitcnt vmcnt(0)" ::: "memory");
    asm volatile("" ::: "memory"); __builtin_amdgcn_s_barrier(); asm volatile("" ::: "memory");
    if (lead) {
        const unsigned x = xb_xcc_id();
        const unsigned nloc = st[0];
        const unsigned old = xb_add(&bar[SB_XSUB(x, k & 3u)], 1u);
        if (old + 1u == ((k >> 2) + 1u) * nloc) {
            __builtin_amdgcn_fence(__ATOMIC_RELEASE, "agent");
            asm volatile("s_waitcnt vmcnt(0)" ::: "memory");
            xb_add(&bar[SB_TOP(k & 3u)], 1u);
        }
    }
}
__device__ __forceinline__ void sb_wait_raw(unsigned* bar, volatile LAS unsigned* st, bool lead, unsigned k) {
    if (lead) {
        const unsigned nx = st[1];
        XB_SPIN(xb_ld(&bar[SB_TOP(k & 3u)]) < ((k >> 2) + 1u) * nx, bar);
        __builtin_amdgcn_fence(__ATOMIC_ACQUIRE, "agent");
        asm volatile("s_waitcnt vmcnt(0)" ::: "memory");
    }
    asm volatile("" ::: "memory"); __builtin_amdgcn_s_barrier(); asm volatile("" ::: "memory");
}

constexpr int LDS_BYTES = 144 * 1024;
constexpr int BAR_LDS_OFF = 128 * 1024 + 256;
constexpr int NORM_LDS_OFF = 128 * 1024 + 1024;
constexpr int VSTRIDE = 320;
constexpr int ATT_V_BYTES = 32 * VSTRIDE;
constexpr int ATT_BIAS_OFF = NWAVES * ATT_V_BYTES;

#define P_x INP(0)
#define P_n1pre INP(1)
#define P_n1post INP(2)
#define P_w1g INP(3)
#define P_w1u INP(4)
#define P_w1d INP(5)
#define P_mpre INP(6)
#define P_mpost INP(7)
#define P_win INP(8)
#define P_btab INP(9)
#define P_cw INP(10)
#define P_cb INP(11)
#define P_wx INP(12)
#define P_bxp INP(13)
#define P_wa INP(14)
#define P_bap INP(15)
#define P_app INP(16)
#define P_wab INP(17)
#define P_wrb INP(18)
#define P_wout INP(19)
#define P_n2pre INP(20)
#define P_n2post INP(21)
#define P_w2g INP(22)
#define P_w2u INP(23)
#define P_w2d INP(24)
#define P_LC WSP(float, WS_LC)
#define P_XS WSP(unsigned long long, WS_XS)
#define P_RSQ0 WSP(float, WS_RSQ0)
#define P_RSQ1 WSP(float, WS_RSQ1)
#define P_RSQ2 WSP(float, WS_RSQ2)
#define P_WGU1 WSP(bf16_t, WS_WGU1)
#define P_WD1 WSP(bf16_t, WS_WD1)
#define P_WIN WSP(bf16_t, WS_WIN)
#define P_WLRU WSP(bf16_t, WS_WLRU)
#define P_WAB WSP(bf16_t, WS_WAB)
#define P_WRB WSP(bf16_t, WS_WRB)
#define P_WOUT WSP(bf16_t, WS_WOUT)
#define P_WGU2 WSP(bf16_t, WS_WGU2)
#define P_WD2 WSP(bf16_t, WS_WD2)
#define P_AB WSP(bf16_t, WS_AB)
#define P_Qb WSP(bf16_t, WS_Q)
#define P_Kb WSP(bf16_t, WS_K)
#define P_Vb WSP(bf16_t, WS_V)
#define P_OG WSP(bf16_t, WS_OG)
#define P_HID WSP(bf16_t, WS_HID)
#define P_Fb WSP(bf16_t, WS_F)
#define P_XR WSP(bf16_t, WS_XR)
#define P_YG WSP(bf16_t, WS_YG)
#define P_GT WSP(bf16_t, WS_GT)
#define P_ATT ((bf16_t*)((unsigned char*)(KARGS()->out) + 64 * MiB))
#define P_XC ((bf16_t*)(KARGS()->out))
#define P_LA WSP(bf16_t, WS_LA)
#define P_BB WSP(bf16_t, WS_BB)
#define P_REC ((bf16_t*)(KARGS()->out))
#define P_MG WSP(bf16_t, WS_MG)
#define P_LSE WSP(float, WS_LSE)
#define P_CA WSP(float, WS_CA)
#define P_CH WSP(float, WS_CH)
#define P_out (KARGS()->out)
constexpr int AR_SLOT = 16384, AR_NSLOT = 3, AR_OSTRIDE = 272, AR_OBYTES = 32 * AR_OSTRIDE;
constexpr int AR_OST = AR_NSLOT * AR_SLOT, AR_BIAS_OFF = AR_OST + NWAVES * AR_OBYTES;
constexpr int AR_BROW = 192, AR_BPAD = 31;
static_assert(AR_BIAS_OFF + NH * AR_BROW * 4 <= 128 * 1024, "attention LDS map");
#define AR_WAIT_V3(sel, a, b, c) asm volatile("s_cmp_eq_u32 %0, 2\n\ts_cbranch_scc0 .Lar_n2%=\n\ts_waitcnt vmcnt(" #a ")\n\ts_branch .Lar_e%=\n.Lar_n2%=:\n\ts_cmp_eq_u32 %0, 1\n\ts_cbranch_scc0 .Lar_n1%=\n\ts_waitcnt vmcnt(" #b ")\n\ts_branch .Lar_e%=\n.Lar_n1%=:\n\ts_waitcnt vmcnt(" #c ")\n.Lar_e%=:" :: "s"(sel) : "memory", "scc")
__device__ __forceinline__ void ar_glds16(const void* gsrc, unsigned lds_dst) { unsigned keep;
    asm volatile("s_mov_b32 %0, m0\n\ts_mov_b32 m0, %2\n\ts_nop 0\n\tglobal_load_lds_dwordx4 %1, off nt\n\ts_mov_b32 m0, %0" : "=&s"(keep) : "v"(gsrc), "s"(lds_dst) : "memory"); }
__device__ __forceinline__ void attn_bias_build(LAS unsigned char* lds, const float* btab_, int tid) {
    LAS float* biasL = (LAS float*)(lds + AR_BIAS_OFF);
    { LAS int* bk = (LAS int*)lds;
      if (tid < 3 * 129) { const int g_ = tid / 129, st = tid % 129; bk[tid] = t5_bucket(st << (2 * g_)); }
      __syncthreads();
      for (int i = tid; i < NH * AR_BROW; i += NTHREADS) { const int head = i / AR_BROW, st = i % AR_BROW - AR_BPAD; const bool in_ = (st >= 0) && (st <= 128);
          biasL[i] = in_ ? btab_[bk[(head >> 2) * 129 + (in_ ? st : 0)] * NH + head] * LOG2E : -INFINITY; }
      __syncthreads(); }
}
template <int RV>
__device__ __forceinline__ void attn_ring_phase(LAS unsigned char* lds, const float* btab_, const bf16_t* Qb_, const bf16_t* Kb_, const bf16_t* Vb_, bf16_t* OG_, float* LSE_, int tid, int lane, int wave, int vcu, int G) {
    LAS float* biasL = (LAS float*)(lds + AR_BIAS_OFF);
    const int qq = lane & 31, hh2 = lane >> 5;
    const unsigned ldsbase = (unsigned)(unsigned long)lds;
    LAS unsigned char* ost = lds + AR_OST + wave * AR_OBYTES;
    const int dr = 4 * wave + (lane >> 4), pos = lane & 15;
    const int kc = pos ^ (dr & 15);
    const int vc = ((((pos >> 2) ^ (dr & 3)) << 2) | (pos & 3));
    const int kread = qq * 256;
    const int trq = (lane & 15) >> 2, trrow = 4 * hh2 + trq;
    const int trcol = ((lane >> 4) & 1) * 32 + (lane & 3) * 8;
    for (int rr = 0; rr < 2; ++rr)
    for (int rid = vcu; rid < 256; rid += G) {
        int b, head, p, q0, R, dsh;
        if (rr == 0) { if (rid < 128) { b = rid >> 5; const int rem = rid & 31; head = rem >> 3; p = 0; q0 = 32 * (rem & 7); dsh = 0; }
                       else { const int a = rid - 128; b = a >> 5; const int rem = a & 31; head = 4 + (rem >> 3); const int r2 = rem & 7; p = r2 >> 1; q0 = 32 * (r2 & 1); dsh = 2; }
                       R = 32; }
        else { b = rid >> 6; const int rem = rid & 63; head = 8 + (rem >> 4); p = rem & 15; q0 = 0; dsh = 4; R = 16; }
        const int g_ = head >> 2, hh = head & 3;
        const size_t rowb = (size_t)b * SEQ + p;
        const bf16_t* Qh = Qb_ + head * HD; const bf16_t* Kh = Kb_ + head * HD + kc * 8; const bf16_t* Vh = Vb_ + head * HD + vc * 8;
        const LAS float* bh = biasL + head * AR_BROW + AR_BPAD;
        const int kstart = (q0 == 0) ? 4 : 0, nsteps = R + 4;
        const int ubase = 32 * (q0 - 4) + dr;
#define AR_DMA(kk, slotoff) do { const size_t tok_ = rowb + ((size_t)(ubase + 32 * (kk)) << dsh); const unsigned ld_ = (unsigned)__builtin_amdgcn_readfirstlane((int)(ldsbase + (unsigned)(slotoff) + (unsigned)wave * 1024u)); \
        ar_glds16(Kh + tok_ * QW, ld_); ar_glds16(Vh + tok_ * QW, ld_ + 8192u); } while (0)
#define AR_LOADQ(dst, iq_) do { const bf16_t* qp_ = Qh + (rowb + ((size_t)(32 * (q0 + (iq_)) + qq) << dsh)) * QW + hh2 * 8; \
        _Pragma("unroll") for (int ks = 0; ks < 8; ++ks) dst[ks] = NTLD((const bf16x8*)(qp_ + ks * 16)); } while (0)
        bf16x8 Qf[8], Qn[8];
        f32x16 O[4];
        float mrun = 0.f, lsum = 0.f;
        int iq = wave;
        bool pend = false; int iq_fin = 0;
        if (iq < R) AR_LOADQ(Qf, iq);
        int slot_cur = 0, slot_n1 = AR_SLOT, slot_n2 = 2 * AR_SLOT;
        if (!(RV & 1)) { AR_DMA(kstart, slot_cur); AR_DMA(kstart + 1, slot_n1); }
        asm volatile("s_waitcnt vmcnt(0)" ::: "memory"); __builtin_amdgcn_s_barrier(); asm volatile("" ::: "memory");
        asm volatile("" : "+v"(Qf[0]), "+v"(Qf[1]), "+v"(Qf[2]), "+v"(Qf[3]), "+v"(Qf[4]), "+v"(Qf[5]), "+v"(Qf[6]), "+v"(Qf[7]));
        for (int k = kstart; k < nsteps; ++k) {
            if (k + 2 < nsteps && !(RV & 1)) AR_DMA(k + 2, slot_n2);
            int nops = 0;
            if (pend && !(RV & 2)) {
                    { const auto rr_ = __builtin_amdgcn_permlane32_swap(__float_as_uint(lsum), __float_as_uint(lsum), false, false); lsum = __uint_as_float(rr_[0]) + __uint_as_float(rr_[1]); }
                    const float inv = 1.f / lsum;
#pragma unroll
                    for (int db = 0; db < 4; ++db)
#pragma unroll
                        for (int a = 0; a < 4; ++a) { u32x2 w; w.x = cvt_pk_bf16(O[db][4 * a] * inv, O[db][4 * a + 1] * inv); w.y = cvt_pk_bf16(O[db][4 * a + 2] * inv, O[db][4 * a + 3] * inv);
                            *(LAS u32x2*)(ost + qq * AR_OSTRIDE + (32 * db + 8 * a + 4 * hh2) * 2) = w; }
                    asm volatile("s_waitcnt lgkmcnt(0)" ::: "memory");
                    bf16_t* og = OG_ + (size_t)g_ * M * 512 + hh * HD;
                    const int u0 = 32 * (q0 + iq_fin);
#pragma unroll
                    for (int i = 0; i < 8; ++i) { const int rowi = i * 4 + (lane >> 4); const u32x4 v = *(const LAS u32x4*)(ost + rowi * AR_OSTRIDE + (lane & 15) * 16);
                        NTST((u32x4*)(og + (rowb + ((size_t)(u0 + rowi) << dsh)) * 512 + (lane & 15) * 8), v); }
                    LSE_[((size_t)g_ * M + rowb + ((size_t)(u0 + qq) << dsh)) * 4 + hh] = mrun + __builtin_amdgcn_logf(lsum);
                    asm volatile("s_waitcnt lgkmcnt(0)" ::: "memory");
                    if (iq_fin + 8 < R) {
#pragma unroll
                        for (int ks = 0; ks < 8; ++ks) Qf[ks] = Qn[ks];
                    }
                pend = false; nops = 2;
            }
            const int j = k - iq;
            const bool active = (iq < R) && (j >= 0);
            if (active && !(RV & 2)) {
                const bool first = (k == (iq > kstart ? iq : kstart));
                if (AR_SKEW && j == 0) __builtin_amdgcn_s_sleep(AR_SKEW);
                if (AR_PRIO == 1) { if (j == 4) __builtin_amdgcn_s_setprio(2); else __builtin_amdgcn_s_setprio(0); }
                if (AR_PRIO == 2) { if (j == 0) __builtin_amdgcn_s_setprio(2); else __builtin_amdgcn_s_setprio(0); }
                if (first) {
#pragma unroll
                    for (int db = 0; db < 4; ++db)
#pragma unroll
                        for (int i = 0; i < 16; ++i) O[db][i] = 0.f;
                    lsum = 0.f;
                    if (iq + 8 < R) { AR_LOADQ(Qn, iq + 8); nops = 1; }
                }
                const LAS unsigned char* ks_ = lds + slot_cur;
                bf16x8 Kf[8];
#pragma unroll
                for (int ks = 0; ks < 8; ++ks) Kf[ks] = *(const LAS bf16x8*)(ks_ + kread + (((2 * ks + hh2) ^ (qq & 15)) << 4));
                if (AR_KPIN) asm volatile("" : "+v"(Kf[0]), "+v"(Kf[1]), "+v"(Kf[2]), "+v"(Kf[3]), "+v"(Kf[4]), "+v"(Kf[5]), "+v"(Kf[6]), "+v"(Kf[7]));
                const LAS float* bp = bh + (128 - 27 - 32 * j + qq - 4 * hh2);
                float bv0[8];
#pragma unroll
                for (int e = 0; e < 8; ++e) bv0[e] = bp[27 - ((e & 3) + 8 * (e >> 2))];
                f32x16 Sx;
#pragma unroll
                for (int i = 0; i < 16; ++i) Sx[i] = 0.f;
#pragma unroll
                for (int ks = 0; ks < 8; ++ks) Sx = __builtin_amdgcn_mfma_f32_32x32x16_bf16(Kf[ks], Qf[ks], Sx, 0, 0, 0);
                float mx = -INFINITY;
                {
#pragma unroll
                    for (int hf = 0; hf < 2; ++hf) {
                        float bv[8];
#pragma unroll
                        for (int e = 0; e < 8; ++e) { const int i = 8 * hf + e; bv[e] = (hf == 0) ? bv0[e] : bp[27 - ((i & 3) + 8 * (i >> 2))]; }
#pragma unroll
                        for (int e = 0; e < 8; ++e) { const int i = 8 * hf + e; const float sc = Sx[i] + bv[e]; Sx[i] = sc; mx = fmaxf(mx, sc); }
                        asm volatile("" ::: "memory");
                    }
                }
                { const auto rr_ = __builtin_amdgcn_permlane32_swap(__float_as_uint(mx), __float_as_uint(mx), false, false); mx = fmaxf(__uint_as_float(rr_[0]), __uint_as_float(rr_[1])); }
                if (first) mrun = mx;
                else if (__any(mx > mrun + 8.0f)) {
                    const float mnew = fmaxf(mrun, mx); const float alpha = __builtin_amdgcn_exp2f(mrun - mnew); mrun = mnew; lsum *= alpha;
#pragma unroll
                    for (int db = 0; db < 4; ++db)
#pragma unroll
                        for (int i = 0; i < 16; ++i) O[db][i] *= alpha;
                }
                float ps = 0.f;
#pragma unroll
                for (int i = 0; i < 16; ++i) { const float pv = __builtin_amdgcn_exp2f(Sx[i] - mrun); Sx[i] = pv; ps += pv; }
                lsum += ps;
                bf16x8 Pf[2];
#pragma unroll
                for (int s = 0; s < 2; ++s) { u32x4 w; w.x = cvt_pk_bf16(Sx[8 * s + 0], Sx[8 * s + 1]); w.y = cvt_pk_bf16(Sx[8 * s + 2], Sx[8 * s + 3]); w.z = cvt_pk_bf16(Sx[8 * s + 4], Sx[8 * s + 5]); w.w = cvt_pk_bf16(Sx[8 * s + 6], Sx[8 * s + 7]);
                    Pf[s] = __builtin_bit_cast(bf16x8, w); }
                asm volatile("" ::: "memory");
                const LAS unsigned char* vs_ = lds + slot_cur + 8192 + trrow * 256 + trcol;
#pragma unroll
                for (int db = 0; db < 4; ++db)
#pragma unroll
                    for (int s = 0; s < 2; ++s) { const LAS unsigned char* ap_ = vs_ + (16 * s) * 256 + ((db ^ trq) << 6);
                        const s16x4 lo = __builtin_bit_cast(s16x4, __builtin_amdgcn_ds_read_tr16_b64_v4i16((LAS s16x4*)ap_));
                        const s16x4 hi = __builtin_bit_cast(s16x4, __builtin_amdgcn_ds_read_tr16_b64_v4i16((LAS s16x4*)(ap_ + 8 * 256)));
                        const bf16x8 Vf = (bf16x8){lo[0], lo[1], lo[2], lo[3], hi[0], hi[1], hi[2], hi[3]};
                        O[db] = __builtin_amdgcn_mfma_f32_32x32x16_bf16(Vf, Pf[s], O[db], 0, 0, 0); }
                if (j == 4) { pend = true; iq_fin = iq; iq += 8; }
            }
            asm volatile("s_waitcnt lgkmcnt(0)" ::: "memory");
            if (RV & 2) { if (active && j == 4) iq += 8; }
            if (k + 2 < nsteps && !(RV & 1)) AR_WAIT_V3(__builtin_amdgcn_readfirstlane(nops), 11, 10, 2);
            else asm volatile("s_waitcnt vmcnt(0)" ::: "memory");
            __builtin_amdgcn_s_barrier(); asm volatile("" ::: "memory");
            { const int t_ = slot_cur; slot_cur = slot_n1; slot_n1 = slot_n2; slot_n2 = t_; }
        }
        if (pend && !(RV & 2)) {
                    { const auto rr_ = __builtin_amdgcn_permlane32_swap(__float_as_uint(lsum), __float_as_uint(lsum), false, false); lsum = __uint_as_float(rr_[0]) + __uint_as_float(rr_[1]); }
                    const float inv = 1.f / lsum;
#pragma unroll
                    for (int db = 0; db < 4; ++db)
#pragma unroll
                        for (int a = 0; a < 4; ++a) { u32x2 w; w.x = cvt_pk_bf16(O[db][4 * a] * inv, O[db][4 * a + 1] * inv); w.y = cvt_pk_bf16(O[db][4 * a + 2] * inv, O[db][4 * a + 3] * inv);
                            *(LAS u32x2*)(ost + qq * AR_OSTRIDE + (32 * db + 8 * a + 4 * hh2) * 2) = w; }
                    asm volatile("s_waitcnt lgkmcnt(0)" ::: "memory");
                    bf16_t* og = OG_ + (size_t)g_ * M * 512 + hh * HD;
                    const int u0 = 32 * (q0 + iq_fin);
#pragma unroll
                    for (int i = 0; i < 8; ++i) { const int rowi = i * 4 + (lane >> 4); const u32x4 v = *(const LAS u32x4*)(ost + rowi * AR_OSTRIDE + (lane & 15) * 16);
                        NTST((u32x4*)(og + (rowb + ((size_t)(u0 + rowi) << dsh)) * 512 + (lane & 15) * 8), v); }
                    LSE_[((size_t)g_ * M + rowb + ((size_t)(u0 + qq) << dsh)) * 4 + hh] = mrun + __builtin_amdgcn_logf(lsum);
                    asm volatile("s_waitcnt lgkmcnt(0)" ::: "memory");
                    if (iq_fin + 8 < R) {
#pragma unroll
                        for (int ks = 0; ks < 8; ++ks) Qf[ks] = Qn[ks];
                    }
            pend = false;
        }
        asm volatile("s_waitcnt lgkmcnt(0)" ::: "memory");
#undef AR_DMA
#undef AR_LOADQ
    }
}

template <int VAR>
__device__ __forceinline__ void attn_phase(LAS unsigned char* lds, const float* btab_, const bf16_t* Qb_, const bf16_t* Kb_, const bf16_t* Vb_, bf16_t* OG_, float* LSE_, int tid, int lane, int wave, int vcu, int G) {
        LAS float* biasL = (LAS float*)(lds + ATT_BIAS_OFF);
        for (int i = tid; i < NH * 129; i += NTHREADS) { const int head = i / 129, st = i % 129, g_ = head >> 2; const int dil = g_ == 0 ? 1 : (g_ == 1 ? 4 : 16);
            biasL[head * 132 + st] = btab_[t5_bucket(st * dil) * NH + head] * LOG2E; }
        __syncthreads();
        LAS unsigned char* vl = lds + wave * ATT_V_BYTES;
        const int qq = lane & 31, hh2 = lane >> 5;
        const int tr_off = ((lane >> 4) >> 1) * 4 * VSTRIDE + (((lane & 15) >> 2)) * VSTRIDE + ((lane >> 4) & 1) * 32 + (lane & 3) * 8;
        for (int wu = vcu; wu < 1536; wu += G) {
            const int b = wu / 384, rem = wu % 384, head = rem >> 5, rem2 = rem & 31;
            const int g_ = head >> 2, hh = head & 3, dsh = 2 * g_;
            const int per = 32 >> dsh;
            const int p = rem2 / per, ub = rem2 % per;
            const int u0 = ub * 256 + wave * 32;
            const size_t rowb = (size_t)b * SEQ + p;
            const bf16_t* Qh = Qb_ + head * HD; const bf16_t* Kh = Kb_ + head * HD; const bf16_t* Vh = Vb_ + head * HD;
            bf16x8 Qf[8];
            { const bf16_t* qp = Qh + (rowb + ((size_t)(u0 + qq) << dsh)) * QW + hh2 * 8;
#pragma unroll
              for (int ks = 0; ks < 8; ++ks) Qf[ks] = *(const bf16x8*)(qp + ks * 16); }
            f32x16 O[4];
#pragma unroll
            for (int db = 0; db < 4; ++db)
#pragma unroll
                for (int i = 0; i < 16; ++i) O[db][i] = 0.f;
            float mrun = -INFINITY, lsum = 0.f;
            const int jstart = (u0 >= 128) ? 0 : (4 - (u0 >> 5));
            bf16x8 Kf[8]; u32x4 vst[8];
            const LAS float* bh = biasL + head * AR_BROW + AR_BPAD;
#define ATT_LOADK(jj) do { const bf16_t* kp = Kh + (rowb + ((size_t)(u0 - 128 + 32 * (jj) + qq) << dsh)) * QW + hh2 * 8; \
    _Pragma("unroll") for (int ks = 0; ks < 8; ++ks) Kf[ks] = *(const bf16x8*)(kp + ks * 16); } while (0)
#define ATT_LOADV(jj) do { _Pragma("unroll") for (int i = 0; i < 8; ++i) { const int rowi = i * 4 + (lane >> 4); \
    vst[i] = *(const u32x4*)(Vh + (rowb + ((size_t)(u0 - 128 + 32 * (jj) + rowi) << dsh)) * QW + (lane & 15) * 8); } } while (0)
            if (!(VAR & 1)) ATT_LOADK(jstart); else { _Pragma("unroll") for (int ks = 0; ks < 8; ++ks) Kf[ks] = Qf[ks]; }
            if (!(VAR & 2)) ATT_LOADV(jstart); else { _Pragma("unroll") for (int i = 0; i < 8; ++i) vst[i] = (u32x4){0x3c003c00u, 0x3c003c00u, 0x3c003c00u, 0x3c003c00u}; }
            for (int j = jstart; j < 5; ++j) {
#pragma unroll
                for (int i = 0; i < 8; ++i) { const int rowi = i * 4 + (lane >> 4); *(LAS u32x4*)(vl + rowi * VSTRIDE + (lane & 15) * 16) = vst[i]; }
                if (j < 4 && !(VAR & 2)) ATT_LOADV(j + 1);
                f32x16 Sx;
#pragma unroll
                for (int i = 0; i < 16; ++i) Sx[i] = 0.f;
#pragma unroll
                for (int ks = 0; ks < 8; ++ks) Sx = __builtin_amdgcn_mfma_f32_32x32x16_bf16(Kf[ks], Qf[ks], Sx, 0, 0, 0);
                if (j < 4 && !(VAR & 1)) ATT_LOADK(j + 1);
                float mx = -INFINITY;
                {
                    const int stb = 128 - 32 * j + qq - 4 * hh2;
#pragma unroll
                    for (int hf = 0; hf < 2; ++hf) {
                        float bv[8];
#pragma unroll
                        for (int e = 0; e < 8; ++e) { const int i = 8 * hf + e; int st = stb - ((i & 3) + 8 * (i >> 2)); st = st < 0 ? 0 : (st > 128 ? 128 : st); bv[e] = bh[st]; }
                        if (j == 0 || j == 4) {
#pragma unroll
                            for (int e = 0; e < 8; ++e) { const int i = 8 * hf + e; const int st = stb - ((i & 3) + 8 * (i >> 2)); const bool ok = (st >= 0) && (st <= 128);
                                const float sc = ok ? Sx[i] + bv[e] : -INFINITY; Sx[i] = sc; mx = fmaxf(mx, sc); }
                        } else {
#pragma unroll
                            for (int e = 0; e < 8; ++e) { const int i = 8 * hf + e; const float sc = Sx[i] + bv[e]; Sx[i] = sc; mx = fmaxf(mx, sc); }
                        }
                        asm volatile("" ::: "memory");
                    }
                }
                mx = fmaxf(mx, __shfl_xor(mx, 32));
                if (j == jstart) mrun = mx;
                else if (__any(mx > mrun + 8.0f)) {
                    const float mnew = fmaxf(mrun, mx); const float alpha = __builtin_amdgcn_exp2f(mrun - mnew); mrun = mnew; lsum *= alpha;
#pragma unroll
                    for (int db = 0; db < 4; ++db)
#pragma unroll
                        for (int i = 0; i < 16; ++i) O[db][i] *= alpha;
                }
                float ps = 0.f;
#pragma unroll
                for (int i = 0; i < 16; ++i) { const float pv = __builtin_amdgcn_exp2f(Sx[i] - mrun); Sx[i] = pv; ps += pv; }
                lsum += ps;
                bf16x8 Pf[2];
#pragma unroll
                for (int s = 0; s < 2; ++s) { u32x4 w; w.x = cvt_pk_bf16(Sx[8 * s + 0], Sx[8 * s + 1]); w.y = cvt_pk_bf16(Sx[8 * s + 2], Sx[8 * s + 3]); w.z = cvt_pk_bf16(Sx[8 * s + 4], Sx[8 * s + 5]); w.w = cvt_pk_bf16(Sx[8 * s + 6], Sx[8 * s + 7]);
                    Pf[s] = __builtin_bit_cast(bf16x8, w); }
                asm volatile("s_waitcnt lgkmcnt(0)" ::: "memory");
                if (VAR & 4) { asm volatile("" :: "v"(Pf[0]), "v"(Pf[1])); } else
#pragma unroll
                for (int db = 0; db < 4; ++db)
#pragma unroll
                    for (int s = 0; s < 2; ++s) {
                        const LAS unsigned char* ap_ = vl + tr_off + (16 * s) * VSTRIDE + 64 * db;
                        const s16x4 lo = __builtin_bit_cast(s16x4, __builtin_amdgcn_ds_read_tr16_b64_v4i16((LAS s16x4*)ap_));
                        const s16x4 hi = __builtin_bit_cast(s16x4, __builtin_amdgcn_ds_read_tr16_b64_v4i16((LAS s16x4*)(ap_ + 8 * VSTRIDE)));
                        const bf16x8 Vf = (bf16x8){lo[0], lo[1], lo[2], lo[3], hi[0], hi[1], hi[2], hi[3]};
                        O[db] = __builtin_amdgcn_mfma_f32_32x32x16_bf16(Vf, Pf[s], O[db], 0, 0, 0);
                    }
                asm volatile("s_waitcnt lgkmcnt(0)" ::: "memory");
            }
#undef ATT_LOADK
#undef ATT_LOADV
            lsum += __shfl_xor(lsum, 32);
            const float inv = 1.f / lsum;
#pragma unroll
            for (int db = 0; db < 4; ++db)
#pragma unroll
                for (int a = 0; a < 4; ++a) { u32x2 w; w.x = cvt_pk_bf16(O[db][4 * a] * inv, O[db][4 * a + 1] * inv); w.y = cvt_pk_bf16(O[db][4 * a + 2] * inv, O[db][4 * a + 3] * inv);
                    *(LAS u32x2*)(vl + qq * VSTRIDE + (32 * db + 8 * a + 4 * hh2) * 2) = w; }
            asm volatile("s_waitcnt lgkmcnt(0)" ::: "memory");
            bf16_t* og = OG_ + (size_t)g_ * M * 512 + hh * HD;
#pragma unroll
            for (int i = 0; i < 8; ++i) { const int rowi = i * 4 + (lane >> 4); const u32x4 v = *(const LAS u32x4*)(vl + rowi * VSTRIDE + (lane & 15) * 16);
                NTST((u32x4*)(og + (rowb + ((size_t)(u0 + rowi) << dsh)) * 512 + (lane & 15) * 8), v); }
            if (hh2 == 0) LSE_[((size_t)g_ * M + rowb + ((size_t)(u0 + qq) << dsh)) * 4 + hh] = mrun + __builtin_amdgcn_logf(lsum);
            asm volatile("s_waitcnt lgkmcnt(0)" ::: "memory");
        }
    }

__global__ void __launch_bounds__(NTHREADS, 2) mk_fwd(Args args) {
    extern __shared__ __attribute__((aligned(16))) unsigned char lds_raw[];
    LAS unsigned char* lds = (LAS unsigned char*)lds_raw;
    cg::grid_group grid = cg::this_grid();
    const int wave_s = __builtin_amdgcn_readfirstlane((int)(threadIdx.x >> 6));
#define TIDX() (wave_s * 64 + lane_id_now())
#define KARGS_EARLY() ({ const Args __attribute__((address_space(4)))* p_ = (const Args __attribute__((address_space(4)))*)__builtin_amdgcn_kernarg_segment_ptr(); p_; })
    volatile LAS unsigned* bst = (volatile LAS unsigned*)(lds + BAR_LDS_OFF);
    if (TIDX() < 2) bst[TIDX()] = 0u;
    __syncthreads();
    (void)xcd_barrier_post((unsigned*)(KARGS_EARLY()->ws), bst, TIDX() == 0);
#define GRID_BAR_RAW() do { XcdBarrier b_; b_.bar = (unsigned*)(KARGS()->ws); b_.x = xb_xcc_id(); b_.st = (volatile LAS unsigned*)(lds + BAR_LDS_OFF); b_.lead = (TIDX() == 0); xcd_barrier(b_); } while (0)
    int bar_idx = 0; (void)bar_idx;
    if (BARSTAT && TIDX() == 0) ((unsigned long long*)(KARGS_EARLY()->ws + 32768))[(14 * 256 + blockIdx.x) * 2 + 1] = __builtin_amdgcn_s_memrealtime();
#define GRID_BAR() do { if (BARSTAT) { const unsigned long long t0_ = __builtin_amdgcn_s_memrealtime(); GRID_BAR_RAW(); const unsigned long long t1_ = __builtin_amdgcn_s_memrealtime(); \
        if (TIDX() == 0) { unsigned long long* wt_ = (unsigned long long*)(KARGS()->ws + 32768); wt_[(bar_idx * 256 + blockIdx.x) * 2] = t1_ - t0_; wt_[(bar_idx * 256 + blockIdx.x) * 2 + 1] = t1_; } ++bar_idx; } else GRID_BAR_RAW(); } while (0)
    const int G = gridDim.x, bx = blockIdx.x;
#define PHASE_IDS() int tid = TIDX(); asm volatile("" : "+v"(tid)); const int lane = tid & 63, wave = __builtin_amdgcn_readfirstlane(tid >> 6); \
    const int vcu = (G % 8 == 0) ? (bx % 8) * (G / 8) + bx / 8 : bx; const int gw = vcu * NWAVES + wave, NGW = G * NWAVES; (void)lane; (void)gw; (void)NGW; (void)vcu;
typedef const Args __attribute__((address_space(4)))* kargs_ptr_t;
#define KARGS() ({ kargs_ptr_t p_ = (kargs_ptr_t)__builtin_amdgcn_kernarg_segment_ptr(); asm volatile("" : "+s"(p_)); p_; })
#define INP(i) (KARGS()->in[i])
#define WSP(T, off) ((T*)(KARGS()->ws + (off)))
    constexpr int I_GU = 16 * 88, I_D = 44 * 32, I_IN = 16 * 272, I_L = 4 * 8, I_AB = 8 * 32, I_SQ = 16 * 32;
    constexpr int NITEMS = 6 * I_GU   + I_IN + 8 * I_L + I_AB + 2 * I_SQ;
    static_assert(I_D == I_GU, "item counts");
    constexpr int P0_LATE = SPLIT_S3 ? NITEMS - 3 * I_GU : NITEMS;
    for (int rep_ = 0; rep_ < 1 + DUP(0); ++rep_) if (PH(0)) { PHASE_IDS();
        LAS float* scr = (LAS float*)(lds + wave * 16384);
#define P0_DECODE(it_, d_) do { int r = (it_); \
            if (p0_job<1>(r, P_w1g, FF, DM, FF, P_n1pre, P_WGU1, DM, 0, d_, lane)) break; \
            if (p0_job<2>(r, P_w1u, FF, DM, FF, P_n1pre, P_WGU1, DM, 0, d_, lane)) break; \
            if (p0_job<0>(r, P_w1d, DM, FF, DM, nullptr, P_WD1, FF, 0, d_, lane)) break; \
            if (p0_job<0>(r, P_win, WINC, DM, 6656, P_mpre, P_WIN, DM, 0, d_, lane)) break;                           \
            if (p0_job<1>(r, P_win + 6656, WINC, DM, DM, P_mpre, P_WIN, DM, 6656, d_, lane)) break;                   \
            if (p0_job<2>(r, P_win + 7680, WINC, DM, DM, P_mpre, P_WIN, DM, 6656, d_, lane)) break;                   \
            bool done = false; \
            _Pragma("unroll 1") for (int h = 0; h < 4 && !done; ++h) { \
                if (p0_job<1>(r, P_wx + (size_t)h * 65536, 256, 256, 256, nullptr, P_WLRU, 256, h * 512, d_, lane)) { done = true; break; } \
                if (p0_job<2>(r, P_wa + (size_t)h * 65536, 256, 256, 256, nullptr, P_WLRU, 256, h * 512, d_, lane)) { done = true; break; } \
            } \
            if (done) break; \
            if (p0_job<0>(r, P_wab, DM, 512, DM, nullptr, P_WAB, DM, 0, d_, lane)) break; \
            if (p0_job<0>(r, P_wrb, DM, DM, DM, nullptr, P_WRB, DM, 0, d_, lane)) break; \
            if (p0_job<0>(r, P_wout, DM, DM, DM, nullptr, P_WOUT, DM, 0, d_, lane)) break; \
            if (p0_job<1>(r, P_w2g, FF, DM, FF, P_n2pre, P_WGU2, DM, 0, d_, lane)) break; \
            if (p0_job<2>(r, P_w2u, FF, DM, FF, P_n2pre, P_WGU2, DM, 0, d_, lane)) break; \
            p0_job<0>(r, P_w2d, DM, FF, DM, nullptr, P_WD2, FF, 0, d_, lane); } while (0)
#define P0_RUN(lo_, hi_) do { P0D dA, dB; float vA[32], vB[32]; f32x4 gA0, gA1, gB0, gB1; \
          int it = (lo_) + gw; \
          if (it < (hi_)) { P0_DECODE(it, dA); p0_load(vA, gA0, gA1, dA, lane); } \
          for (; it < (hi_); it += 2 * NGW) { \
              const int itB = it + NGW; const bool hasB = itB < (hi_); \
              if (hasB) { P0_DECODE(itB, dB); p0_load(vB, gB0, gB1, dB, lane); } \
              p0_finish(vA, gA0, gA1, dA, scr, lane); \
              const int itA2 = it + 2 * NGW; \
              if (itA2 < (hi_)) { P0_DECODE(itA2, dA); p0_load(vA, gA0, gA1, dA, lane); } \
              if (hasB) p0_finish(vB, gB0, gB1, dB, scr, lane); \
          } } while (0)
        P0_RUN(0, SPLIT_P0 ? 2 * I_GU : P0_LATE);
        { float* lc_ = P_LC; const float *bx_ = P_bxp, *ba_ = P_bap, *ap_ = P_app;
          for (int c = gw * 64 + lane; c < DM; c += NGW * 64) { lc_[c] = -bx_[c] * LOG2E; lc_[DM + c] = -ba_[c] * LOG2E; const float nap = -ap_[c]; lc_[2 * DM + c] = -8.f * ((nap > 20.f) ? nap : log1pf(expf(nap))); } }
        { const float* x_ = P_x; bf16_t* AB_ = P_AB; float* RSQ0_ = P_RSQ0;
        for (int row0 = gw; row0 < M; row0 += 4 * NGW) {
            f32x4 a[4][2][2];
#pragma unroll
            for (int q = 0; q < 4; ++q)
#pragma unroll
                for (int j = 0; j < 2; ++j) { const float* xr = x_ + (size_t)(row0 + q * NGW) * DM + 8 * lane + 512 * j; a[q][j][0] = NTLD((const f32x4*)xr); a[q][j][1] = NTLD((const f32x4*)(xr + 4)); }
#pragma unroll
            for (int q = 0; q < 4; ++q) { const int row = row0 + q * NGW; float s = 0.f;
#pragma unroll
                for (int j = 0; j < 2; ++j) { const f32x4 u = a[q][j][0], v = a[q][j][1];
                    s += (u[0] * u[0] + u[1] * u[1]) + (u[2] * u[2] + u[3] * u[3]) + (v[0] * v[0] + v[1] * v[1]) + (v[2] * v[2] + v[3] * v[3]);
                    u32x4 w; w.x = cvt_pk_bf16(u[0], u[1]); w.y = cvt_pk_bf16(u[2], u[3]); w.z = cvt_pk_bf16(v[0], v[1]); w.w = cvt_pk_bf16(v[2], v[3]);
                    *(u32x4*)(AB_ + (size_t)row * DM + 8 * lane + 512 * j) = w; }
                s = wave_sum(s); if (lane == 0) *(f32x4*)(RSQ0_ + 4 * (size_t)row) = (f32x4){s, 0.f, 0.f, 0.f}; }
        } }
        if (SPLIT_P0) { sb_arrive((unsigned*)(KARGS()->ws), (volatile LAS unsigned*)(lds + BAR_LDS_OFF), tid == 0, 0u); P0_RUN(2 * I_GU, P0_LATE); }
    }
    unsigned long long tgs0_ = 0ull; if (BARSTAT >= 320 && BARSTAT < 330) { tgs0_ = __builtin_amdgcn_s_memrealtime(); if (TIDX() == 0) ((unsigned long long*)(KARGS()->ws + 32768))[(13 * 256 + blockIdx.x) * 2 + 1] = tgs0_; }
#define SB_WAIT(k_) do { if (BARSTAT) { const unsigned long long t0_ = __builtin_amdgcn_s_memrealtime(); sb_wait((unsigned*)(KARGS()->ws), (volatile LAS unsigned*)(lds + BAR_LDS_OFF), TIDX() == 0, (k_)); const unsigned long long t1_ = __builtin_amdgcn_s_memrealtime(); \
        if (TIDX() == 0) { unsigned long long* wt_ = (unsigned long long*)(KARGS()->ws + 32768); wt_[(bar_idx * 256 + blockIdx.x) * 2] = t1_ - t0_; wt_[(bar_idx * 256 + blockIdx.x) * 2 + 1] = t1_; } ++bar_idx; } else sb_wait((unsigned*)(KARGS()->ws), (volatile LAS unsigned*)(lds + BAR_LDS_OFF), TIDX() == 0, (k_)); } while (0)
#define SB_ARRIVE(k_) sb_arrive((unsigned*)(KARGS()->ws), (volatile LAS unsigned*)(lds + BAR_LDS_OFF), TIDX() == 0, (k_))
    if (SPLIT_P0) SB_WAIT(0u); else GRID_BAR();
    constexpr bool gg = SPLIT_GG;
    constexpr unsigned K_G1 = SPLIT_P0 ? 1u : 0u, K_G2 = K_G1 + (SPLIT_GG ? 2u : 0u), K_ATT = K_G2 + (SPLIT_GN ? 2u : 0u), K_G3B = K_ATT + (SPLIT_ATT ? 1u : 0u), K_P7 = K_G3B + (SPLIT_G3B ? 1u : 0u), K_LA = K_P7 + (SPLIT_P7 ? 3u : 0u), K_S3 = K_LA + (SPLIT_LA ? 2u : 0u), K_G4W = K_S3 + (SPLIT_S3 ? 1u : 0u),
                       K_G4 = K_G4W + (SPLIT_G4 ? 1u : 0u), K_G4N = K_G4 + (SPLIT_GG ? 2u : 0u), K_G5 = K_G4N + (SPLIT_GN ? 2u : 0u);
    if (KARGS()->ws == nullptr) grid.sync();
    if (BARSTAT == 320 && TIDX() == 0) ((unsigned long long*)(KARGS()->ws + 32768))[(14 * 256 + blockIdx.x) * 2] = __builtin_amdgcn_s_memrealtime() - tgs0_;
    unsigned long long clk0_ = 0ull, rt0_ = 0ull; if (BARSTAT == 300) { clk0_ = __builtin_amdgcn_s_memtime(); rt0_ = __builtin_amdgcn_s_memrealtime(); }

    pg8::StaticOrder SO; SO.wv = wave_s;
    for (int rep_ = 0; rep_ < 1 + DUP(1); ++rep_) if (PH(1)) { pg8::Gemm g{P_AB, DM, P_WGU1, DM, M, 2 * FF, DM, 0, KREP_G1, EREP_G1}; if (gg) { g.sb_bar = (unsigned*)(KARGS()->ws); g.sb_st = (volatile LAS unsigned*)(lds + BAR_LDS_OFF); g.arr_u = 5; g.arr_k = K_G1; } SO.init(M, 2 * FF, G, bx); pg8::EpiSwiGLU E{P_HID, FF, P_RSQ0, (LAS float*)(lds + NORM_LDS_OFF)}; pg8::gemm_phase(lds, g, SO, E); }
    if (BARSTAT == 300 && blockIdx.x == 0 && TIDX() == 0) { const unsigned long long c1_ = __builtin_amdgcn_s_memtime(), r1_ = __builtin_amdgcn_s_memrealtime(); ((float*)(KARGS()->ws + 200 * 1024))[0] = (float)(c1_ - clk0_) / (float)(r1_ - rt0_) * 100.f; }
    if (gg) { SB_ARRIVE(K_G1 + 1u); SB_WAIT(K_G1); } else GRID_BAR();
    for (int rep_ = 0; rep_ < 1 + DUP(2); ++rep_) if (PH(2)) { pg8::Gemm g{P_HID, FF, P_WD1, FF, M, DM, FF, 0}; SO.init(M, DM, G, bx); if (gg) { g.sb_bar = (unsigned*)(KARGS()->ws); g.sb_st = (volatile LAS unsigned*)(lds + BAR_LDS_OFF); g.sb_mode = 3; g.sb_u = 0; g.sb_k = K_G1 + 1u; } if (SPLIT_GN) { g.sb_bar = (unsigned*)(KARGS()->ws); g.sb_st = (volatile LAS unsigned*)(lds + BAR_LDS_OFF); g.arr_u = 0; g.arr_k = K_G2; } if (BARSTAT == 313) g.ts = (unsigned long long*)(KARGS()->ws + 201 * 1024);
        if (FUSED_NORM) { pg8::EpiNormRes<0> E{P_x, P_AB, nullptr, P_n1post, 0.5f, P_XS, 1u, P_RSQ1, lds + NORM_LDS_OFF}; pg8::gemm_phase(lds, g, SO, E); }
        else { pg8::EpiBf16 E{P_Fb, DM}; pg8::gemm_phase(lds, g, SO, E); } }

    if (!FUSED_NORM) GRID_BAR();
    for (int rep_ = 0; rep_ < 1 + DUP(3); ++rep_) if (PH(3) && !FUSED_NORM) { PHASE_IDS(); norm_pass<true, false>(P_Fb, P_AB, P_x, P_n1post, 0.5f, nullptr, P_RSQ1, gw, NGW, lane); }
    if (SPLIT_GN) { SB_ARRIVE(K_G2 + 1u); SB_WAIT(K_G2); } else GRID_BAR();
    for (int rep_ = 0; rep_ < 1 + DUP(4); ++rep_) if (PH(4)) { pg8::Gemm g{P_AB, DM, P_WIN, DM, M, 3 * QW, DM, 0, 1, EREP_G3A}; g.stag = STAG_G3A; if (SPLIT_GN) { g.sb_bar = (unsigned*)(KARGS()->ws); g.sb_st = (volatile LAS unsigned*)(lds + BAR_LDS_OFF); g.sb_mode = 1; g.sb_k = K_G2 + 1u; g.prep_split = 1; }     if ((BARSTAT >= 310 && BARSTAT <= 312) || (BARSTAT >= 342 && BARSTAT <= 349)) g.ts = (unsigned long long*)(KARGS()->ws + 201 * 1024); SO.init(M, 3 * QW, G, bx); pg8::EpiProj<0> E{P_Qb, (size_t)(WS_K - WS_Q) / 2, P_RSQ1, (LAS float*)(lds + NORM_LDS_OFF)}; pg8::gemm_phase(lds, g, SO, E); }
    if (SPLIT_ATT) SB_ARRIVE(K_ATT); else GRID_BAR();
    for (int rep_ = 0; rep_ < 1 + DUP(5); ++rep_) if (PH(5)) { PHASE_IDS();
        attn_bias_build(lds, P_btab, tid);
        if (SPLIT_ATT) SB_WAIT(K_ATT);
        if (ATTN_RING) attn_ring_phase<0>(lds, P_btab, P_Qb, P_Kb, P_Vb, P_OG, P_LSE, tid, lane, wave, vcu, G);
        else attn_phase<0>(lds, P_btab, P_Qb, P_Kb, P_Vb, P_OG, P_LSE, tid, lane, wave, vcu, G);
        if (ATTN_PROBE) attn_ring_phase<ATTN_PROBE>(lds, P_btab, P_Qb, P_Kb, P_Vb, (bf16_t*)(KARGS()->out), (float*)((unsigned char*)(KARGS()->out) + 96 * MiB), tid, lane, wave, vcu, G);
    }
    if (SPLIT_G3B) SB_ARRIVE(K_G3B); else GRID_BAR();
    for (int rep_ = 0; rep_ < 1 + DUP(6); ++rep_) if (PH(6)) { pg8::Gemm g{P_AB, DM, P_WIN + (size_t)3 * QW * DM, DM, M, 4 * DM, DM, 0}; if (SPLIT_G3B) { g.sb_bar = (unsigned*)(KARGS()->ws); g.sb_st = (volatile LAS unsigned*)(lds + BAR_LDS_OFF); g.sb_mode = 1; g.sb_k = K_G3B; } SO.init(M, 4 * DM, G, bx); pg8::EpiProj<1> E{P_XR, (size_t)(WS_YG - WS_XR) / 2, P_RSQ1, (LAS float*)(lds + NORM_LDS_OFF)}; pg8::gemm_phase(lds, g, SO, E); }

    if (SPLIT_P7) SB_ARRIVE(K_P7); else GRID_BAR();
    for (int rep_ = 0; rep_ < 1 + DUP(7); ++rep_) if (PH(7)) { PHASE_IDS();
#define P7_MERGE(msel_) do { \
        for (int row0 = gw; row0 < M / 2; row0 += 4 * NGW) {     \
            const int hh = lane >> 4; float ls[4][3]; u32x4 vv[4][3]; \
        _Pragma("unroll") \
            for (int q = 0; q < 4; ++q) \
        _Pragma("unroll") \
                for (int g_ = 0; g_ < 3; ++g_) { const int i_ = row0 + q * NGW; const size_t row = (size_t)g_ * M + ((((i_ >> 12) << 13) | (i_ & 4095)) | (msel_)); ls[q][g_] = LSE_[row * 4 + hh]; vv[q][g_] = NTLD((const u32x4*)(OG_ + row * 512 + lane * 8)); } \
        _Pragma("unroll") \
            for (int q = 0; q < 4; ++q) { const int i_ = row0 + q * NGW; const int row = (((i_ >> 12) << 13) | (i_ & 4095)) | (msel_); const float l0 = ls[q][0], l1 = ls[q][1], l2 = ls[q][2]; \
                const float mx = fmaxf(l0, fmaxf(l1, l2)); const float e0 = __builtin_amdgcn_exp2f(l0 - mx), e1 = __builtin_amdgcn_exp2f(l1 - mx), e2 = __builtin_amdgcn_exp2f(l2 - mx); \
                const float inv = 1.f / (e0 + e1 + e2); const float a0 = e0 * inv, a1 = e1 * inv, a2 = e2 * inv; \
                const u32x4 v0 = vv[q][0], v1 = vv[q][1], v2 = vv[q][2]; \
                u32x4 o; \
                o.x = cvt_pk_bf16(a0 * bflo(v0.x) + a1 * bflo(v1.x) + a2 * bflo(v2.x), a0 * bfhi(v0.x) + a1 * bfhi(v1.x) + a2 * bfhi(v2.x)); \
                o.y = cvt_pk_bf16(a0 * bflo(v0.y) + a1 * bflo(v1.y) + a2 * bflo(v2.y), a0 * bfhi(v0.y) + a1 * bfhi(v1.y) + a2 * bfhi(v2.y)); \
                o.z = cvt_pk_bf16(a0 * bflo(v0.z) + a1 * bflo(v1.z) + a2 * bflo(v2.z), a0 * bfhi(v0.z) + a1 * bfhi(v1.z) + a2 * bfhi(v2.z)); \
                o.w = cvt_pk_bf16(a0 * bflo(v0.w) + a1 * bflo(v1.w) + a2 * bflo(v2.w), a0 * bfhi(v0.w) + a1 * bfhi(v1.w) + a2 * bfhi(v2.w)); \
                NTST((u32x4*)(ATT_ + (size_t)row * DM + lane * 8), o); } \
        } \
        } while (0)
        { const float* LSE_ = P_LSE; const bf16_t* OG_ = P_OG; bf16_t* ATT_ = P_ATT; if (SPLIT_P7) { P7_MERGE(0); SB_WAIT(K_P7); } }
        const float *cw_ = P_cw, *cb_ = P_cb; const bf16_t* XR_ = P_XR; bf16_t* XC_ = P_XC;
        for (int it = gw; it < (M / 32) * 2; it += NGW) {
            const int rb = it >> 1, c0 = (it & 1) * 512 + lane * 8, r0 = rb * 32, t0 = r0 % SEQ;
            float w[4][8], bias[8];
#pragma unroll
            for (int j = 0; j < 4; ++j)
#pragma unroll
                for (int i = 0; i < 8; ++i) w[j][i] = cw_[j * DM + c0 + i];
#pragma unroll
            for (int i = 0; i < 8; ++i) bias[i] = cb_[c0 + i];
            float xw[3][8];
#pragma unroll
            for (int j = 0; j < 3; ++j) { const int tt = t0 - 3 + j;
                u32x4 v = (u32x4){0u, 0u, 0u, 0u}; if (tt >= 0) v = *(const u32x4*)(XR_ + (size_t)(r0 - 3 + j) * DM + c0);
                xw[j][0] = bflo(v.x); xw[j][1] = bfhi(v.x); xw[j][2] = bflo(v.y); xw[j][3] = bfhi(v.y); xw[j][4] = bflo(v.z); xw[j][5] = bfhi(v.z); xw[j][6] = bflo(v.w); xw[j][7] = bfhi(v.w); }
#pragma unroll 1
            for (int t8 = 0; t8 < 32; t8 += 8) { u32x4 vv[8];
#pragma unroll
              for (int q = 0; q < 8; ++q) vv[q] = NTLD((const u32x4*)(XR_ + (size_t)(r0 + t8 + q) * DM + c0));
#pragma unroll
              for (int q = 0; q < 8; ++q) { const int t = t8 + q; const u32x4 v = vv[q];
                const float x3[8] = {bflo(v.x), bfhi(v.x), bflo(v.y), bfhi(v.y), bflo(v.z), bfhi(v.z), bflo(v.w), bfhi(v.w)}; float o[8];
#pragma unroll
                for (int i = 0; i < 8; ++i) { o[i] = bias[i] + w[0][i] * xw[0][i] + w[1][i] * xw[1][i] + w[2][i] * xw[2][i] + w[3][i] * x3[i]; xw[0][i] = xw[1][i]; xw[1][i] = xw[2][i]; xw[2][i] = x3[i]; }
                u32x4 ov; ov.x = cvt_pk_bf16(o[0], o[1]); ov.y = cvt_pk_bf16(o[2], o[3]); ov.z = cvt_pk_bf16(o[4], o[5]); ov.w = cvt_pk_bf16(o[6], o[7]);
                NTST((u32x4*)(XC_ + (size_t)(r0 + t) * DM + c0), ov); } }
        }
        { const float* LSE_ = P_LSE; const bf16_t* OG_ = P_OG; bf16_t* ATT_ = P_ATT; if (SPLIT_P7) { SB_ARRIVE(K_P7 + 1u); P7_MERGE(4096); SB_ARRIVE(K_P7 + 2u); } else { P7_MERGE(0); P7_MERGE(4096); } }
#undef P7_MERGE
    }
    if (SPLIT_P7) SB_WAIT(K_P7 + 1u); else GRID_BAR();
    for (int rep_ = 0; rep_ < 1 + DUP(8); ++rep_) if (PH(8)) { pg8::Gemm g{P_XC, DM, P_WLRU, 256, M, 2 * DM, 256, 1}; if (SPLIT_LA) { g.sb_bar = (unsigned*)(KARGS()->ws); g.sb_st = (volatile LAS unsigned*)(lds + BAR_LDS_OFF); g.arr_u = 1; g.arr_k = K_LA; } if (SPLIT_P7) { g.sb_bar = (unsigned*)(KARGS()->ws); g.sb_st = (volatile LAS unsigned*)(lds + BAR_LDS_OFF); g.sb_mode = 1; g.sb_u = 2; g.sb_k = K_P7 + 2u; } if (BARSTAT == 315) g.ts = (unsigned long long*)(KARGS()->ws + 201 * 1024); SO.init(M, 2 * DM, G, bx); pg8::EpiLru E{P_XC, P_LC, P_LA, P_BB}; pg8::gemm_phase(lds, g, SO, E); }
    if (SPLIT_LA) { SB_ARRIVE(K_LA + 1u); SB_WAIT(K_LA); } else GRID_BAR();
    for (int rep_ = 0; rep_ < 1 + DUP(9); ++rep_) if (PH(9)) { PHASE_IDS(); const bf16_t *LA_ = P_LA, *BB_ = P_BB; float *CA_ = P_CA, *CH_ = P_CH;
#define S1_ITEM(hf_, ck_, b_) do { const int hf = (hf_), ck = (ck_), b = (b_); const int c0 = hf * 512 + lane * 8; const size_t r0 = (size_t)b * SEQ + ck * 32; \
        float h[8], sl[8]; \
        _Pragma("unroll") for (int i = 0; i < 8; ++i) { h[i] = 0.f; sl[i] = 0.f; } \
        _Pragma("unroll 8") for (int t = 0; t < 32; ++t) { const u32x4 lw = NTLD((const u32x4*)(LA_ + (r0 + t) * DM + c0)), bw = NTLD((const u32x4*)(BB_ + (r0 + t) * DM + c0)); \
            const float l[8] = {bflo(lw.x), bfhi(lw.x), bflo(lw.y), bfhi(lw.y), bflo(lw.z), bfhi(lw.z), bflo(lw.w), bfhi(lw.w)}, bv[8] = {bflo(bw.x), bfhi(bw.x), bflo(bw.y), bfhi(bw.y), bflo(bw.z), bfhi(bw.z), bflo(bw.w), bfhi(bw.w)}; \
            _Pragma("unroll") for (int i = 0; i < 8; ++i) { sl[i] += l[i]; h[i] = __builtin_amdgcn_exp2f(l[i] * LOG2E) * h[i] + bv[i]; } } \
        float* ca = CA_ + ((size_t)(b * 256 + ck)) * DM + c0; float* ch = CH_ + ((size_t)(b * 256 + ck)) * DM + c0; \
        *(f32x4*)ca = (f32x4){sl[0], sl[1], sl[2], sl[3]}; *(f32x4*)(ca + 4) = (f32x4){sl[4], sl[5], sl[6], sl[7]}; \
        *(f32x4*)ch = (f32x4){h[0], h[1], h[2], h[3]}; *(f32x4*)(ch + 4) = (f32x4){h[4], h[5], h[6], h[7]}; } while (0)
    if (SPLIT_LA) {
        const int j = vcu * 4 + (wave & 3);
        const int ckl = ((j >> 1) & 63) | (((j >> 7) & 1) << 7);
        if (wave < 4) S1_ITEM(j & 1, ckl, j >> 8);
        SB_WAIT(K_LA + 1u);
        if (wave < 4) S1_ITEM(j & 1, ckl | 64, j >> 8);
    } else {
        for (int it = gw; it < BATCH * 256 * 2; it += NGW) S1_ITEM(it & 1, (it >> 1) & 255, it >> 9);
    }
#undef S1_ITEM
    }
    if (SPLIT_S3) { SB_ARRIVE(K_S3); { PHASE_IDS(); LAS float* scr = (LAS float*)(lds + wave * 16384); P0_RUN(P0_LATE, NITEMS); } SB_WAIT(K_S3); } else GRID_BAR();
#undef P0_RUN
#undef P0_DECODE
    for (int rep_ = 0; rep_ < 1 + DUP(10); ++rep_) if (PH(10)) { PHASE_IDS(); const bf16_t *LA_ = P_LA, *BB_ = P_BB, *YG_ = P_YG; const float *CA_ = P_CA, *CH_ = P_CH; bf16_t* REC_ = P_REC;
    for (int wu = vcu; wu < 256; wu += G) {
        const int b = wu >> 6, hf = (wu >> 5) & 1, g = wu & 31, ck = 8 * g + wave; const int c0 = hf * 512 + lane * 8; const size_t r0 = (size_t)b * SEQ + ck * 32;
        LAS float* part = (LAS float*)lds;
        float h[8];
        { float pa[8], ph[8];
#pragma unroll
          for (int i = 0; i < 8; ++i) { pa[i] = 0.f; ph[i] = 0.f; }
          { int k = g * wave; const int ke = g * wave + g;
            for (; k + 4 <= ke; k += 4) {
              f32x4 qa0[4], qa1[4], qh0[4], qh1[4];
#pragma unroll
              for (int u = 0; u < 4; ++u) { const float* ca = CA_ + ((size_t)(b * 256 + k + u)) * DM + c0; const float* ch = CH_ + ((size_t)(b * 256 + k + u)) * DM + c0;
                  qa0[u] = *(const f32x4*)ca; qa1[u] = *(const f32x4*)(ca + 4); qh0[u] = *(const f32x4*)ch; qh1[u] = *(const f32x4*)(ch + 4); }
#pragma unroll
              for (int u = 0; u < 4; ++u)
#pragma unroll
                  for (int i = 0; i < 4; ++i) { ph[i] = __builtin_amdgcn_exp2f(qa0[u][i] * LOG2E) * ph[i] + qh0[u][i]; pa[i] += qa0[u][i]; ph[4 + i] = __builtin_amdgcn_exp2f(qa1[u][i] * LOG2E) * ph[4 + i] + qh1[u][i]; pa[4 + i] += qa1[u][i]; } }
            for (; k < ke; ++k) { const float* ca = CA_ + ((size_t)(b * 256 + k)) * DM + c0; const float* ch = CH_ + ((size_t)(b * 256 + k)) * DM + c0;
              const f32x4 a0 = *(const f32x4*)ca, a1 = *(const f32x4*)(ca + 4), h0 = *(const f32x4*)ch, h1 = *(const f32x4*)(ch + 4);
#pragma unroll
              for (int i = 0; i < 4; ++i) { ph[i] = __builtin_amdgcn_exp2f(a0[i] * LOG2E) * ph[i] + h0[i]; pa[i] += a0[i]; ph[4 + i] = __builtin_amdgcn_exp2f(a1[i] * LOG2E) * ph[4 + i] + h1[i]; pa[4 + i] += a1[i]; } } }
          LAS float* pp = part + (wave * 64 + lane) * 16;
          *(LAS f32x4*)pp = (f32x4){pa[0], pa[1], pa[2], pa[3]}; *(LAS f32x4*)(pp + 4) = (f32x4){pa[4], pa[5], pa[6], pa[7]}; *(LAS f32x4*)(pp + 8) = (f32x4){ph[0], ph[1], ph[2], ph[3]}; *(LAS f32x4*)(pp + 12) = (f32x4){ph[4], ph[5], ph[6], ph[7]}; }
        __syncthreads();
#pragma unroll
        for (int i = 0; i < 8; ++i) h[i] = 0.f;
#pragma unroll
        for (int r = 0; r < 8; ++r) { const LAS float* pp = part + (r * 64 + lane) * 16; const f32x4 a0 = *(const LAS f32x4*)pp, a1 = *(const LAS f32x4*)(pp + 4), h0 = *(const LAS f32x4*)(pp + 8), h1 = *(const LAS f32x4*)(pp + 12);
#pragma unroll
            for (int i = 0; i < 4; ++i) { h[i] = __builtin_amdgcn_exp2f(a0[i] * LOG2E) * h[i] + h0[i]; h[4 + i] = __builtin_amdgcn_exp2f(a1[i] * LOG2E) * h[4 + i] + h1[i]; } }
        { int k = 8 * g;
          for (; k + 4 <= ck; k += 4) {
            f32x4 qa0[4], qa1[4], qh0[4], qh1[4];
#pragma unroll
            for (int u = 0; u < 4; ++u) { const float* ca = CA_ + ((size_t)(b * 256 + k + u)) * DM + c0; const float* ch = CH_ + ((size_t)(b * 256 + k + u)) * DM + c0;
                qa0[u] = *(const f32x4*)ca; qa1[u] = *(const f32x4*)(ca + 4); qh0[u] = *(const f32x4*)ch; qh1[u] = *(const f32x4*)(ch + 4); }
#pragma unroll
            for (int u = 0; u < 4; ++u)
#pragma unroll
                for (int i = 0; i < 4; ++i) { h[i] = __builtin_amdgcn_exp2f(qa0[u][i] * LOG2E) * h[i] + qh0[u][i]; h[4 + i] = __builtin_amdgcn_exp2f(qa1[u][i] * LOG2E) * h[4 + i] + qh1[u][i]; } }
          for (; k < ck; ++k) { const float* ca = CA_ + ((size_t)(b * 256 + k)) * DM + c0; const float* ch = CH_ + ((size_t)(b * 256 + k)) * DM + c0;
            const f32x4 a0 = *(const f32x4*)ca, a1 = *(const f32x4*)(ca + 4), h0 = *(const f32x4*)ch, h1 = *(const f32x4*)(ch + 4);
#pragma unroll
            for (int i = 0; i < 4; ++i) { h[i] = __builtin_amdgcn_exp2f(a0[i] * LOG2E) * h[i] + h0[i]; h[4 + i] = __builtin_amdgcn_exp2f(a1[i] * LOG2E) * h[4 + i] + h1[i]; } } }
        __syncthreads();
#pragma unroll 8
        for (int t = 0; t < 32; ++t) { const u32x4 lw = NTLD((const u32x4*)(LA_ + (r0 + t) * DM + c0)), bw = NTLD((const u32x4*)(BB_ + (r0 + t) * DM + c0)), yw = NTLD((const u32x4*)(YG_ + (r0 + t) * DM + c0));
            const float l[8] = {bflo(lw.x), bfhi(lw.x), bflo(lw.y), bfhi(lw.y), bflo(lw.z), bfhi(lw.z), bflo(lw.w), bfhi(lw.w)}, bv[8] = {bflo(bw.x), bfhi(bw.x), bflo(bw.y), bfhi(bw.y), bflo(bw.z), bfhi(bw.z), bflo(bw.w), bfhi(bw.w)},
                        yv[8] = {bflo(yw.x), bfhi(yw.x), bflo(yw.y), bfhi(yw.y), bflo(yw.z), bfhi(yw.z), bflo(yw.w), bfhi(yw.w)};
            float o[8];
#pragma unroll
            for (int i = 0; i < 8; ++i) { h[i] = __builtin_amdgcn_exp2f(l[i] * LOG2E) * h[i] + bv[i]; o[i] = h[i] * gelu_tanh(yv[i]); }
            u32x4 w; w.x = cvt_pk_bf16(o[0], o[1]); w.y = cvt_pk_bf16(o[2], o[3]); w.z = cvt_pk_bf16(o[4], o[5]); w.w = cvt_pk_bf16(o[6], o[7]); NTST((u32x4*)(REC_ + (r0 + t) * DM + c0), w); }
    } }
    if (SPLIT_G4) SB_ARRIVE(K_G4W); else GRID_BAR();
    for (int rep_ = 0; rep_ < 1 + DUP(11); ++rep_) if (PH(11)) { pg8::Gemm g{P_ATT, DM, P_WAB, DM, M, DM, 512 + DM, 0}; g.A2 = P_REC; g.Bt2 = P_WRB; g.ksw = 512 / 64; if (SPLIT_G4) { g.sb_bar = (unsigned*)(KARGS()->ws); g.sb_st = (volatile LAS unsigned*)(lds + BAR_LDS_OFF); g.sb_mode = 2; g.sb_k = K_G4W; } if (gg) { g.sb_bar = (unsigned*)(KARGS()->ws); g.sb_st = (volatile LAS unsigned*)(lds + BAR_LDS_OFF); g.arr_u = 0; g.arr_k = K_G4; } if (BARSTAT == 316 || BARSTAT == 340 || BARSTAT == 341) g.ts = (unsigned long long*)(KARGS()->ws + 201 * 1024); SO.init(M, DM, G, bx); pg8::EpiGate E{P_GT, P_MG}; pg8::gemm_phase(lds, g, SO, E); }

    if (gg) { SB_ARRIVE(K_G4 + 1u); SB_WAIT(K_G4); } else GRID_BAR();
    for (int rep_ = 0; rep_ < 1 + DUP(12); ++rep_) if (PH(12)) { pg8::Gemm g{P_MG, DM, P_WOUT, DM, M, DM, DM, 0}; SO.init(M, DM, G, bx); if (gg) { g.sb_bar = (unsigned*)(KARGS()->ws); g.sb_st = (volatile LAS unsigned*)(lds + BAR_LDS_OFF); g.sb_mode = 3; g.sb_u = 0; g.sb_k = K_G4 + 1u; } if (SPLIT_GN) { g.sb_bar = (unsigned*)(KARGS()->ws); g.sb_st = (volatile LAS unsigned*)(lds + BAR_LDS_OFF); g.arr_u = 0; g.arr_k = K_G4N; } if (BARSTAT == 314) g.ts = (unsigned long long*)(KARGS()->ws + 201 * 1024);
        if (FUSED_NORM) { pg8::EpiNormRes<1> E{nullptr, P_AB, nullptr, P_mpost, 1.0f, P_XS, 2u, P_RSQ2, lds + NORM_LDS_OFF}; pg8::gemm_phase(lds, g, SO, E); }
        else { pg8::EpiBf16 E{P_Fb, DM}; pg8::gemm_phase(lds, g, SO, E); } }

    if (!FUSED_NORM) GRID_BAR();
    for (int rep_ = 0; rep_ < 1 + DUP(13); ++rep_) if (PH(13) && !FUSED_NORM) { PHASE_IDS(); norm_pass<false, false>(P_Fb, P_AB, nullptr, P_mpost, 1.0f, nullptr, P_RSQ2, gw, NGW, lane); }
    if (SPLIT_GN) { SB_ARRIVE(K_G4N + 1u); SB_WAIT(K_G4N); } else GRID_BAR();
    for (int rep_ = 0; rep_ < 1 + DUP(14); ++rep_) if (PH(14)) { pg8::Gemm g{P_AB, DM, P_WGU2, DM, M, 2 * FF, DM, 0}; SO.init(M, 2 * FF, G, bx); if (gg) { g.sb_bar = (unsigned*)(KARGS()->ws); g.sb_st = (volatile LAS unsigned*)(lds + BAR_LDS_OFF); g.arr_u = 5; g.arr_k = K_G5; } if (SPLIT_GN) { g.sb_bar = (unsigned*)(KARGS()->ws); g.sb_st = (volatile LAS unsigned*)(lds + BAR_LDS_OFF); g.sb_mode = 1; g.sb_k = K_G4N + 1u; g.prep_split = 1; }     pg8::EpiSwiGLU E{P_HID, FF, P_RSQ2, (LAS float*)(lds + NORM_LDS_OFF)}; pg8::gemm_phase(lds, g, SO, E); }
    if (gg) { SB_ARRIVE(K_G5 + 1u); SB_WAIT(K_G5); } else GRID_BAR();
    for (int rep_ = 0; rep_ < 1 + DUP(15); ++rep_) if (PH(15)) { pg8::Gemm g{P_HID, FF, P_WD2, FF, M, DM, FF, 0}; SO.init(M, DM, G, bx); if (gg) { g.sb_bar = (unsigned*)(KARGS()->ws); g.sb_st = (volatile LAS unsigned*)(lds + BAR_LDS_OFF); g.sb_mode = 3; g.sb_u = 0; g.sb_k = K_G5 + 1u; }
        if (FUSED_NORM) { pg8::EpiNormRes<2> E{nullptr, P_AB, P_out, P_n2post, 0.5f, P_XS, 3u, nullptr, lds + NORM_LDS_OFF}; pg8::gemm_phase(lds, g, SO, E); }
        else { pg8::EpiBf16 E{P_Fb, DM}; pg8::gemm_phase(lds, g, SO, E); } }
    if (!FUSED_NORM) GRID_BAR();
    for (int rep_ = 0; rep_ < 1 + DUP(16); ++rep_) if (PH(16) && !FUSED_NORM) { PHASE_IDS(); norm_pass<false, true>(P_Fb, P_AB, nullptr, P_n2post, 0.5f, P_out, nullptr, gw, NGW, lane); }
    if (BARSTAT) {
        const unsigned long long tend_ = __builtin_amdgcn_s_memrealtime();
        if (TIDX() == 0) ((unsigned long long*)(KARGS()->ws + 32768))[(15 * 256 + blockIdx.x) * 2 + 1] = tend_;
        GRID_BAR_RAW();
        if (blockIdx.x == 0 && TIDX() == 0) {
            const unsigned long long* wt_ = (const unsigned long long*)(KARGS()->ws + 32768); const int nb_ = bar_idx; float val = 0.f;
            float tot_mean = 0.f, tot_max = 0.f, sel_mean = 0.f;
            for (int bi = 0; bi < nb_; ++bi) { float sm = 0.f, mx_ = 0.f; for (int w_ = 0; w_ < 256; ++w_) { const float d_ = (float)__hip_atomic_load(wt_ + (bi * 256 + w_) * 2, __ATOMIC_RELAXED, __HIP_MEMORY_SCOPE_AGENT) * 0.01f; sm += d_; mx_ = fmaxf(mx_, d_); }
                sm *= (1.f / 256.f); tot_mean += sm; tot_max += mx_; if (bi == BARSTAT - 1) sel_mean = sm; }
            unsigned long long t_first = ~0ull, t_last = 0ull; for (int w_ = 0; w_ < 256; ++w_) { const unsigned long long a_ = __hip_atomic_load(wt_ + (0 * 256 + w_) * 2 + 1, __ATOMIC_RELAXED, __HIP_MEMORY_SCOPE_AGENT), b_ = __hip_atomic_load(wt_ + (15 * 256 + w_) * 2 + 1, __ATOMIC_RELAXED, __HIP_MEMORY_SCOPE_AGENT); if (a_ < t_first) t_first = a_; if (b_ > t_last) t_last = b_; }
            if (BARSTAT >= 200 && BARSTAT < 300) { const int pi_ = BARSTAT - 200; const int ia_ = (pi_ == 0) ? 14 : pi_ - 1, ib_ = (pi_ >= nb_) ? 15 : pi_; unsigned long long ta_ = 0ull, tb_ = 0ull;
                for (int w_ = 0; w_ < 256; ++w_) { const unsigned long long a_ = __hip_atomic_load(wt_ + (ia_ * 256 + w_) * 2 + 1, __ATOMIC_RELAXED, __HIP_MEMORY_SCOPE_AGENT), b_ = __hip_atomic_load(wt_ + (ib_ * 256 + w_) * 2 + 1, __ATOMIC_RELAXED, __HIP_MEMORY_SCOPE_AGENT); if (a_ > ta_) ta_ = a_; if (b_ > tb_) tb_ = b_; }
                val = ((float)(tb_ - ta_) * 0.01f - (float)BAROFF) * (float)BARSCL; if (BARQ > 0) val = floorf(val / (float)BARQ) * (float)BARQ; }
            else if (BARSTAT >= 500 && BARSTAT < 756) { const int ia_ = (BARSTAT - 500) / 16, ib_ = (BARSTAT - 500) % 16; unsigned long long ta_ = 0ull, tb_ = 0ull;
                for (int w_ = 0; w_ < 256; ++w_) { const unsigned long long a_ = __hip_atomic_load(wt_ + (ia_ * 256 + w_) * 2 + 1, __ATOMIC_RELAXED, __HIP_MEMORY_SCOPE_AGENT), b_ = __hip_atomic_load(wt_ + (ib_ * 256 + w_) * 2 + 1, __ATOMIC_RELAXED, __HIP_MEMORY_SCOPE_AGENT); if (a_ > ta_) ta_ = a_; if (b_ > tb_) tb_ = b_; }
                val = (float)(tb_ - ta_) * 0.01f - (float)BAROFF; if (BARQ > 0) val = floorf(val / (float)BARQ) * (float)BARQ; }
            else if (BARSTAT >= 400 && BARSTAT < 460) { const int bi = (BARSTAT - 400) % 20, md = (BARSTAT - 400) / 20; unsigned long long mn = ~0ull, mx2 = 0ull; double sm = 0.0;
                unsigned long long mxe = 0ull;
                for (int w_ = 0; w_ < 256; ++w_) { const unsigned long long w8 = __hip_atomic_load(wt_ + (bi * 256 + w_) * 2, __ATOMIC_RELAXED, __HIP_MEMORY_SCOPE_AGENT), e8 = __hip_atomic_load(wt_ + (bi * 256 + w_) * 2 + 1, __ATOMIC_RELAXED, __HIP_MEMORY_SCOPE_AGENT);
                    const unsigned long long a8 = e8 - w8; if (a8 < mn) mn = a8; if (a8 > mx2) mx2 = a8; if (e8 > mxe) mxe = e8; sm += (double)(a8 & 0xffffffffull); }
                const double mean_lo = sm / 256.0; const double mx_lo = (double)(mx2 & 0xffffffffull);
                val = (md == 0) ? (float)(mx2 - mn) * 0.01f : (md == 1) ? (float)(mx_lo - mean_lo) * 0.01f : (float)(mxe - mx2) * 0.01f; }
            else if (BARSTAT >= 350 && BARSTAT < 360) { const unsigned long long* t_ = (const unsigned long long*)(KARGS()->ws + 203 * 1024); const int w_ = (BARSTAT - 350) >> 1, q_ = (BARSTAT - 350) & 1;
                val = q_ == 0 ? (float)t_[w_ * 4 + 0] / (float)t_[w_ * 4 + 2] : (float)t_[w_ * 4 + 1] / (float)t_[w_ * 4 + 3]; }
            else if (BARSTAT >= 346 && BARSTAT <= 349) { const unsigned long long* t_ = (const unsigned long long*)(KARGS()->ws + 201 * 1024); const int k_ = BARSTAT - 346; val = (float)(t_[7 + k_] - t_[6 + k_]) * 0.1f; }
            else if (BARSTAT == 344) { const unsigned long long* t_ = (const unsigned long long*)(KARGS()->ws + 201 * 1024); val = ((float)(t_[4] - t_[5]) * 0.01f - 19.f) * 10.f; }
            else if (BARSTAT >= 340 && BARSTAT <= 345) { const unsigned long long* t_ = (const unsigned long long*)(KARGS()->ws + 201 * 1024); val = (float)(t_[5] - t_[4]) * 0.1f; }
            else if (BARSTAT >= 330 && BARSTAT < 340) { const unsigned long long* t_ = (const unsigned long long*)(KARGS()->ws + 202 * 1024); const int k_ = BARSTAT - 330; val = (float)(t_[k_ + 1] - t_[k_]) * 0.1f; }
            else if (BARSTAT == 321 || BARSTAT == 322) { unsigned long long mn = ~0ull, mx_ = 0ull; for (int w_ = 0; w_ < 256; ++w_) { const unsigned long long a_ = __hip_atomic_load(wt_ + (13 * 256 + w_) * 2 + 1, __ATOMIC_RELAXED, __HIP_MEMORY_SCOPE_AGENT); if (a_ < mn) mn = a_; if (a_ > mx_) mx_ = a_; }
                unsigned long long rel = 0ull; for (int w_ = 0; w_ < 256; ++w_) { const unsigned long long a_ = __hip_atomic_load(wt_ + (14 * 256 + w_) * 2 + 1, __ATOMIC_RELAXED, __HIP_MEMORY_SCOPE_AGENT); if (a_ > rel) rel = a_; }
                val = (BARSTAT == 321) ? (float)(mx_ - mn) * 0.01f : (float)(rel - mx_) * 0.01f; }
            else if (BARSTAT == 320) { float sm = 0.f; for (int w_ = 0; w_ < 256; ++w_) sm += (float)__hip_atomic_load(wt_ + (14 * 256 + w_) * 2, __ATOMIC_RELAXED, __HIP_MEMORY_SCOPE_AGENT) * 0.01f; val = sm * (1.f / 256.f); }
            else if (BARSTAT >= 310) { const unsigned long long* t_ = (const unsigned long long*)(KARGS()->ws + 201 * 1024); const int a_ = (BARSTAT == 310) ? 0 : (BARSTAT == 311 ? 2 : 1), b_ = (BARSTAT == 310) ? 1 : (BARSTAT == 311 ? 3 : 2);     val = (float)(t_[b_] - t_[a_]) * 0.01f; if (BARSTAT == 310 || BARSTAT == 311) val *= 10.f; }
            else if (BARSTAT == 300) val = (((const float*)(KARGS()->ws + 200 * 1024))[0] - 1500.f) * 0.1f;
            else if (BARSTAT == 100) val = tot_mean; else if (BARSTAT == 101) val = tot_max; else if (BARSTAT == 103) { unsigned long long tb0 = 0ull; for (int w_ = 0; w_ < 256; ++w_) { const unsigned long long a_ = __hip_atomic_load(wt_ + (0 * 256 + w_) * 2 + 1, __ATOMIC_RELAXED, __HIP_MEMORY_SCOPE_AGENT); if (a_ > tb0) tb0 = a_; } val = (float)(t_last - tb0) * 0.01f - (float)BAROFF; }
            else if (BARSTAT == 102) { val = (float)(t_last - t_first) * 0.01f - (float)BAROFF; if (BARQ > 0) val = floorf(val / (float)BARQ) * (float)BARQ; } else val = sel_mean;
            KARGS()->out[0] = val;
        }
    }
}

extern "C" void kernel_launch(void* const* d_in, const int* in_sizes, int n_in, void* d_out, int out_size, void* d_ws, size_t ws_size, hipStream_t stream) {
    static int grid = 0;
    if (grid == 0) {
        if (n_in != 25 || out_size != M * DM || ws_size < WS_END) { fprintf(stderr, "kernel_launch: unexpected shapes (n_in %d out %d ws %zu)\n", n_in, out_size, ws_size); grid = -1; return; }
        int dev = 0, cus = 0, per_cu = 0;
        hipGetDevice(&dev); hipDeviceGetAttribute(&cus, hipDeviceAttributeMultiprocessorCount, dev);
        hipFuncSetAttribute((const void*)mk_fwd, hipFuncAttributeMaxDynamicSharedMemorySize, LDS_BYTES);
        hipOccupancyMaxActiveBlocksPerMultiprocessor(&per_cu, (const void*)mk_fwd, NTHREADS, LDS_BYTES);
        if (per_cu < 1) { fprintf(stderr, "kernel_launch: occupancy query says %d blocks per CU\n", per_cu); per_cu = 1; }
        grid = cus;
        if ((SPLIT_GG || SPLIT_GN || SPLIT_LA) && cus != 256) { fprintf(stderr, "kernel_launch: this build's GEMM->GEMM seams assume 256 CUs (found %d)\n", cus); grid = -1; return; }
        fprintf(stderr, "kernel_launch: cus %d per_cu %d grid %d\n", cus, per_cu, grid);
    }
    if (grid < 0) return;
    if (hipMemsetAsync(d_ws, 0, 65536, stream) != hipSuccess) { fprintf(stderr, "kernel_launch: memset failed\n"); return; }
    Args a{};
    for (int i = 0; i < 25; ++i) a.in[i] = (const float*)d_in[i];
    a.out = (float*)d_out; a.ws = (unsigned char*)d_ws;
    void* kargs[] = {&a};
    hipError_t e = hipLaunchCooperativeKernel((const void*)mk_fwd, dim3(grid), dim3(NTHREADS), kargs, LDS_BYTES, stream);
    if (e != hipSuccess) fprintf(stderr, "cooperative launch failed: %s (grid %d)\n", hipGetErrorString(e), grid);
}
```

```cpp
#include <hip/hip_runtime.h>
#include <hip/hip_cooperative_groups.h>
#include <cstdio>
#include <cstdint>
#include <cmath>
namespace cg = cooperative_groups;

#define LAS __attribute__((address_space(3)))
typedef unsigned short bf16_t;
typedef short bf16x8 __attribute__((ext_vector_type(8)));
typedef float f32x4 __attribute__((ext_vector_type(4)));
typedef float f32x16 __attribute__((ext_vector_type(16)));
typedef unsigned u32x4 __attribute__((ext_vector_type(4)));
typedef unsigned u32x2 __attribute__((ext_vector_type(2)));
typedef short s16x4 __attribute__((ext_vector_type(4)));

#ifndef PHMASK
#define PHMASK 0x1FFFF
#endif
#define PH(n) ((PHMASK >> (n)) & 1)
#ifndef DUPMASK
#define DUPMASK 0
#endif
#define DUP(n) ((DUPMASK >> (n)) & 1)
#ifndef NTSTORE
#define NTSTORE 2
#endif
#ifndef NT_NORM
#define NT_NORM 0
#endif
#ifndef NT_LOADS
#define NT_LOADS 1
#endif
#define NTLD(p) (NT_LOADS ? __builtin_nontemporal_load(p) : *(p))
#ifndef NT_OUT
#define NT_OUT 1
#endif
#define ST16_WT(p, v) asm volatile("global_store_dwordx4 %0, %1, off sc1\n\ts_nop 1" :: "v"(p), "v"(v) : "memory")
#define EPI_ST16(p, v) do { if (NTSTORE == 2) { asm volatile("global_store_dwordx4 %0, %1, off sc1\n\ts_nop 1" :: "v"((u32x4*)(p)), "v"(v) : "memory"); } else if (NTSTORE == 1) __builtin_nontemporal_store((v), (u32x4*)(p)); else *(u32x4*)(p) = (v); } while (0)
#ifndef EREP_G1
#define EREP_G1 1
#endif
#ifndef EREP_G3A
#define EREP_G3A 1
#endif
#ifndef BARSTAT
#define BARSTAT 0
#endif
#ifndef TS_MODE
#define TS_MODE 0
#define BAROFF 0
#define BARSCL 1
#define BARQ 0
#define AR_SKEW 0
#define AR_PRIO 0
#define SPLIT_P7 1
#define SPLIT_GG 1
#define SPLIT_LA 1
#define SPLIT_S3 1
#define SPLIT_GN 1
#define SPLIT_ATT 1
#define SPLIT_G3B 1
#define SPLIT_G4 1
#define SPLIT_P0 1
#define ZACC 3
#define STAG_G3A 0
#define AR_KPIN 0
#endif
#ifndef ATTN_RING
#define ATTN_RING 1
#endif
#ifndef RELAX_VM
#define RELAX_VM 1
#endif
#ifndef FUSED_NORM
#define FUSED_NORM 1
#endif
#ifndef ATTN_PROBE
#define ATTN_PROBE 0
#endif
#ifndef KREP_G1
#define KREP_G1 1
#endif

constexpr int BATCH = 4, SEQ = 8192, DM = 1024, M = BATCH * SEQ, FF = 2816, NH = 12, HD = 128, QW = 1536, WINC = 8704;
constexpr float EPS = 1e-6f;
constexpr float LOG2E = 1.4426950408889634f;
constexpr float C2 = 0.08838834764831845f * 1.4426950408889634f;
constexpr int NWAVES = 8, NTHREADS = 512;

constexpr size_t MiB = 1u << 20;
constexpr size_t WS_RSQ0 = 508 * MiB, WS_RSQ1 = WS_RSQ0 + 512 * 1024, WS_RSQ2 = WS_RSQ1 + 512 * 1024;
constexpr size_t WS_LC = 128 * 1024;
constexpr size_t WS_XS = 508 * MiB + 1536 * 1024;
constexpr size_t WS_WGU1 = 1 * MiB, WS_WD1 = 12 * MiB, WS_WIN = 18 * MiB, WS_WLRU = 35 * MiB, WS_WAB = 58 * MiB  , WS_WRB = 37 * MiB, WS_WOUT = 39 * MiB, WS_WGU2 = 41 * MiB, WS_WD2 = 52 * MiB;
constexpr size_t WS_LSE = 510 * MiB + 512 * 1024;
constexpr size_t WS_AB = 60 * MiB;
constexpr size_t WS_Q = 124 * MiB, WS_K = 220 * MiB, WS_V = 316 * MiB;
constexpr size_t WS_OG = 412 * MiB;
constexpr size_t WS_HID = 124 * MiB;
constexpr size_t WS_F = 300 * MiB;
constexpr size_t WS_XR = 124 * MiB, WS_YG = 188 * MiB, WS_GT = 252 * MiB, WS_ATT = 380 * MiB, WS_XC = 60 * MiB;
constexpr size_t WS_LA = 124 * MiB, WS_BB = 412 * MiB, WS_CA = 476 * MiB, WS_CH = 480 * MiB;
constexpr size_t WS_REC = 60 * MiB, WS_MG = 124 * MiB;
constexpr size_t WS_END = 512 * MiB;
static_assert(WS_V - WS_K == WS_K - WS_Q && WS_GT - WS_YG == WS_YG - WS_XR, "section strides");

__device__ __forceinline__ float bf2f(unsigned short h) { return __uint_as_float((unsigned)h << 16); }
__device__ __forceinline__ float bflo(unsigned w) { return __uint_as_float(w << 16); }
__device__ __forceinline__ float bfhi(unsigned w) { return __uint_as_float(w & 0xffff0000u); }
typedef float f32x2_t __attribute__((ext_vector_type(2))); typedef __bf16 bf16x2_t __attribute__((ext_vector_type(2)));
__device__ __forceinline__ unsigned cvt_pk_bf16(float lo, float hi) { const f32x2_t v = {lo, hi}; const bf16x2_t b = __builtin_convertvector(v, bf16x2_t); return __builtin_bit_cast(unsigned, b); }
__device__ __forceinline__ float wave_sum(float v) {
#pragma unroll
    for (int o = 1; o < 64; o <<= 1) v += __shfl_xor(v, o);
    return v;
}
__device__ __forceinline__ float fast_sigmoid(float x) { return __builtin_amdgcn_rcpf(1.f + __builtin_amdgcn_exp2f(-x * LOG2E)); }
__device__ __forceinline__ float gelu_tanh(float x) {
    const float u = 0.7978845608028654f * (x + 0.044715f * x * x * x);
    return x * fast_sigmoid(2.f * u);
}

__device__ __forceinline__ int lane_id_now() { unsigned z_ = 0u; asm volatile("" : "+s"(z_)); return (int)__builtin_amdgcn_mbcnt_hi(~0u, __builtin_amdgcn_mbcnt_lo(~0u, z_)); }
__device__ __forceinline__ void dbg_stamp(int idx) { const unsigned long long __attribute__((address_space(4)))* ka = (const unsigned long long __attribute__((address_space(4)))*)__builtin_amdgcn_kernarg_segment_ptr(); unsigned long long* p_ = (unsigned long long*)((unsigned char*)ka[26] + 201 * 1024); p_[idx] = __builtin_amdgcn_s_memrealtime(); }
__device__ __forceinline__ void sb_arrive_lead(unsigned* bar, volatile LAS unsigned* st, unsigned k);
__device__ __forceinline__ void sb_arrive_raw(unsigned* bar, volatile LAS unsigned* st, bool lead, unsigned k);
__device__ __forceinline__ void sb_wait_raw(unsigned* bar, volatile LAS unsigned* st, bool lead, unsigned k);
namespace pg8 {
constexpr int BM = 256, BK = 64, HALF = 128, HTB = HALF * BK * 2, STAGE_BYTES = 8 * HTB, NXCD = 8, WGM = 8;
__host__ __device__ __forceinline__ int lds_byte(int r, int c) { const int st = (r >> 4) * 2 + (c >> 5), rr = r & 15, cc = c & 31, ob = rr * 64 + cc * 2; return st * 1024 + (ob ^ (((ob >> 9) & 1) << 5)); }
__host__ __device__ __forceinline__ void stage_rc(int b, int& R, int& C) { const int st = b / 1024, sb = b % 1024, swz = sb ^ (((sb >> 9) & 1) << 5); R = (st >> 1) * 16 + swz / 64; C = (st & 1) * 32 + (swz % 64) / 2; }
__host__ __device__ __forceinline__ int perm32(int rho) { const int n = rho >> 4, i = rho & 15; return 8 * (i >> 2) + 4 * n + (i & 3); }

struct Unit { int pm, pn; };
struct Gemm { const bf16_t* A; int lda; const bf16_t* Bt; int ldb; int M, N, K; int amode; int krep = 1; int erep = 1;
              const bf16_t* A2 = nullptr; const bf16_t* Bt2 = nullptr; int ksw = 1 << 20; unsigned long long* ts = nullptr; int stag = 0;
              unsigned* sb_bar = nullptr; volatile LAS unsigned* sb_st = nullptr; int sb_mode = 0; unsigned sb_k = 0; int sb_u = 0; int arr_u = -1; unsigned arr_k = 0; int prep_split = 0; };

static_assert((M / 256) % 8 == 0, "StaticOrder::next assumes full row groups");
struct StaticOrder {
    int nM, nN, nwg, G, c; int wv;
    __device__ void init(int M_, int N_, int G_, int c_) { nM = M_ / BM; nN = N_ / BM; nwg = nM * nN; G = G_; c = c_; }
    __device__ bool next(int i, Unit& u) const {
        const long L = (long)i * G + c; if (L >= nwg) return false;
        int wgid = (int)L; { const int q = nwg / NXCD, r = nwg % NXCD, xcd = wgid % NXCD, off = wgid / NXCD; wgid = (xcd < r ? xcd * (q + 1) : r * (q + 1) + (xcd - r) * q) + off; }
        const int nig = WGM * nN, gid = wgid / nig, fm = gid * WGM;
        u.pm = fm + ((wgid % nig) % WGM); u.pn = (wgid % nig) / WGM; return true;
    }
};

template <class Epi>
__device__ __forceinline__ void gemm_phase(LAS unsigned char* lds, const Gemm g, const StaticOrder& S, const Epi& E) {
    int tid = S.wv * 64 + lane_id_now(); asm volatile("" : "+v"(tid));
    const int wid = __builtin_amdgcn_readfirstlane(tid >> 6), lane = tid & 63, wr = wid >> 2, wc = wid & 3, fr = lane & 15, fq = lane >> 4;
    const int K = g.K, nt = K / BK;
    unsigned voffA[2], voffB[2];
#pragma unroll
    for (int i = 0; i < 2; ++i) { int R, C; stage_rc(tid * 16 + i * 8192, R, C); const int Rb = (R & ~31) + perm32(R & 31);
        voffA[i] = (unsigned)(R * g.lda + C) * 2u; voffB[i] = (unsigned)(Rb * g.ldb + C) * 2u; }
    const size_t kstep = (size_t)(BK * 2);
    const size_t hstepA = (size_t)HALF * g.lda * 2, hstepB = (size_t)HALF * g.ldb * 2;
    const unsigned ldsw = (unsigned)wid * 1024u;
    const int aoff = lds_byte(wr * 64 + fr, fq * 8), boff = lds_byte(wc * 32 + fr, fq * 8);
#define PG8_SA(b, h) (((b) * 2 + (h)) * HTB)
#define PG8_SB(b, h) ((4 + (b) * 2 + (h)) * HTB)
#define PG8_STAGE(bufoff, gbase, voff) do { _Pragma("unroll") for (int _i = 0; _i < 2; ++_i) \
        __builtin_amdgcn_global_load_lds((const unsigned*)((const char*)(gbase) + (voff)[_i]), (LAS unsigned*)(lds + (bufoff) + ldsw + _i * 8192), 16, 0, 0); } while (0)
#define PG8_LDA(dst, b, h) do { _Pragma("unroll") for (int m = 0; m < 4; ++m) _Pragma("unroll") for (int k = 0; k < 2; ++k) dst[m][k] = *(const LAS bf16x8*)(lds + PG8_SA(b, h) + aoff + m * 2048 + k * 1024); } while (0)
#define PG8_LDB(dst, b, h) do { _Pragma("unroll") for (int n = 0; n < 2; ++n) _Pragma("unroll") for (int k = 0; k < 2; ++k) dst[n][k] = *(const LAS bf16x8*)(lds + PG8_SB(b, h) + boff + n * 2048 + k * 1024); } while (0)
#define PG8_MMA(ai, bj, At, Bt) do { __builtin_amdgcn_s_setprio(1); _Pragma("unroll") for (int m = 0; m < 4; ++m) _Pragma("unroll") for (int n = 0; n < 2; ++n) _Pragma("unroll") for (int k = 0; k < 2; ++k) \
        acc[ai][bj][m][n] = __builtin_amdgcn_mfma_f32_16x16x32_bf16(Bt[n][k], At[m][k], acc[ai][bj][m][n], 0, 0, 0); __builtin_amdgcn_s_setprio(0); } while (0)
#define PG8_MMAZ(ai, bj, At, Bt) do { __builtin_amdgcn_s_setprio(1); _Pragma("unroll") for (int m = 0; m < 4; ++m) _Pragma("unroll") for (int n = 0; n < 2; ++n) { \
        acc[ai][bj][m][n] = __builtin_amdgcn_mfma_f32_16x16x32_bf16(Bt[n][0], At[m][0], (f32x4){0.f, 0.f, 0.f, 0.f}, 0, 0, 0); acc[ai][bj][m][n] = __builtin_amdgcn_mfma_f32_16x16x32_bf16(Bt[n][1], At[m][1], acc[ai][bj][m][n], 0, 0, 0); } __builtin_amdgcn_s_setprio(0); } while (0)
#define PG8_WAIT_V(n) asm volatile("s_waitcnt vmcnt(" #n ")" ::: "memory")
#define PG8_WAIT_V_SEL(sel, a, b) asm volatile("s_cmp_eq_u32 %0, 0\n\ts_cbranch_scc1 .Lwv_b%=\n\ts_waitcnt vmcnt(" #a ")\n\ts_branch .Lwv_e%=\n.Lwv_b%=:\n\ts_waitcnt vmcnt(" #b ")\n.Lwv_e%=:" :: "s"(sel) : "memory", "scc")
#define PG8_WAIT_L(n) asm volatile("s_waitcnt lgkmcnt(" #n ")" ::: "memory")
#define PG8_BAR __builtin_amdgcn_s_barrier()
#define PG8_SCHED __builtin_amdgcn_sched_barrier(0)
#define PG8_APTR(u) ((const char*)g.A + (size_t)(u).pm * 2 * hstepA + (g.amode == 1 ? (size_t)(((u).pn >> 1) * 256 * 2) : (size_t)0))
#define PG8_BPTR(u) ((const char*)g.Bt + (size_t)(u).pn * 2 * hstepB)
#define PG8_APTR2(u) ((const char*)g.A2 + (size_t)(u).pm * 2 * hstepA - (size_t)g.ksw * kstep)
#define PG8_BPTR2(u) ((const char*)g.Bt2 + (size_t)(u).pn * 2 * hstepB - (size_t)g.ksw * kstep)
    Unit cur, nxt; int ui = 0; bool after_epi = false;
    if (!S.next(0, cur)) return;
    f32x4 acc[2][2][4][2];
#pragma unroll
    for (int a = 0; a < 2; ++a)
#pragma unroll
        for (int b = 0; b < 2; ++b)
#pragma unroll
            for (int m = 0; m < 4; ++m)
#pragma unroll
                for (int n = 0; n < 2; ++n) acc[a][b][m][n] = (f32x4){0.f, 0.f, 0.f, 0.f};
    bf16x8 At[4][2], B0[2][2], B1[2][2];
    const char* cA = PG8_APTR(cur); const char* cB = PG8_BPTR(cur);
    if (BARSTAT >= 310 && g.ts && blockIdx.x == 0 && tid == 0) g.ts[0] = __builtin_amdgcn_s_memrealtime();
    const int pm_first = cur.pm;
    E.prep(cur.pm, tid, g.prep_split ? 1 : 0);
    if (g.stag > 0) { const int n_ = ((blockIdx.x >> 3) & 3) * g.stag; for (int i_ = 0; i_ < n_; ++i_) __builtin_amdgcn_s_sleep(8); }
    PG8_STAGE(PG8_SB(0, 0), cB, voffB); PG8_STAGE(PG8_SB(0, 1), cB + hstepB, voffB); PG8_STAGE(PG8_SA(0, 0), cA, voffA); PG8_STAGE(PG8_SA(0, 1), cA + hstepA, voffA);
    if (wr == 1) PG8_BAR;
    PG8_WAIT_V(2); PG8_BAR;
    PG8_STAGE(PG8_SB(1, 0), cB + kstep, voffB); PG8_STAGE(PG8_SA(1, 0), cA + kstep, voffA); PG8_STAGE(PG8_SB(1, 1), cB + hstepB + kstep, voffB);
    PG8_WAIT_V(6); PG8_BAR;
    if (BARSTAT >= 310 && g.ts && blockIdx.x == 0 && tid == 0) g.ts[1] = __builtin_amdgcn_s_memrealtime();
    for (;;) {
        const bool has_next = S.next(ui + 1, nxt);
        const char* nA0 = has_next ? PG8_APTR(nxt) : cA; const char* nB0 = has_next ? PG8_BPTR(nxt) : cB;
        const char* cA2 = g.A2 ? PG8_APTR2(cur) : cA; const char* cB2 = g.A2 ? PG8_BPTR2(cur) : cB;
        const char* nA = nA0; const char* nB = nB0;
#define PG8_PAIR(t, MMAF, WAIT12) do { \
            const bool last = ((t) == nt - 2); \
            const char* a1 = (((t) + 1) < g.ksw ? cA : cA2) + (size_t)((t) + 1) * kstep; \
            const char* a2 = last ? nA : (((t) + 2) < g.ksw ? cA : cA2) + (size_t)((t) + 2) * kstep; const char* b2 = last ? nB : (((t) + 2) < g.ksw ? cB : cB2) + (size_t)((t) + 2) * kstep; \
            const char* a3 = a2 + kstep; const char* b3 = b2 + kstep; \
            PG8_LDB(B0, 0, 0); PG8_LDB(B1, 0, 1); PG8_SCHED; PG8_LDA(At, 0, 0); PG8_STAGE(PG8_SA(1, 1), a1 + hstepA, voffA); \
            WAIT12; PG8_WAIT_L(0); PG8_BAR; MMAF(0, 0, At, B0); MMAF(0, 1, At, B1); PG8_BAR; PG8_SCHED; \
            PG8_LDA(At, 0, 1); PG8_STAGE(PG8_SB(0, 0), b2, voffB); PG8_STAGE(PG8_SB(0, 1), b2 + hstepB, voffB); PG8_STAGE(PG8_SA(0, 0), a2, voffA); \
            WAIT12; PG8_WAIT_L(0); PG8_BAR; MMAF(1, 0, At, B0); MMAF(1, 1, At, B1); PG8_BAR; PG8_SCHED; \
            PG8_LDB(B0, 1, 0); PG8_LDB(B1, 1, 1); PG8_SCHED; PG8_LDA(At, 1, 0); PG8_STAGE(PG8_SA(0, 1), a2 + hstepA, voffA); \
            PG8_WAIT_V(8); PG8_WAIT_L(0); PG8_BAR; PG8_MMA(0, 0, At, B0); PG8_MMA(0, 1, At, B1); PG8_BAR; PG8_SCHED; \
            PG8_LDA(At, 1, 1); PG8_STAGE(PG8_SB(1, 0), b3, voffB); PG8_STAGE(PG8_SB(1, 1), b3 + hstepB, voffB); PG8_STAGE(PG8_SA(1, 0), a3, voffA); \
            PG8_WAIT_V(8); PG8_WAIT_L(0); PG8_BAR; PG8_MMA(1, 0, At, B0); PG8_MMA(1, 1, At, B1); PG8_BAR; PG8_SCHED; \
        } while (0)
#define PG8_WAIT_FIRST do { if (RELAX_VM && Epi::NVM >= 16) PG8_WAIT_V_SEL(relax, 24, 8); else PG8_WAIT_V(8); } while (0)
        if (ZACC & Epi::ZBIT) {
            { const int relax = __builtin_amdgcn_readfirstlane((RELAX_VM && Epi::NVM >= 16 && after_epi) ? 1 : 0);
              PG8_PAIR(0, PG8_MMAZ, PG8_WAIT_FIRST); }
            for (int t = 2; t < nt; t += 2) {
                if (g.arr_u >= 0 && ui == g.arr_u + 1 && t == 2 && wid == 0 && lane_id_now() == 0) sb_arrive_lead(g.sb_bar, g.sb_st, g.arr_k);
                if (g.sb_mode == 3 && ui == g.sb_u && t == nt - 2) { sb_wait_raw(g.sb_bar, g.sb_st, wid == 0 && lane_id_now() == 0, g.sb_k); if (g.prep_split) E.prep(pm_first, wid * 64 + lane_id_now(), 2); }
                if (t == g.ksw) E.mid(acc, cur, wr, wc, fr, fq);
                PG8_PAIR(t, PG8_MMA, PG8_WAIT_V(8));
            }
        } else {
            for (int t = 0; t < nt; t += 2) {
                if (g.arr_u >= 0 && ui == g.arr_u + 1 && t == 2 && wid == 0 && lane_id_now() == 0) sb_arrive_lead(g.sb_bar, g.sb_st, g.arr_k);
                if (g.sb_mode == 3 && ui == g.sb_u && t == nt - 2) { sb_wait_raw(g.sb_bar, g.sb_st, wid == 0 && lane_id_now() == 0, g.sb_k); if (g.prep_split) E.prep(pm_first, wid * 64 + lane_id_now(), 2); }
                if (g.sb_mode == 2 && ui == 0 && t + 2 == g.ksw) sb_wait_raw(g.sb_bar, g.sb_st, wid == 0 && lane_id_now() == 0, g.sb_k);
                if (t == g.ksw) { if (BARSTAT == 340 && g.ts && blockIdx.x == 0 && tid == 0) g.ts[4] = __builtin_amdgcn_s_memrealtime(); E.mid(acc, cur, wr, wc, fr, fq); if (BARSTAT == 340 && g.ts && blockIdx.x == 0 && tid == 0) { asm volatile("" : "+v"(acc[0][0][0][0]), "+v"(acc[1][1][3][1])); g.ts[5] = __builtin_amdgcn_s_memrealtime(); } }
                const int relax = __builtin_amdgcn_readfirstlane((RELAX_VM && Epi::NVM >= 16 && after_epi && t == 0) ? 1 : 0);
                PG8_PAIR(t, PG8_MMA, PG8_WAIT_FIRST);
            }
        }
#undef PG8_WAIT_FIRST
#undef PG8_PAIR
        if (BARSTAT == 342 && g.ts && blockIdx.x == 0 && tid == 0) g.ts[4] = __builtin_amdgcn_s_memrealtime();
        if (wr == 0) PG8_BAR;
        if ((BARSTAT == 341 || BARSTAT == 343) && g.ts && blockIdx.x == 0 && tid == 0) g.ts[4] = __builtin_amdgcn_s_memrealtime();
        if (g.sb_mode == 1 && ui == g.sb_u) { sb_wait_raw(g.sb_bar, g.sb_st, wid == 0 && lane_id_now() == 0, g.sb_k); if (g.prep_split) E.prep(pm_first, wid * 64 + lane_id_now(), 2); }
        { int le_ = (int)__builtin_amdgcn_mbcnt_hi(~0u, __builtin_amdgcn_mbcnt_lo(~0u, 0u)); asm volatile("" : "+v"(le_)); const int fr_e = le_ & 15, fq_e = le_ >> 4;
          for (int er = 0; er < g.erep; ++er) { E(acc, cur, wr, wc, fr_e, fq_e); asm volatile("" ::: "memory"); } }
        if (BARSTAT >= 341 && BARSTAT <= 343 && g.ts && blockIdx.x == 0 && tid == 0) g.ts[5] = __builtin_amdgcn_s_memrealtime();
        if (BARSTAT == 344 && g.ts && blockIdx.x == 0 && tid == 0) g.ts[4] = __builtin_amdgcn_s_memrealtime();
        if (!has_next) break;
        if (BARSTAT == 346 && g.ts && blockIdx.x == 0 && tid == 0) dbg_stamp(6);
        if (!(ZACC & Epi::ZBIT)) {
#pragma unroll
        for (int a = 0; a < 2; ++a)
#pragma unroll
            for (int b = 0; b < 2; ++b)
#pragma unroll
                for (int m = 0; m < 4; ++m)
#pragma unroll
                    for (int n = 0; n < 2; ++n) acc[a][b][m][n] = (f32x4){0.f, 0.f, 0.f, 0.f};
        }
        cur = nxt; cA = nA; cB = nB; ++ui; after_epi = true;
        if (wr == 1) PG8_BAR;
    }
    if (BARSTAT >= 310 && g.ts && blockIdx.x == 0 && tid == 0) g.ts[2] = __builtin_amdgcn_s_memrealtime();
    PG8_WAIT_V(0);
    PG8_BAR;
    if (BARSTAT >= 310 && g.ts && blockIdx.x == 0 && tid == 0) g.ts[3] = __builtin_amdgcn_s_memrealtime();
#undef PG8_SA
#undef PG8_SB
#undef PG8_STAGE
#undef PG8_LDA
#undef PG8_LDB
#undef PG8_MMA
#undef PG8_MMAZ
#undef PG8_WAIT_V
#undef PG8_WAIT_V_SEL
#undef PG8_WAIT_L
#undef PG8_BAR
#undef PG8_SCHED
#undef PG8_APTR
#undef PG8_BPTR
#undef PG8_APTR2
#undef PG8_BPTR2
}

#define EPI_NO_MID __device__ __forceinline__ void mid(f32x4 (&)[2][2][4][2], const Unit&, int, int, int, int) const {}
__device__ __forceinline__ float rowscale(const float* rsq, int row) { const f32x4 p = *(const f32x4*)(rsq + 4 * (size_t)row); return rsqrtf(((p[0] + p[1]) + (p[2] + p[3])) * (1.f / DM) + EPS); }

__device__ __forceinline__ void rowscale8(const float* rsq, int row0, float (&sc)[8]) {
    f32x4 p[8];
#pragma unroll
    for (int k = 0; k < 8; ++k) p[k] = *(const f32x4*)(rsq + 4 * (size_t)(row0 + (k >> 2) * HALF + (k & 3) * 16));
#pragma unroll
    for (int k = 0; k < 8; ++k) sc[k] = rsqrtf(((p[k][0] + p[k][1]) + (p[k][2] + p[k][3])) * (1.f / DM) + EPS);
    asm volatile("" : "+v"(sc[0]), "+v"(sc[1]), "+v"(sc[2]), "+v"(sc[3]), "+v"(sc[4]), "+v"(sc[5]), "+v"(sc[6]), "+v"(sc[7]) :: "memory");
}
__device__ __forceinline__ void prep_rowscale(LAS float* tab, const float* rsq, int pm0, int tid, int part) {
    if (part == 1 && tid >= 256) return;
    if (part == 2) { if (tid >= 256) return; tid += 256; }
    const int slot = tid >> 8, rl = tid & 255; const int row = (((pm0 & ~8) + 8 * slot) * BM) + rl;
    const f32x4 p = *(const f32x4*)(rsq + 4 * (size_t)row);
    tab[slot * 256 + rl] = rsqrtf(((p[0] + p[1]) + (p[2] + p[3])) * (1.f / DM) + EPS);
}
__device__ __forceinline__ void rowscale8_tab(const LAS float* tab, int pm, int rl0, float (&sc)[8]) {
    const LAS float* t = tab + ((pm >> 3) & 1) * 256 + rl0;
#pragma unroll
    for (int k = 0; k < 8; ++k) sc[k] = t[(k >> 2) * HALF + (k & 3) * 16];
}
#define EPI_NO_PREP __device__ __forceinline__ void prep(int, int, int) const {}
struct EpiSwiGLU {
    EPI_NO_MID
    static constexpr int NVM = 8;
    static constexpr int ZBIT = 1;
    bf16_t* O; int ldc; const float* rsq; LAS float* rtab;
    __device__ __forceinline__ void prep(int pm0, int tid, int part) const { prep_rowscale(rtab, rsq, pm0, tid, part); }
    __device__ __forceinline__ void operator()(const f32x4 (&acc)[2][2][4][2], const Unit& u, int wr, int wc, int fr, int fq) const {
        const int row0 = u.pm * BM + wr * 64 + fr, col0 = u.pn * HALF + wc * 32 + 8 * fq;
        float sc8[8]; rowscale8_tab(rtab, u.pm, wr * 64 + fr, sc8);
#pragma unroll
        for (int ai = 0; ai < 2; ++ai)
#pragma unroll
            for (int m = 0; m < 4; ++m) { const int row = row0 + ai * HALF + m * 16; const float s = sc8[ai * 4 + m];
                float o[8];
#pragma unroll
                for (int n = 0; n < 2; ++n)
#pragma unroll
                    for (int i = 0; i < 4; ++i) { const float gt = acc[ai][0][m][n][i] * s, up = acc[ai][1][m][n][i] * s; o[n * 4 + i] = gt * fast_sigmoid(gt) * up; }
                u32x4 w; w.x = cvt_pk_bf16(o[0], o[1]); w.y = cvt_pk_bf16(o[2], o[3]); w.z = cvt_pk_bf16(o[4], o[5]); w.w = cvt_pk_bf16(o[6], o[7]);
                EPI_ST16(O + (size_t)row * ldc + col0, w); }
    }
};
struct EpiBf16 {
    EPI_NO_MID
    EPI_NO_PREP
    static constexpr int NVM = 16;
    static constexpr int ZBIT = 32;
    bf16_t* O; int ldc;
    __device__ __forceinline__ void operator()(const f32x4 (&acc)[2][2][4][2], const Unit& u, int wr, int wc, int fr, int fq) const {
        const int row0 = u.pm * BM + wr * 64 + fr, col0 = u.pn * BM + wc * 32 + 8 * fq;
#pragma unroll
        for (int ai = 0; ai < 2; ++ai)
#pragma unroll
            for (int m = 0; m < 4; ++m) { bf16_t* rowp = O + (size_t)(row0 + ai * HALF + m * 16) * ldc + col0;
#pragma unroll
                for (int bj = 0; bj < 2; ++bj) { const f32x4 v0 = acc[ai][bj][m][0], v1 = acc[ai][bj][m][1];
                    u32x4 w; w.x = cvt_pk_bf16(v0[0], v0[1]); w.y = cvt_pk_bf16(v0[2], v0[3]); w.z = cvt_pk_bf16(v1[0], v1[1]); w.w = cvt_pk_bf16(v1[2], v1[3]);
                    EPI_ST16(rowp + bj * HALF, w); } }
    }
};
template <int MODE> struct EpiProj {
    EPI_NO_MID
    static constexpr int NVM = 16;
    static constexpr int ZBIT = 2;
    bf16_t* o0; size_t sec_stride; const float* rsq; LAS float* rtab;
    __device__ __forceinline__ void prep(int pm0, int tid, int part) const { prep_rowscale(rtab, rsq, pm0, tid, part); }
    __device__ __forceinline__ void operator()(const f32x4 (&acc)[2][2][4][2], const Unit& u, int wr, int wc, int fr, int fq) const {
        const int row0 = u.pm * BM + wr * 64 + fr;
        int sec, ldc, colt; float sc = 1.f;
        if (MODE == 0) { sec = u.pn / 6; ldc = QW; colt = (u.pn % 6) * BM; if (sec == 0) sc = C2; }
        else { sec = u.pn < 8 ? (u.pn >> 2) : 2; ldc = u.pn < 8 ? DM : 2 * DM; colt = u.pn < 8 ? (u.pn & 3) * BM : (u.pn - 8) * HALF; }
        bf16_t* base = o0 + (size_t)sec * sec_stride;
        const int col0 = colt + wc * 32 + 8 * fq;
        float sc8[8]; rowscale8_tab(rtab, u.pm, wr * 64 + fr, sc8);
        if (MODE == 1 && sec == 2) {
#pragma unroll
            for (int ai = 0; ai < 2; ++ai)
#pragma unroll
                for (int m = 0; m < 4; ++m) { const int row = row0 + ai * HALF + m * 16; const float s = sc8[ai * 4 + m]; bf16_t* rowp = base + (size_t)row * ldc + col0;
                    float rr[8], gg[8];
#pragma unroll
                    for (int n = 0; n < 2; ++n)
#pragma unroll
                        for (int i = 0; i < 4; ++i) { const float ea = 1.f + __builtin_amdgcn_exp2f(acc[ai][0][m][n][i] * (-LOG2E * s)), eb = fminf(1.f + __builtin_amdgcn_exp2f(acc[ai][1][m][n][i] * (-LOG2E * s)), 1e30f);
                            rr[n * 4 + i] = __builtin_amdgcn_rcpf(ea) * eb; gg[n * 4 + i] = __builtin_amdgcn_rcpf(eb); }
                    u32x4 w; w.x = cvt_pk_bf16(rr[0], rr[1]); w.y = cvt_pk_bf16(rr[2], rr[3]); w.z = cvt_pk_bf16(rr[4], rr[5]); w.w = cvt_pk_bf16(rr[6], rr[7]); EPI_ST16(rowp, w);
                    u32x4 v; v.x = cvt_pk_bf16(gg[0], gg[1]); v.y = cvt_pk_bf16(gg[2], gg[3]); v.z = cvt_pk_bf16(gg[4], gg[5]); v.w = cvt_pk_bf16(gg[6], gg[7]); EPI_ST16(rowp + DM, v); }
        } else {
#pragma unroll
        for (int ai = 0; ai < 2; ++ai)
#pragma unroll
            for (int m = 0; m < 4; ++m) { const int row = row0 + ai * HALF + m * 16; const float s = sc8[ai * 4 + m] * sc; bf16_t* rowp = base + (size_t)row * ldc + col0;
#pragma unroll
                for (int bj = 0; bj < 2; ++bj) { const f32x4 v0 = acc[ai][bj][m][0] * s, v1 = acc[ai][bj][m][1] * s;
                    u32x4 w; w.x = cvt_pk_bf16(v0[0], v0[1]); w.y = cvt_pk_bf16(v0[2], v0[3]); w.z = cvt_pk_bf16(v1[0], v1[1]); w.w = cvt_pk_bf16(v1[2], v1[3]);
                    EPI_ST16(rowp + bj * HALF, w); } }
        }
    }
};
struct EpiLru {
    EPI_NO_MID
    EPI_NO_PREP
    static constexpr int NVM = 0;
    static constexpr int ZBIT = 4;
    const bf16_t* XC; const float* lc; bf16_t *LA, *BB;
    __device__ __forceinline__ void operator()(const f32x4 (&acc)[2][2][4][2], const Unit& u, int wr, int wc, int fr, int fq) const {
        const int row0 = u.pm * BM + wr * 64 + fr, c0 = (u.pn >> 1) * 256 + (u.pn & 1) * 128 + wc * 32 + 8 * fq;
        f32x4 cbx[2], cba[2], csp[2];
#pragma unroll
        for (int n = 0; n < 2; ++n) { cbx[n] = *(const f32x4*)(lc + c0 + 4 * n); cba[n] = *(const f32x4*)(lc + DM + c0 + 4 * n); csp[n] = *(const f32x4*)(lc + 2 * DM + c0 + 4 * n); }
        u32x4 xw8[8];
#pragma unroll
        for (int k = 0; k < 8; ++k) xw8[k] = *(const u32x4*)(XC + (size_t)(row0 + (k >> 2) * HALF + (k & 3) * 16) * DM + c0);
#pragma unroll
        for (int k = 0; k < 8; ++k) asm volatile("" : "+v"(xw8[k]) :: "memory");
#pragma unroll
        for (int ai = 0; ai < 2; ++ai)
#pragma unroll
            for (int m = 0; m < 4; ++m) { const int row = row0 + ai * HALF + m * 16; const size_t off = (size_t)row * DM + c0;
                const u32x4 xw = xw8[ai * 4 + m]; float xv[8] = {bflo(xw.x), bfhi(xw.x), bflo(xw.y), bfhi(xw.y), bflo(xw.z), bfhi(xw.z), bflo(xw.w), bfhi(xw.w)};
                float la[8], bb[8], x2v[8]; bool far_ = false;
#pragma unroll
                for (int n = 0; n < 2; ++n)
#pragma unroll
                    for (int i = 0; i < 4; ++i) { const int j = n * 4 + i;
                        const float gx = __builtin_amdgcn_rcpf(1.f + __builtin_amdgcn_exp2f(__builtin_fmaf(acc[ai][0][m][n][i], -LOG2E, cbx[n][i])));
                        const float ga = __builtin_amdgcn_rcpf(1.f + __builtin_amdgcn_exp2f(__builtin_fmaf(acc[ai][1][m][n][i], -LOG2E, cba[n][i])));
                        const float l = ga * csp[n][i]; la[j] = l; const float x2 = l + l; x2v[j] = x2; far_ = far_ || (x2 < -0.25f);
                        const float om = -x2 * (1.f + x2 * (0.5f + x2 * (0.16666667f + x2 * (0.041666668f + x2 * (0.0083333333f + x2 * 0.0013888889f)))));
                        bb[j] = __builtin_amdgcn_sqrtf(om) * (gx * xv[j]); }
                if (__any(far_)) {
#pragma unroll
                    for (int j = 0; j < 8; ++j) if (x2v[j] < -0.25f) { const int n = j >> 2, i = j & 3;
                        const float gx = __builtin_amdgcn_rcpf(1.f + __builtin_amdgcn_exp2f(__builtin_fmaf(acc[ai][0][m][n][i], -LOG2E, cbx[n][i])));
                        bb[j] = sqrtf(1.f - __builtin_amdgcn_exp2f(x2v[j] * LOG2E)) * (gx * xv[j]); }
                }
                u32x4 w; w.x = cvt_pk_bf16(la[0], la[1]); w.y = cvt_pk_bf16(la[2], la[3]); w.z = cvt_pk_bf16(la[4], la[5]); w.w = cvt_pk_bf16(la[6], la[7]); EPI_ST16(LA + off, w);
                u32x4 v; v.x = cvt_pk_bf16(bb[0], bb[1]); v.y = cvt_pk_bf16(bb[2], bb[3]); v.z = cvt_pk_bf16(bb[4], bb[5]); v.w = cvt_pk_bf16(bb[6], bb[7]); EPI_ST16(BB + off, v); }
    }
};
struct EpiGate {
    EPI_NO_PREP
    static constexpr int NVM = 0;
    static constexpr int ZBIT = 8;
    const bf16_t* GT; bf16_t* MG;
    __device__ __forceinline__ void scale(f32x4 (&acc)[2][2][4][2], const Unit& u, int wr, int wc, int fr, int fq, int goff) const {
        int row0 = u.pm * BM + wr * 64 + fr; const int col0 = u.pn * BM + wc * 32 + 8 * fq;
        asm volatile("" : "+v"(row0));
        u32x4 gw[8][2];
#pragma unroll
        for (int k = 0; k < 8; ++k)
#pragma unroll
            for (int bj = 0; bj < 2; ++bj) gw[k][bj] = NTLD((const u32x4*)(GT + (size_t)(row0 + (k >> 2) * HALF + (k & 3) * 16) * (2 * DM) + goff + col0 + bj * HALF));
#pragma unroll
        for (int k = 0; k < 8; ++k)
#pragma unroll
            for (int bj = 0; bj < 2; ++bj) { const u32x4 b = gw[k][bj];
                acc[k >> 2][bj][k & 3][0] *= (f32x4){bflo(b.x), bfhi(b.x), bflo(b.y), bfhi(b.y)}; acc[k >> 2][bj][k & 3][1] *= (f32x4){bflo(b.z), bfhi(b.z), bflo(b.w), bfhi(b.w)}; }
    }
    __device__ __forceinline__ void mid(f32x4 (&acc)[2][2][4][2], const Unit& u, int wr, int wc, int fr, int fq) const { scale(acc, u, wr, wc, fr, fq, 0); }
    __device__ __forceinline__ void operator()(f32x4 (&acc)[2][2][4][2], const Unit& u, int wr, int wc, int fr, int fq) const {
        scale(acc, u, wr, wc, fr, fq, DM);
        const int row0 = u.pm * BM + wr * 64 + fr, col0 = u.pn * BM + wc * 32 + 8 * fq;
#pragma unroll
        for (int ai = 0; ai < 2; ++ai)
#pragma unroll
            for (int m = 0; m < 4; ++m) { const int row = row0 + ai * HALF + m * 16;
#pragma unroll
                for (int bj = 0; bj < 2; ++bj) { const f32x4 v0 = acc[ai][bj][m][0], v1 = acc[ai][bj][m][1];
                    u32x4 w; w.x = cvt_pk_bf16(v0[0], v0[1]); w.y = cvt_pk_bf16(v0[2], v0[3]); w.z = cvt_pk_bf16(v1[0], v1[1]); w.w = cvt_pk_bf16(v1[2], v1[3]);
                    EPI_ST16(MG + (size_t)row * DM + col0 + bj * HALF, w); } }
    }
};
__device__ __forceinline__ float quad_sum(float v) {
    const auto a = __builtin_amdgcn_permlane16_swap(__float_as_uint(v), __float_as_uint(v), false, false); v = __uint_as_float(a[0]) + __uint_as_float(a[1]);
    const auto b = __builtin_amdgcn_permlane32_swap(__float_as_uint(v), __float_as_uint(v), false, false); return __uint_as_float(b[0]) + __uint_as_float(b[1]);
}
template <int MODE> struct EpiNormRes {
    EPI_NO_MID
    EPI_NO_PREP
    static constexpr int NVM = 0;
    static constexpr int ZBIT = 16;
    const float* resf; bf16_t* AB; float* outf; const float* gpost; float coef; unsigned long long* xs; unsigned epoch; float* rsq_out; LAS unsigned char* sl;
    static constexpr int DEPTH = (MODE == 0) ? 3 : 4;
    static constexpr int NPRE = (MODE == 0) ? 6 : 4;
    __device__ __forceinline__ void load_row(u32x4 (&pre)[NPRE][2], int k, size_t rowoff) const {
        if (MODE == 0) { const float* p = resf + rowoff; const int sl_ = (k % 3) * 2; pre[sl_][0] = NTLD((const u32x4*)p); pre[sl_][1] = NTLD((const u32x4*)(p + 4)); pre[sl_ + 1][0] = NTLD((const u32x4*)(p + HALF)); pre[sl_ + 1][1] = NTLD((const u32x4*)(p + HALF + 4)); }
        else { const bf16_t* p = AB + rowoff; pre[k & 3][0] = NTLD((const u32x4*)p); pre[k & 3][1] = NTLD((const u32x4*)(p + HALF)); }
    }
    __device__ __forceinline__ void operator()(const f32x4 (&acc)[2][2][4][2], const Unit& u, int wr, int wc, int fr, int fq) const {
        LAS float* P = (LAS float*)sl;
        LAS float* S = (LAS float*)(sl + 4096);
        const int wid = wr * 4 + wc, lane = fq * 16 + fr;
        const int col0 = u.pn * BM + wc * 32 + 8 * fq;
        const bool tsw_ = (BARSTAT >= 330 && BARSTAT < 340) && MODE == TS_MODE && blockIdx.x == 0 && wid == 0 && lane == 0; unsigned long long* tsp_ = (unsigned long long*)((unsigned char*)xs - 1536 * 1024 - 508 * MiB + 202 * 1024);
        if (tsw_) tsp_[0] = __builtin_amdgcn_s_memrealtime();
        const size_t off0 = (size_t)(u.pm * BM + wr * 64 + fr) * DM + col0;
        f32x4 gv[2][2];
#pragma unroll
        for (int bj = 0; bj < 2; ++bj) { gv[bj][0] = *(const f32x4*)(gpost + col0 + bj * HALF); gv[bj][1] = *(const f32x4*)(gpost + col0 + bj * HALF + 4); }
        u32x4 pre[NPRE][2];
#pragma unroll
        for (int k = 0; k < DEPTH; ++k) load_row(pre, k, off0 + (size_t)((k >> 2) * HALF + (k & 3) * 16) * DM);
#pragma unroll
        for (int ai = 0; ai < 2; ++ai)
#pragma unroll
            for (int m = 0; m < 4; ++m) { float s = 0.f;
#pragma unroll
                for (int bj = 0; bj < 2; ++bj)
#pragma unroll
                    for (int n = 0; n < 2; ++n) { const f32x4 v = acc[ai][bj][m][n]; s += (v[0] * v[0] + v[1] * v[1]) + (v[2] * v[2] + v[3] * v[3]); }
                s = quad_sum(s);
                if (fq == 0) P[(ai * HALF + wr * 64 + m * 16 + fr) * 4 + wc] = s; }
        asm volatile("s_waitcnt lgkmcnt(0)" ::: "memory"); __builtin_amdgcn_s_barrier(); asm volatile("" ::: "memory");
        if (tsw_) tsp_[1] = __builtin_amdgcn_s_memrealtime();
        if (lane < 32) { const int row = wid * 32 + lane; const f32x4 p = *(const LAS f32x4*)(P + row * 4); const float tot = (p[0] + p[1]) + (p[2] + p[3]);
            unsigned long long* slot = xs + ((size_t)(u.pm * BM + row) * 4);
            __hip_atomic_store(slot + u.pn, ((unsigned long long)epoch << 32) | (unsigned long long)__float_as_uint(tot), __ATOMIC_RELAXED, __HIP_MEMORY_SCOPE_AGENT);
            float sum = 0.f; unsigned spins = 0;
            for (;;) { bool ok = true; float t = 0.f;
#pragma unroll
                for (int k = 0; k < 4; ++k) { const unsigned long long g = __hip_atomic_load(slot + k, __ATOMIC_RELAXED, __HIP_MEMORY_SCOPE_AGENT); ok = ok && ((unsigned)(g >> 32) == epoch); t += __uint_as_float((unsigned)g); }
                sum = t; if (ok || ++spins > (1u << 16)) break; __builtin_amdgcn_s_sleep(1); }
            S[row] = rsqrtf(sum * (1.f / DM) + EPS) * coef; }
        if (tsw_) tsp_[2] = __builtin_amdgcn_s_memrealtime();
        asm volatile("s_waitcnt vmcnt(0) lgkmcnt(0)" ::: "memory"); __builtin_amdgcn_s_barrier(); asm volatile("" ::: "memory");
        if (tsw_) tsp_[3] = __builtin_amdgcn_s_memrealtime();
        float rsv[8];
#pragma unroll
        for (int k = 0; k < 8; ++k) rsv[k] = S[(k >> 2) * HALF + wr * 64 + (k & 3) * 16 + fr];
#pragma unroll
        for (int k = 0; k < 8; ++k) { const int ai = k >> 2, m = k & 3; const int rl = ai * HALF + wr * 64 + m * 16 + fr; const size_t off = off0 + (size_t)(ai * HALF + m * 16) * DM; const float rs = rsv[k];
            f32x4 h[2][2];
#pragma unroll
            for (int bj = 0; bj < 2; ++bj) { f32x4 r0, r1;
                if (MODE == 0) { r0 = __builtin_bit_cast(f32x4, pre[(k % 3) * 2 + bj][0]); r1 = __builtin_bit_cast(f32x4, pre[(k % 3) * 2 + bj][1]); }
                else { const u32x4 w = pre[k & 3][bj]; r0 = (f32x4){bflo(w.x), bfhi(w.x), bflo(w.y), bfhi(w.y)}; r1 = (f32x4){bflo(w.z), bfhi(w.z), bflo(w.w), bfhi(w.w)}; }
                h[bj][0] = r0 + acc[ai][bj][m][0] * rs * gv[bj][0]; h[bj][1] = r1 + acc[ai][bj][m][1] * rs * gv[bj][1]; }
            asm volatile("" : "+v"(h[0][0]), "+v"(h[0][1]), "+v"(h[1][0]), "+v"(h[1][1]) :: "memory");
            if (k + DEPTH < 8) load_row(pre, k + DEPTH, off0 + (size_t)((((k + DEPTH) >> 2)) * HALF + ((k + DEPTH) & 3) * 16) * DM);
            asm volatile("" ::: "memory");
            float s2 = 0.f;
#pragma unroll
            for (int bj = 0; bj < 2; ++bj) { const f32x4 h0 = h[bj][0], h1 = h[bj][1];
                if (MODE == 2) { if (NT_OUT) { __builtin_nontemporal_store(h0, (f32x4*)(outf + off + bj * HALF)); __builtin_nontemporal_store(h1, (f32x4*)(outf + off + bj * HALF + 4)); } else if (NT_NORM == 1) { ST16_WT(outf + off + bj * HALF, h0); ST16_WT(outf + off + bj * HALF + 4, h1); } else if (NT_NORM == 2) { __builtin_nontemporal_store(h0, (f32x4*)(outf + off + bj * HALF)); __builtin_nontemporal_store(h1, (f32x4*)(outf + off + bj * HALF + 4)); } else { *(f32x4*)(outf + off + bj * HALF) = h0; *(f32x4*)(outf + off + bj * HALF + 4) = h1; } }
                else { u32x4 w; w.x = cvt_pk_bf16(h0[0], h0[1]); w.y = cvt_pk_bf16(h0[2], h0[3]); w.z = cvt_pk_bf16(h1[0], h1[1]); w.w = cvt_pk_bf16(h1[2], h1[3]); if (NT_NORM == 1) ST16_WT(AB + off + bj * HALF, w); else if (NT_NORM == 2) __builtin_nontemporal_store(w, (u32x4*)(AB + off + bj * HALF)); else *(u32x4*)(AB + off + bj * HALF) = w;
                    s2 += (h0[0] * h0[0] + h0[1] * h0[1]) + (h0[2] * h0[2] + h0[3] * h0[3]) + (h1[0] * h1[0] + h1[1] * h1[1]) + (h1[2] * h1[2] + h1[3] * h1[3]); } }
            if (MODE != 2) { s2 = quad_sum(s2); if (fq == 0) P[rl * 4 + wc] = s2; }
        }
        if (tsw_) tsp_[4] = __builtin_amdgcn_s_memrealtime();
        if (MODE != 2) {
            asm volatile("s_waitcnt lgkmcnt(0)" ::: "memory"); __builtin_amdgcn_s_barrier(); asm volatile("" ::: "memory");
            if (lane < 32) { const int row = wid * 32 + lane; const f32x4 p = *(const LAS f32x4*)(P + row * 4); rsq_out[(size_t)(u.pm * BM + row) * 4 + u.pn] = (p[0] + p[1]) + (p[2] + p[3]); }
        }
        asm volatile("s_waitcnt lgkmcnt(0)" ::: "memory"); __builtin_amdgcn_s_barrier(); asm volatile("" ::: "memory");
        if (tsw_) tsp_[5] = __builtin_amdgcn_s_memrealtime();
    }
};
}

struct Args {
    const float* in[25];
    float* out;
    unsigned char* ws;
};

struct P0D { const float* wp; const float* gp; bf16_t* dst; int ldw, ldt; };
__device__ __forceinline__ void p0_load(float (&v)[32], f32x4& g0, f32x4& g1, const P0D& d, int lane) {
#pragma unroll
    for (int i = 0; i < 32; ++i) v[i] = NTLD(d.wp + (size_t)(2 * i) * d.ldw);
    const int c = lane & 7;
    g0 = (f32x4){1.f, 1.f, 1.f, 1.f}; g1 = g0;
    if (d.gp) { g0 = *(const f32x4*)(d.gp + 8 * c); g1 = *(const f32x4*)(d.gp + 8 * c + 4); }
}
__device__ __forceinline__ void p0_finish(const float (&v)[32], const f32x4 g0, const f32x4 g1, const P0D& d, LAS float* scr, int lane) {
    const int c = lane & 7;
#pragma unroll
    for (int i = 0; i < 32; ++i) scr[(2 * i + (lane >> 5)) * 33 + (lane & 31)] = v[i];
    asm volatile("s_waitcnt lgkmcnt(0)" ::: "memory");
#pragma unroll
    for (int j = 0; j < 4; ++j) { const int n = (lane >> 3) + 8 * j; const LAS float* s = scr + (8 * c) * 33 + n;
        u32x4 o; o.x = cvt_pk_bf16(s[0 * 33] * g0[0], s[1 * 33] * g0[1]); o.y = cvt_pk_bf16(s[2 * 33] * g0[2], s[3 * 33] * g0[3]); o.z = cvt_pk_bf16(s[4 * 33] * g1[0], s[5 * 33] * g1[1]); o.w = cvt_pk_bf16(s[6 * 33] * g1[2], s[7 * 33] * g1[3]);
        *(u32x4*)(d.dst + (size_t)n * d.ldt + 8 * c) = o; }
    asm volatile("s_waitcnt lgkmcnt(0)" ::: "memory");
}
template <int MAP>
__device__ __forceinline__ bool p0_job(int& r, const float* W, int ldw, int Ksrc, int Nsrc, const float* gain, bf16_t* WT, int ldt, int rowbase, P0D& d, int lane) {
    const int nblk = Nsrc / 32, items = (Ksrc / 64) * nblk;
    if (r >= items) { r -= items; return false; }
    const int kb = r / nblk, nb = r % nblk, n0 = nb * 32, k0 = kb * 64;
    int drow0 = rowbase + n0;
    if (MAP == 1 || MAP == 3) drow0 = rowbase + (n0 / 128) * 256 + (n0 % 128);
    if (MAP == 2) drow0 = rowbase + (n0 / 128) * 256 + 128 + (n0 % 128);
    d.wp = W + (size_t)(k0 + (lane >> 5)) * ldw + n0 + (lane & 31); d.gp = gain ? gain + k0 : nullptr; d.dst = WT + (size_t)drow0 * ldt + k0; d.ldw = ldw; d.ldt = ldt;
    return true;
}

__device__ __forceinline__ int t5_bucket(int dist) {
    if (dist < 16) return dist;
    const double v = log((double)dist / 16.0) / log(128.0) * 16.0;
    const int b = 16 + (int)v; return b < 31 ? b : 31;
}

template <bool RES_F32, bool OUT_F32>
__device__ __forceinline__ void norm_pass(const bf16_t* Fb, bf16_t* AB, const float* resf, const float* gpost, float coef, float* outf, float* rsq_out, int gw, int NGW, int lane) {
    for (int row = gw; row < M; row += NGW) {
        const bf16_t* fr_ = Fb + (size_t)row * DM; float fv[2][8]; float rv[2][8]; float s = 0.f;
#pragma unroll
        for (int j = 0; j < 2; ++j) { const int c = 8 * lane + 512 * j; const u32x4 w = *(const u32x4*)(fr_ + c);
            fv[j][0] = bflo(w.x); fv[j][1] = bfhi(w.x); fv[j][2] = bflo(w.y); fv[j][3] = bfhi(w.y); fv[j][4] = bflo(w.z); fv[j][5] = bfhi(w.z); fv[j][6] = bflo(w.w); fv[j][7] = bfhi(w.w);
            if (RES_F32) { const f32x4 r0 = *(const f32x4*)(resf + (size_t)row * DM + c), r1 = *(const f32x4*)(resf + (size_t)row * DM + c + 4);
#pragma unroll
                for (int i = 0; i < 4; ++i) { rv[j][i] = r0[i]; rv[j][4 + i] = r1[i]; } }
            else { const u32x4 r = *(const u32x4*)(AB + (size_t)row * DM + c);
                rv[j][0] = bflo(r.x); rv[j][1] = bfhi(r.x); rv[j][2] = bflo(r.y); rv[j][3] = bfhi(r.y); rv[j][4] = bflo(r.z); rv[j][5] = bfhi(r.z); rv[j][6] = bflo(r.w); rv[j][7] = bfhi(r.w); }
#pragma unroll
            for (int i = 0; i < 8; ++i) s += fv[j][i] * fv[j][i]; }
        s = wave_sum(s);
        const float rs = rsqrtf(s * (1.f / DM) + EPS) * coef; float s2 = 0.f;
#pragma unroll
        for (int j = 0; j < 2; ++j) { const int c = 8 * lane + 512 * j;
            const f32x4 g0 = *(const f32x4*)(gpost + c), g1 = *(const f32x4*)(gpost + c + 4);
            f32x4 o0, o1;
#pragma unroll
            for (int i = 0; i < 4; ++i) { o0[i] = rv[j][i] + fv[j][i] * rs * g0[i]; o1[i] = rv[j][4 + i] + fv[j][4 + i] * rs * g1[i]; s2 += o0[i] * o0[i] + o1[i] * o1[i]; }
            if (OUT_F32) { *(f32x4*)(outf + (size_t)row * DM + c) = o0; *(f32x4*)(outf + (size_t)row * DM + c + 4) = o1; }
            else { u32x4 w; w.x = cvt_pk_bf16(o0[0], o0[1]); w.y = cvt_pk_bf16(o0[2], o0[3]); w.z = cvt_pk_bf16(o1[0], o1[1]); w.w = cvt_pk_bf16(o1[2], o1[3]); *(u32x4*)(AB + (size_t)row * DM + c) = w; } }
        if (!OUT_F32) { s2 = wave_sum(s2); if (lane == 0) *(f32x4*)(rsq_out + 4 * (size_t)row) = (f32x4){s2, 0.f, 0.f, 0.f}; }
    }
}

#define XB_TMO      128
#define XB_XCNT(j)  (256  + 64 * (j))
#define XB_XSUB(j)  (1280 + 64 * (j))
#define XB_XGEN(j)  (2304 + 64 * (j))
#define XB_TOP      3328
#define XB_TOPGEN   3392
#define XCD_BAR_WORDS 3456
#define XB_SPIN_CAP (1u << 18)

__device__ __forceinline__ unsigned xb_ld(unsigned* p)              { return __hip_atomic_load(p, __ATOMIC_RELAXED, __HIP_MEMORY_SCOPE_AGENT); }
__device__ __forceinline__ unsigned xb_add(unsigned* p, unsigned v) { return __hip_atomic_fetch_add(p, v, __ATOMIC_RELAXED, __HIP_MEMORY_SCOPE_AGENT); }
__device__ __forceinline__ unsigned xb_xcc_id() { return (unsigned)__builtin_amdgcn_s_getreg((3 << 11) | 20) & 0xFu; }
#define XB_SPIN(cond, bar) do { unsigned _sp = 0; while (cond) { __builtin_amdgcn_s_sleep(1); \
    if ((++_sp & 255u) == 0u) { if (xb_ld(&(bar)[XB_TMO])) break; if (_sp > XB_SPIN_CAP) { atomicAdd(&(bar)[XB_TMO], 1u); break; } } } } while (0)

struct XcdBarrier {
    unsigned* bar; unsigned x;
    volatile LAS unsigned* st;
    bool lead;
};

__device__ __forceinline__ XcdBarrier xcd_barrier_post(unsigned* bar, volatile LAS unsigned* st, bool lead) {
    XcdBarrier b; b.bar = bar; b.x = xb_xcc_id(); b.st = st; b.lead = lead;
    if (lead) (void)xb_add(&bar[XB_XCNT(b.x)], 1u);
    return b;
}
__device__ __forceinline__ void xcd_barrier_complete(unsigned* bar, unsigned x, unsigned& nloc, unsigned& nx) {
    const unsigned G = gridDim.x * gridDim.y * gridDim.z;
    unsigned sum, cnt, mine, sp = 0u;
    for (;;) {
        sum = 0u; cnt = 0u; mine = 0u;
#pragma unroll
        for (unsigned j = 0; j < 16; ++j) { const unsigned c = xb_ld(&bar[XB_XCNT(j)]); sum += c; cnt += (c > 0u) ? 1u : 0u; mine = (j == x) ? c : mine; }
        if (sum == G) break;
        __builtin_amdgcn_s_sleep(1);
        if ((++sp & 255u) == 0u) { if (xb_ld(&bar[XB_TMO])) break; if (sp > XB_SPIN_CAP) { atomicAdd(&bar[XB_TMO], 1u); break; } }
    }
    nloc = mine > 0u ? mine : 1u; nx = cnt > 0u ? cnt : 1u;
}

__device__ __forceinline__ void xcd_barrier(const XcdBarrier& b) {
    asm volatile("s_waitcnt vmcnt(0)" ::: "memory");
    __syncthreads();
    if (b.lead) {
        unsigned* bar = b.bar;
        __builtin_amdgcn_s_waitcnt(0);
        unsigned nloc = b.st[0], nx = b.st[1];
        if (nloc == 0u) { xcd_barrier_complete(bar, b.x, nloc, nx); b.st[0] = nloc; b.st[1] = nx; }
        const unsigned old = xb_add(&bar[XB_XSUB(b.x)], 1u);
        const unsigned gen = old / nloc;
        if (old + 1u == (gen + 1u) * nloc) {
            __builtin_amdgcn_fence(__ATOMIC_RELEASE, "agent");
            asm volatile("s_waitcnt vmcnt(0)" ::: "memory");
            const unsigned og = xb_add(&bar[XB_TOP], 1u);
            const unsigned tg = og / nx;
            if (og + 1u == (tg + 1u) * nx) xb_add(&bar[XB_TOPGEN], 1u);
            else XB_SPIN(xb_ld(&bar[XB_TOPGEN]) == tg, bar);
            __builtin_amdgcn_fence(__ATOMIC_ACQUIRE, "agent");
            xb_add(&bar[XB_XGEN(b.x)], 1u);
            asm volatile("s_waitcnt vmcnt(0)" ::: "memory");
        } else {
            XB_SPIN(xb_ld(&bar[XB_XGEN(b.x)]) == gen, bar);
            __builtin_amdgcn_fence(__ATOMIC_ACQUIRE, "agent");
            asm volatile("s_waitcnt vmcnt(0)" ::: "memory");
        }
    }
    __syncthreads();
}


#define SB_XSUB(j, s)  (4096 + 2048 * (s) + 64 * (j))
#define SB_TOP(s)      (4096 + 2048 * (s) + 64 * 17)
__device__ __forceinline__ void sb_arrive(unsigned* bar, volatile LAS unsigned* st, bool lead, unsigned k) {
    asm volatile("s_waitcnt vmcnt(0)" ::: "memory");
    __syncthreads();
    if (lead) {
        __builtin_amdgcn_s_waitcnt(0);
        const unsigned x = xb_xcc_id();
        unsigned nloc = st[0], nx = st[1];
        if (nloc == 0u) { xcd_barrier_complete(bar, x, nloc, nx); st[0] = nloc; st[1] = nx; }
        const unsigned old = xb_add(&bar[SB_XSUB(x, k & 3u)], 1u);
        if (old + 1u == ((k >> 2) + 1u) * nloc) {
            __builtin_amdgcn_fence(__ATOMIC_RELEASE, "agent");
            asm volatile("s_waitcnt vmcnt(0)" ::: "memory");
            xb_add(&bar[SB_TOP(k & 3u)], 1u);
        }
    }
}
__device__ __forceinline__ void sb_wait(unsigned* bar, volatile LAS unsigned* st, bool lead, unsigned k) {
    if (lead) {
        const unsigned nx = st[1];
        XB_SPIN(xb_ld(&bar[SB_TOP(k & 3u)]) < ((k >> 2) + 1u) * nx, bar);
        __builtin_amdgcn_fence(__ATOMIC_ACQUIRE, "agent");
        asm volatile("s_waitcnt vmcnt(0)" ::: "memory");
    }
    __syncthreads();
}

__device__ __forceinline__ void sb_arrive_lead(unsigned* bar, volatile LAS unsigned* st, unsigned k) {
    const unsigned x = xb_xcc_id();
    const unsigned nloc = st[0];
    const unsigned old = xb_add(&bar[SB_XSUB(x, k & 3u)], 1u);
    if (old + 1u == ((k >> 2) + 1u) * nloc) {
        __builtin_amdgcn_fence(__ATOMIC_RELEASE, "agent");
        asm volatile("s_waitcnt vmcnt(0)" ::: "memory");
        xb_add(&bar[SB_TOP(k & 3u)], 1u);
    }
}
__device__ __forceinline__ void sb_arrive_raw(unsigned* bar, volatile LAS unsigned* st, bool lead, unsigned k) {
    asm volatile("s_waitcnt vmcnt(0)" ::: "memory");
    asm volatile("" ::: "memory"); __builtin_amdgcn_s_barrier(); asm volatile("" ::: "memory");
    if (lead) {
        const unsigned x = xb_xcc_id();
        const unsigned nloc = st[0];
        const unsigned old = xb_add(&bar[SB_XSUB(x, k & 3u)], 1u);
        if (old + 1u == ((k >> 2) + 1u) * nloc) {
            __builtin_amdgcn_fence(__ATOMIC_RELEASE, "agent");
            asm volatile("s_waitcnt vmcnt(0)" ::: "memory");
            xb_add(&bar[SB_TOP(k & 3u)], 1u);
        }
    }
}
__device__ __forceinline__ void sb_wait_raw(unsigned* bar, volatile LAS unsigned* st, bool lead, unsigned k) {
    if (lead) {
        const unsigned nx = st[1];
        XB_SPIN(xb_ld(&bar[SB_TOP(k & 3u)]) < ((k >> 2) + 1u) * nx, bar);
        __builtin_amdgcn_fence(__ATOMIC_ACQUIRE, "agent");
        asm volatile("s_waitcnt vmcnt(0)" ::: "memory");
    }
    asm volatile("" ::: "memory"); __builtin_amdgcn_s_barrier(); asm volatile("" ::: "memory");
}

constexpr int LDS_BYTES = 144 * 1024;
constexpr int BAR_LDS_OFF = 128 * 1024 + 256;
constexpr int NORM_LDS_OFF = 128 * 1024 + 1024;
constexpr int VSTRIDE = 320;
constexpr int ATT_V_BYTES = 32 * VSTRIDE;
constexpr int ATT_BIAS_OFF = NWAVES * ATT_V_BYTES;

#define P_x INP(0)
#define P_n1pre INP(1)
#define P_n1post INP(2)
#define P_w1g INP(3)
#define P_w1u INP(4)
#define P_w1d INP(5)
#define P_mpre INP(6)
#define P_mpost INP(7)
#define P_win INP(8)
#define P_btab INP(9)
#define P_cw INP(10)
#define P_cb INP(11)
#define P_wx INP(12)
#define P_bxp INP(13)
#define P_wa INP(14)
#define P_bap INP(15)
#define P_app INP(16)
#define P_wab INP(17)
#define P_wrb INP(18)
#define P_wout INP(19)
#define P_n2pre INP(20)
#define P_n2post INP(21)
#define P_w2g INP(22)
#define P_w2u INP(23)
#define P_w2d INP(24)
#define P_LC WSP(float, WS_LC)
#define P_XS WSP(unsigned long long, WS_XS)
#define P_RSQ0 WSP(float, WS_RSQ0)
#define P_RSQ1 WSP(float, WS_RSQ1)
#define P_RSQ2 WSP(float, WS_RSQ2)
#define P_WGU1 WSP(bf16_t, WS_WGU1)
#define P_WD1 WSP(bf16_t, WS_WD1)
#define P_WIN WSP(bf16_t, WS_WIN)
#define P_WLRU WSP(bf16_t, WS_WLRU)
#define P_WAB WSP(bf16_t, WS_WAB)
#define P_WRB WSP(bf16_t, WS_WRB)
#define P_WOUT WSP(bf16_t, WS_WOUT)
#define P_WGU2 WSP(bf16_t, WS_WGU2)
#define P_WD2 WSP(bf16_t, WS_WD2)
#define P_AB WSP(bf16_t, WS_AB)
#define P_Qb WSP(bf16_t, WS_Q)
#define P_Kb WSP(bf16_t, WS_K)
#define P_Vb WSP(bf16_t, WS_V)
#define P_OG WSP(bf16_t, WS_OG)
#define P_HID WSP(bf16_t, WS_HID)
#define P_Fb WSP(bf16_t, WS_F)
#define P_XR WSP(bf16_t, WS_XR)
#define P_YG WSP(bf16_t, WS_YG)
#define P_GT WSP(bf16_t, WS_GT)
#define P_ATT ((bf16_t*)((unsigned char*)(KARGS()->out) + 64 * MiB))
#define P_XC ((bf16_t*)(KARGS()->out))
#define P_LA WSP(bf16_t, WS_LA)
#define P_BB WSP(bf16_t, WS_BB)
#define P_REC ((bf16_t*)(KARGS()->out))
#define P_MG WSP(bf16_t, WS_MG)
#define P_LSE WSP(float, WS_LSE)
#define P_CA WSP(float, WS_CA)
#define P_CH WSP(float, WS_CH)
#define P_out (KARGS()->out)
constexpr int AR_SLOT = 16384, AR_NSLOT = 3, AR_OSTRIDE = 272, AR_OBYTES = 32 * AR_OSTRIDE;
constexpr int AR_OST = AR_NSLOT * AR_SLOT, AR_BIAS_OFF = AR_OST + NWAVES * AR_OBYTES;
constexpr int AR_BROW = 192, AR_BPAD = 31;
static_assert(AR_BIAS_OFF + NH * AR_BROW * 4 <= 128 * 1024, "attention LDS map");
#define AR_WAIT_V3(sel, a, b, c) asm volatile("s_cmp_eq_u32 %0, 2\n\ts_cbranch_scc0 .Lar_n2%=\n\ts_waitcnt vmcnt(" #a ")\n\ts_branch .Lar_e%=\n.Lar_n2%=:\n\ts_cmp_eq_u32 %0, 1\n\ts_cbranch_scc0 .Lar_n1%=\n\ts_waitcnt vmcnt(" #b ")\n\ts_branch .Lar_e%=\n.Lar_n1%=:\n\ts_waitcnt vmcnt(" #c ")\n.Lar_e%=:" :: "s"(sel) : "memory", "scc")
__device__ __forceinline__ void ar_glds16(const void* gsrc, unsigned lds_dst) { unsigned keep;
    asm volatile("s_mov_b32 %0, m0\n\ts_mov_b32 m0, %2\n\ts_nop 0\n\tglobal_load_lds_dwordx4 %1, off nt\n\ts_mov_b32 m0, %0" : "=&s"(keep) : "v"(gsrc), "s"(lds_dst) : "memory"); }
__device__ __forceinline__ void attn_bias_build(LAS unsigned char* lds, const float* btab_, int tid) {
    LAS float* biasL = (LAS float*)(lds + AR_BIAS_OFF);
    { LAS int* bk = (LAS int*)lds;
      if (tid < 3 * 129) { const int g_ = tid / 129, st = tid % 129; bk[tid] = t5_bucket(st << (2 * g_)); }
      __syncthreads();
      for (int i = tid; i < NH * AR_BROW; i += NTHREADS) { const int head = i / AR_BROW, st = i % AR_BROW - AR_BPAD; const bool in_ = (st >= 0) && (st <= 128);
          biasL[i] = in_ ? btab_[bk[(head >> 2) * 129 + (in_ ? st : 0)] * NH + head] * LOG2E : -INFINITY; }
      __syncthreads(); }
}
template <int RV>
__device__ __forceinline__ void attn_ring_phase(LAS unsigned char* lds, const float* btab_, const bf16_t* Qb_, const bf16_t* Kb_, const bf16_t* Vb_, bf16_t* OG_, float* LSE_, int tid, int lane, int wave, int vcu, int G) {
    LAS float* biasL = (LAS float*)(lds + AR_BIAS_OFF);
    const int qq = lane & 31, hh2 = lane >> 5;
    const unsigned ldsbase = (unsigned)(unsigned long)lds;
    LAS unsigned char* ost = lds + AR_OST + wave * AR_OBYTES;
    const int dr = 4 * wave + (lane >> 4), pos = lane & 15;
    const int kc = pos ^ (dr & 15);
    const int vc = ((((pos >> 2) ^ (dr & 3)) << 2) | (pos & 3));
    const int kread = qq * 256;
    const int trq = (lane & 15) >> 2, trrow = 4 * hh2 + trq;
    const int trcol = ((lane >> 4) & 1) * 32 + (lane & 3) * 8;
    for (int rr = 0; rr < 2; ++rr)
    for (int rid = vcu; rid < 256; rid += G) {
        int b, head, p, q0, R, dsh;
        if (rr == 0) { if (rid < 128) { b = rid >> 5; const int rem = rid & 31; head = rem >> 3; p = 0; q0 = 32 * (rem & 7); dsh = 0; }
                       else { const int a = rid - 128; b = a >> 5; const int rem = a & 31; head = 4 + (rem >> 3); const int r2 = rem & 7; p = r2 >> 1; q0 = 32 * (r2 & 1); dsh = 2; }
                       R = 32; }
        else { b = rid >> 6; const int rem = rid & 63; head = 8 + (rem >> 4); p = rem & 15; q0 = 0; dsh = 4; R = 16; }
        const int g_ = head >> 2, hh = head & 3;
        const size_t rowb = (size_t)b * SEQ + p;
        const bf16_t* Qh = Qb_ + head * HD; const bf16_t* Kh = Kb_ + head * HD + kc * 8; const bf16_t* Vh = Vb_ + head * HD + vc * 8;
        const LAS float* bh = biasL + head * AR_BROW + AR_BPAD;
        const int kstart = (q0 == 0) ? 4 : 0, nsteps = R + 4;
        const int ubase = 32 * (q0 - 4) + dr;
#define AR_DMA(kk, slotoff) do { const size_t tok_ = rowb + ((size_t)(ubase + 32 * (kk)) << dsh); const unsigned ld_ = (unsigned)__builtin_amdgcn_readfirstlane((int)(ldsbase + (unsigned)(slotoff) + (unsigned)wave * 1024u)); \
        ar_glds16(Kh + tok_ * QW, ld_); ar_glds16(Vh + tok_ * QW, ld_ + 8192u); } while (0)
#define AR_LOADQ(dst, iq_) do { const bf16_t* qp_ = Qh + (rowb + ((size_t)(32 * (q0 + (iq_)) + qq) << dsh)) * QW + hh2 * 8; \
        _Pragma("unroll") for (int ks = 0; ks < 8; ++ks) dst[ks] = NTLD((const bf16x8*)(qp_ + ks * 16)); } while (0)
        bf16x8 Qf[8], Qn[8];
        f32x16 O[4];
        float mrun = 0.f, lsum = 0.f;
        int iq = wave;
        bool pend = false; int iq_fin = 0;
        if (iq < R) AR_LOADQ(Qf, iq);
        int slot_cur = 0, slot_n1 = AR_SLOT, slot_n2 = 2 * AR_SLOT;
        if (!(RV & 1)) { AR_DMA(kstart, slot_cur); AR_DMA(kstart + 1, slot_n1); }
        asm volatile("s_waitcnt vmcnt(0)" ::: "memory"); __builtin_amdgcn_s_barrier(); asm volatile("" ::: "memory");
        asm volatile("" : "+v"(Qf[0]), "+v"(Qf[1]), "+v"(Qf[2]), "+v"(Qf[3]), "+v"(Qf[4]), "+v"(Qf[5]), "+v"(Qf[6]), "+v"(Qf[7]));
        for (int k = kstart; k < nsteps; ++k) {
            if (k + 2 < nsteps && !(RV & 1)) AR_DMA(k + 2, slot_n2);
            int nops = 0;
            if (pend && !(RV & 2)) {
                    { const auto rr_ = __builtin_amdgcn_permlane32_swap(__float_as_uint(lsum), __float_as_uint(lsum), false, false); lsum = __uint_as_float(rr_[0]) + __uint_as_float(rr_[1]); }
                    const float inv = 1.f / lsum;
#pragma unroll
                    for (int db = 0; db < 4; ++db)
#pragma unroll
                        for (int a = 0; a < 4; ++a) { u32x2 w; w.x = cvt_pk_bf16(O[db][4 * a] * inv, O[db][4 * a + 1] * inv); w.y = cvt_pk_bf16(O[db][4 * a + 2] * inv, O[db][4 * a + 3] * inv);
                            *(LAS u32x2*)(ost + qq * AR_OSTRIDE + (32 * db + 8 * a + 4 * hh2) * 2) = w; }
                    asm volatile("s_waitcnt lgkmcnt(0)" ::: "memory");
                    bf16_t* og = OG_ + (size_t)g_ * M * 512 + hh * HD;
                    const int u0 = 32 * (q0 + iq_fin);
#pragma unroll
                    for (int i = 0; i < 8; ++i) { const int rowi = i * 4 + (lane >> 4); const u32x4 v = *(const LAS u32x4*)(ost + rowi * AR_OSTRIDE + (lane & 15) * 16);
                        *(u32x4*)(og + (rowb + ((size_t)(u0 + rowi) << dsh)) * 512 + (lane & 15) * 8) = v; }
                    LSE_[((size_t)g_ * M + rowb + ((size_t)(u0 + qq) << dsh)) * 4 + hh] = mrun + __builtin_amdgcn_logf(lsum);
                    asm volatile("s_waitcnt lgkmcnt(0)" ::: "memory");
                    if (iq_fin + 8 < R) {
#pragma unroll
                        for (int ks = 0; ks < 8; ++ks) Qf[ks] = Qn[ks];
                    }
                pend = false; nops = 2;
            }
            const int j = k - iq;
            const bool active = (iq < R) && (j >= 0);
            if (active && !(RV & 2)) {
                const bool first = (k == (iq > kstart ? iq : kstart));
                if (AR_SKEW && j == 0) __builtin_amdgcn_s_sleep(AR_SKEW);
                if (AR_PRIO == 1) { if (j == 4) __builtin_amdgcn_s_setprio(2); else __builtin_amdgcn_s_setprio(0); }
                if (AR_PRIO == 2) { if (j == 0) __builtin_amdgcn_s_setprio(2); else __builtin_amdgcn_s_setprio(0); }
                if (first) {
#pragma unroll
                    for (int db = 0; db < 4; ++db)
#pragma unroll
                        for (int i = 0; i < 16; ++i) O[db][i] = 0.f;
                    lsum = 0.f;
                    if (iq + 8 < R) { AR_LOADQ(Qn, iq + 8); nops = 1; }
                }
                const LAS unsigned char* ks_ = lds + slot_cur;
                bf16x8 Kf[8];
#pragma unroll
                for (int ks = 0; ks < 8; ++ks) Kf[ks] = *(const LAS bf16x8*)(ks_ + kread + (((2 * ks + hh2) ^ (qq & 15)) << 4));
                if (AR_KPIN) asm volatile("" : "+v"(Kf[0]), "+v"(Kf[1]), "+v"(Kf[2]), "+v"(Kf[3]), "+v"(Kf[4]), "+v"(Kf[5]), "+v"(Kf[6]), "+v"(Kf[7]));
                const LAS float* bp = bh + (128 - 27 - 32 * j + qq - 4 * hh2);
                float bv0[8];
#pragma unroll
                for (int e = 0; e < 8; ++e) bv0[e] = bp[27 - ((e & 3) + 8 * (e >> 2))];
                f32x16 Sx;
#pragma unroll
                for (int i = 0; i < 16; ++i) Sx[i] = 0.f;
#pragma unroll
                for (int ks = 0; ks < 8; ++ks) Sx = __builtin_amdgcn_mfma_f32_32x32x16_bf16(Kf[ks], Qf[ks], Sx, 0, 0, 0);
                float mx = -INFINITY;
                {
#pragma unroll
                    for (int hf = 0; hf < 2; ++hf) {
                        float bv[8];
#pragma unroll
                        for (int e = 0; e < 8; ++e) { const int i = 8 * hf + e; bv[e] = (hf == 0) ? bv0[e] : bp[27 - ((i & 3) + 8 * (i >> 2))]; }
#pragma unroll
                        for (int e = 0; e < 8; ++e) { const int i = 8 * hf + e; const float sc = Sx[i] + bv[e]; Sx[i] = sc; mx = fmaxf(mx, sc); }
                        asm volatile("" ::: "memory");
                    }
                }
                { const auto rr_ = __builtin_amdgcn_permlane32_swap(__float_as_uint(mx), __float_as_uint(mx), false, false); mx = fmaxf(__uint_as_float(rr_[0]), __uint_as_float(rr_[1])); }
                if (first) mrun = mx;
                else if (__any(mx > mrun + 8.0f)) {
                    const float mnew = fmaxf(mrun, mx); const float alpha = __builtin_amdgcn_exp2f(mrun - mnew); mrun = mnew; lsum *= alpha;
#pragma unroll
                    for (int db = 0; db < 4; ++db)
#pragma unroll
                        for (int i = 0; i < 16; ++i) O[db][i] *= alpha;
                }
                float ps = 0.f;
#pragma unroll
                for (int i = 0; i < 16; ++i) { const float pv = __builtin_amdgcn_exp2f(Sx[i] - mrun); Sx[i] = pv; ps += pv; }
                lsum += ps;
                bf16x8 Pf[2];
#pragma unroll
                for (int s = 0; s < 2; ++s) { u32x4 w; w.x = cvt_pk_bf16(Sx[8 * s + 0], Sx[8 * s + 1]); w.y = cvt_pk_bf16(Sx[8 * s + 2], Sx[8 * s + 3]); w.z = cvt_pk_bf16(Sx[8 * s + 4], Sx[8 * s + 5]); w.w = cvt_pk_bf16(Sx[8 * s + 6], Sx[8 * s + 7]);
                    Pf[s] = __builtin_bit_cast(bf16x8, w); }
                asm volatile("" ::: "memory");
                const LAS unsigned char* vs_ = lds + slot_cur + 8192 + trrow * 256 + trcol;
#pragma unroll
                for (int db = 0; db < 4; ++db)
#pragma unroll
                    for (int s = 0; s < 2; ++s) { const LAS unsigned char* ap_ = vs_ + (16 * s) * 256 + ((db ^ trq) << 6);
                        const s16x4 lo = __builtin_bit_cast(s16x4, __builtin_amdgcn_ds_read_tr16_b64_v4i16((LAS s16x4*)ap_));
                        const s16x4 hi = __builtin_bit_cast(s16x4, __builtin_amdgcn_ds_read_tr16_b64_v4i16((LAS s16x4*)(ap_ + 8 * 256)));
                        const bf16x8 Vf = (bf16x8){lo[0], lo[1], lo[2], lo[3], hi[0], hi[1], hi[2], hi[3]};
                        O[db] = __builtin_amdgcn_mfma_f32_32x32x16_bf16(Vf, Pf[s], O[db], 0, 0, 0); }
                if (j == 4) { pend = true; iq_fin = iq; iq += 8; }
            }
            asm volatile("s_waitcnt lgkmcnt(0)" ::: "memory");
            if (RV & 2) { if (active && j == 4) iq += 8; }
            if (k + 2 < nsteps && !(RV & 1)) AR_WAIT_V3(__builtin_amdgcn_readfirstlane(nops), 11, 10, 2);
            else asm volatile("s_waitcnt vmcnt(0)" ::: "memory");
            __builtin_amdgcn_s_barrier(); asm volatile("" ::: "memory");
            { const int t_ = slot_cur; slot_cur = slot_n1; slot_n1 = slot_n2; slot_n2 = t_; }
        }
        if (pend && !(RV & 2)) {
                    { const auto rr_ = __builtin_amdgcn_permlane32_swap(__float_as_uint(lsum), __float_as_uint(lsum), false, false); lsum = __uint_as_float(rr_[0]) + __uint_as_float(rr_[1]); }
                    const float inv = 1.f / lsum;
#pragma unroll
                    for (int db = 0; db < 4; ++db)
#pragma unroll
                        for (int a = 0; a < 4; ++a) { u32x2 w; w.x = cvt_pk_bf16(O[db][4 * a] * inv, O[db][4 * a + 1] * inv); w.y = cvt_pk_bf16(O[db][4 * a + 2] * inv, O[db][4 * a + 3] * inv);
                            *(LAS u32x2*)(ost + qq * AR_OSTRIDE + (32 * db + 8 * a + 4 * hh2) * 2) = w; }
                    asm volatile("s_waitcnt lgkmcnt(0)" ::: "memory");
                    bf16_t* og = OG_ + (size_t)g_ * M * 512 + hh * HD;
                    const int u0 = 32 * (q0 + iq_fin);
#pragma unroll
                    for (int i = 0; i < 8; ++i) { const int rowi = i * 4 + (lane >> 4); const u32x4 v = *(const LAS u32x4*)(ost + rowi * AR_OSTRIDE + (lane & 15) * 16);
                        *(u32x4*)(og + (rowb + ((size_t)(u0 + rowi) << dsh)) * 512 + (lane & 15) * 8) = v; }
                    LSE_[((size_t)g_ * M + rowb + ((size_t)(u0 + qq) << dsh)) * 4 + hh] = mrun + __builtin_amdgcn_logf(lsum);
                    asm volatile("s_waitcnt lgkmcnt(0)" ::: "memory");
                    if (iq_fin + 8 < R) {
#pragma unroll
                        for (int ks = 0; ks < 8; ++ks) Qf[ks] = Qn[ks];
                    }
            pend = false;
        }
        asm volatile("s_waitcnt lgkmcnt(0)" ::: "memory");
#undef AR_DMA
#undef AR_LOADQ
    }
}

template <int VAR>
__device__ __forceinline__ void attn_phase(LAS unsigned char* lds, const float* btab_, const bf16_t* Qb_, const bf16_t* Kb_, const bf16_t* Vb_, bf16_t* OG_, float* LSE_, int tid, int lane, int wave, int vcu, int G) {
        LAS float* biasL = (LAS float*)(lds + ATT_BIAS_OFF);
        for (int i = tid; i < NH * 129; i += NTHREADS) { const int head = i / 129, st = i % 129, g_ = head >> 2; const int dil = g_ == 0 ? 1 : (g_ == 1 ? 4 : 16);
            biasL[head * 132 + st] = btab_[t5_bucket(st * dil) * NH + head] * LOG2E; }
        __syncthreads();
        LAS unsigned char* vl = lds + wave * ATT_V_BYTES;
        const int qq = lane & 31, hh2 = lane >> 5;
        const int tr_off = ((lane >> 4) >> 1) * 4 * VSTRIDE + (((lane & 15) >> 2)) * VSTRIDE + ((lane >> 4) & 1) * 32 + (lane & 3) * 8;
        for (int wu = vcu; wu < 1536; wu += G) {
            const int b = wu / 384, rem = wu % 384, head = rem >> 5, rem2 = rem & 31;
            const int g_ = head >> 2, hh = head & 3, dsh = 2 * g_;
            const int per = 32 >> dsh;
            const int p = rem2 / per, ub = rem2 % per;
            const int u0 = ub * 256 + wave * 32;
            const size_t rowb = (size_t)b * SEQ + p;
            const bf16_t* Qh = Qb_ + head * HD; const bf16_t* Kh = Kb_ + head * HD; const bf16_t* Vh = Vb_ + head * HD;
            bf16x8 Qf[8];
            { const bf16_t* qp = Qh + (rowb + ((size_t)(u0 + qq) << dsh)) * QW + hh2 * 8;
#pragma unroll
              for (int ks = 0; ks < 8; ++ks) Qf[ks] = *(const bf16x8*)(qp + ks * 16); }
            f32x16 O[4];
#pragma unroll
            for (int db = 0; db < 4; ++db)
#pragma unroll
                for (int i = 0; i < 16; ++i) O[db][i] = 0.f;
            float mrun = -INFINITY, lsum = 0.f;
            const int jstart = (u0 >= 128) ? 0 : (4 - (u0 >> 5));
            bf16x8 Kf[8]; u32x4 vst[8];
            const LAS float* bh = biasL + head * AR_BROW + AR_BPAD;
#define ATT_LOADK(jj) do { const bf16_t* kp = Kh + (rowb + ((size_t)(u0 - 128 + 32 * (jj) + qq) << dsh)) * QW + hh2 * 8; \
    _Pragma("unroll") for (int ks = 0; ks < 8; ++ks) Kf[ks] = *(const bf16x8*)(kp + ks * 16); } while (0)
#define ATT_LOADV(jj) do { _Pragma("unroll") for (int i = 0; i < 8; ++i) { const int rowi = i * 4 + (lane >> 4); \
    vst[i] = *(const u32x4*)(Vh + (rowb + ((size_t)(u0 - 128 + 32 * (jj) + rowi) << dsh)) * QW + (lane & 15) * 8); } } while (0)
            if (!(VAR & 1)) ATT_LOADK(jstart); else { _Pragma("unroll") for (int ks = 0; ks < 8; ++ks) Kf[ks] = Qf[ks]; }
            if (!(VAR & 2)) ATT_LOADV(jstart); else { _Pragma("unroll") for (int i = 0; i < 8; ++i) vst[i] = (u32x4){0x3c003c00u, 0x3c003c00u, 0x3c003c00u, 0x3c003c00u}; }
            for (int j = jstart; j < 5; ++j) {
#pragma unroll
                for (int i = 0; i < 8; ++i) { const int rowi = i * 4 + (lane >> 4); *(LAS u32x4*)(vl + rowi * VSTRIDE + (lane & 15) * 16) = vst[i]; }
                if (j < 4 && !(VAR & 2)) ATT_LOADV(j + 1);
                f32x16 Sx;
#pragma unroll
                for (int i = 0; i < 16; ++i) Sx[i] = 0.f;
#pragma unroll
                for (int ks = 0; ks < 8; ++ks) Sx = __builtin_amdgcn_mfma_f32_32x32x16_bf16(Kf[ks], Qf[ks], Sx, 0, 0, 0);
                if (j < 4 && !(VAR & 1)) ATT_LOADK(j + 1);
                float mx = -INFINITY;
                {
                    const int stb = 128 - 32 * j + qq - 4 * hh2;
#pragma unroll
                    for (int hf = 0; hf < 2; ++hf) {
                        float bv[8];
#pragma unroll
                        for (int e = 0; e < 8; ++e) { const int i = 8 * hf + e; int st = stb - ((i & 3) + 8 * (i >> 2)); st = st < 0 ? 0 : (st > 128 ? 128 : st); bv[e] = bh[st]; }
                        if (j == 0 || j == 4) {
#pragma unroll
                            for (int e = 0; e < 8; ++e) { const int i = 8 * hf + e; const int st = stb - ((i & 3) + 8 * (i >> 2)); const bool ok = (st >= 0) && (st <= 128);
                                const float sc = ok ? Sx[i] + bv[e] : -INFINITY; Sx[i] = sc; mx = fmaxf(mx, sc); }
                        } else {
#pragma unroll
                            for (int e = 0; e < 8; ++e) { const int i = 8 * hf + e; const float sc = Sx[i] + bv[e]; Sx[i] = sc; mx = fmaxf(mx, sc); }
                        }
                        asm volatile("" ::: "memory");
                    }
                }
                mx = fmaxf(mx, __shfl_xor(mx, 32));
                if (j == jstart) mrun = mx;
                else if (__any(mx > mrun + 8.0f)) {
                    const float mnew = fmaxf(mrun, mx); const float alpha = __builtin_amdgcn_exp2f(mrun - mnew); mrun = mnew; lsum *= alpha;
#pragma unroll
                    for (int db = 0; db < 4; ++db)
#pragma unroll
                        for (int i = 0; i < 16; ++i) O[db][i] *= alpha;
                }
                float ps = 0.f;
#pragma unroll
                for (int i = 0; i < 16; ++i) { const float pv = __builtin_amdgcn_exp2f(Sx[i] - mrun); Sx[i] = pv; ps += pv; }
                lsum += ps;
                bf16x8 Pf[2];
#pragma unroll
                for (int s = 0; s < 2; ++s) { u32x4 w; w.x = cvt_pk_bf16(Sx[8 * s + 0], Sx[8 * s + 1]); w.y = cvt_pk_bf16(Sx[8 * s + 2], Sx[8 * s + 3]); w.z = cvt_pk_bf16(Sx[8 * s + 4], Sx[8 * s + 5]); w.w = cvt_pk_bf16(Sx[8 * s + 6], Sx[8 * s + 7]);
                    Pf[s] = __builtin_bit_cast(bf16x8, w); }
                asm volatile("s_waitcnt lgkmcnt(0)" ::: "memory");
                if (VAR & 4) { asm volatile("" :: "v"(Pf[0]), "v"(Pf[1])); } else
#pragma unroll
                for (int db = 0; db < 4; ++db)
#pragma unroll
                    for (int s = 0; s < 2; ++s) {
                        const LAS unsigned char* ap_ = vl + tr_off + (16 * s) * VSTRIDE + 64 * db;
                        const s16x4 lo = __builtin_bit_cast(s16x4, __builtin_amdgcn_ds_read_tr16_b64_v4i16((LAS s16x4*)ap_));
                        const s16x4 hi = __builtin_bit_cast(s16x4, __builtin_amdgcn_ds_read_tr16_b64_v4i16((LAS s16x4*)(ap_ + 8 * VSTRIDE)));
                        const bf16x8 Vf = (bf16x8){lo[0], lo[1], lo[2], lo[3], hi[0], hi[1], hi[2], hi[3]};
                        O[db] = __builtin_amdgcn_mfma_f32_32x32x16_bf16(Vf, Pf[s], O[db], 0, 0, 0);
                    }
                asm volatile("s_waitcnt lgkmcnt(0)" ::: "memory");
            }
#undef ATT_LOADK
#undef ATT_LOADV
            lsum += __shfl_xor(lsum, 32);
            const float inv = 1.f / lsum;
#pragma unroll
            for (int db = 0; db < 4; ++db)
#pragma unroll
                for (int a = 0; a < 4; ++a) { u32x2 w; w.x = cvt_pk_bf16(O[db][4 * a] * inv, O[db][4 * a + 1] * inv); w.y = cvt_pk_bf16(O[db][4 * a + 2] * inv, O[db][4 * a + 3] * inv);
                    *(LAS u32x2*)(vl + qq * VSTRIDE + (32 * db + 8 * a + 4 * hh2) * 2) = w; }
            asm volatile("s_waitcnt lgkmcnt(0)" ::: "memory");
            bf16_t* og = OG_ + (size_t)g_ * M * 512 + hh * HD;
#pragma unroll
            for (int i = 0; i < 8; ++i) { const int rowi = i * 4 + (lane >> 4); const u32x4 v = *(const LAS u32x4*)(vl + rowi * VSTRIDE + (lane & 15) * 16);
                *(u32x4*)(og + (rowb + ((size_t)(u0 + rowi) << dsh)) * 512 + (lane & 15) * 8) = v; }
            if (hh2 == 0) LSE_[((size_t)g_ * M + rowb + ((size_t)(u0 + qq) << dsh)) * 4 + hh] = mrun + __builtin_amdgcn_logf(lsum);
            asm volatile("s_waitcnt lgkmcnt(0)" ::: "memory");
        }
    }

__global__ void __launch_bounds__(NTHREADS, 2) mk_fwd(Args args) {
    extern __shared__ __attribute__((aligned(16))) unsigned char lds_raw[];
    LAS unsigned char* lds = (LAS unsigned char*)lds_raw;
    cg::grid_group grid = cg::this_grid();
    const int wave_s = __builtin_amdgcn_readfirstlane((int)(threadIdx.x >> 6));
#define TIDX() (wave_s * 64 + lane_id_now())
#define KARGS_EARLY() ({ const Args __attribute__((address_space(4)))* p_ = (const Args __attribute__((address_space(4)))*)__builtin_amdgcn_kernarg_segment_ptr(); p_; })
    volatile LAS unsigned* bst = (volatile LAS unsigned*)(lds + BAR_LDS_OFF);
    if (TIDX() < 2) bst[TIDX()] = 0u;
    __syncthreads();
    (void)xcd_barrier_post((unsigned*)(KARGS_EARLY()->ws), bst, TIDX() == 0);
#define GRID_BAR_RAW() do { XcdBarrier b_; b_.bar = (unsigned*)(KARGS()->ws); b_.x = xb_xcc_id(); b_.st = (volatile LAS unsigned*)(lds + BAR_LDS_OFF); b_.lead = (TIDX() == 0); xcd_barrier(b_); } while (0)
    int bar_idx = 0; (void)bar_idx;
    if (BARSTAT && TIDX() == 0) ((unsigned long long*)(KARGS_EARLY()->ws + 32768))[(14 * 256 + blockIdx.x) * 2 + 1] = __builtin_amdgcn_s_memrealtime();
#define GRID_BAR() do { if (BARSTAT) { const unsigned long long t0_ = __builtin_amdgcn_s_memrealtime(); GRID_BAR_RAW(); const unsigned long long t1_ = __builtin_amdgcn_s_memrealtime(); \
        if (TIDX() == 0) { unsigned long long* wt_ = (unsigned long long*)(KARGS()->ws + 32768); wt_[(bar_idx * 256 + blockIdx.x) * 2] = t1_ - t0_; wt_[(bar_idx * 256 + blockIdx.x) * 2 + 1] = t1_; } ++bar_idx; } else GRID_BAR_RAW(); } while (0)
    const int G = gridDim.x, bx = blockIdx.x;
#define PHASE_IDS() int tid = TIDX(); asm volatile("" : "+v"(tid)); const int lane = tid & 63, wave = __builtin_amdgcn_readfirstlane(tid >> 6); \
    const int vcu = (G % 8 == 0) ? (bx % 8) * (G / 8) + bx / 8 : bx; const int gw = vcu * NWAVES + wave, NGW = G * NWAVES; (void)lane; (void)gw; (void)NGW; (void)vcu;
typedef const Args __attribute__((address_space(4)))* kargs_ptr_t;
#define KARGS() ({ kargs_ptr_t p_ = (kargs_ptr_t)__builtin_amdgcn_kernarg_segment_ptr(); asm volatile("" : "+s"(p_)); p_; })
#define INP(i) (KARGS()->in[i])
#define WSP(T, off) ((T*)(KARGS()->ws + (off)))
    constexpr int I_GU = 16 * 88, I_D = 44 * 32, I_IN = 16 * 272, I_L = 4 * 8, I_AB = 8 * 32, I_SQ = 16 * 32;
    constexpr int NITEMS = 6 * I_GU   + I_IN + 8 * I_L + I_AB + 2 * I_SQ;
    static_assert(I_D == I_GU, "item counts");
    constexpr int P0_LATE = SPLIT_S3 ? NITEMS - 3 * I_GU : NITEMS;
    for (int rep_ = 0; rep_ < 1 + DUP(0); ++rep_) if (PH(0)) { PHASE_IDS();
        LAS float* scr = (LAS float*)(lds + wave * 16384);
#define P0_DECODE(it_, d_) do { int r = (it_); \
            if (p0_job<1>(r, P_w1g, FF, DM, FF, P_n1pre, P_WGU1, DM, 0, d_, lane)) break; \
            if (p0_job<2>(r, P_w1u, FF, DM, FF, P_n1pre, P_WGU1, DM, 0, d_, lane)) break; \
            if (p0_job<0>(r, P_w1d, DM, FF, DM, nullptr, P_WD1, FF, 0, d_, lane)) break; \
            if (p0_job<0>(r, P_win, WINC, DM, 6656, P_mpre, P_WIN, DM, 0, d_, lane)) break;                           \
            if (p0_job<1>(r, P_win + 6656, WINC, DM, DM, P_mpre, P_WIN, DM, 6656, d_, lane)) break;                   \
            if (p0_job<2>(r, P_win + 7680, WINC, DM, DM, P_mpre, P_WIN, DM, 6656, d_, lane)) break;                   \
            bool done = false; \
            _Pragma("unroll 1") for (int h = 0; h < 4 && !done; ++h) { \
                if (p0_job<1>(r, P_wx + (size_t)h * 65536, 256, 256, 256, nullptr, P_WLRU, 256, h * 512, d_, lane)) { done = true; break; } \
                if (p0_job<2>(r, P_wa + (size_t)h * 65536, 256, 256, 256, nullptr, P_WLRU, 256, h * 512, d_, lane)) { done = true; break; } \
            } \
            if (done) break; \
            if (p0_job<0>(r, P_wab, DM, 512, DM, nullptr, P_WAB, DM, 0, d_, lane)) break; \
            if (p0_job<0>(r, P_wrb, DM, DM, DM, nullptr, P_WRB, DM, 0, d_, lane)) break; \
            if (p0_job<0>(r, P_wout, DM, DM, DM, nullptr, P_WOUT, DM, 0, d_, lane)) break; \
            if (p0_job<1>(r, P_w2g, FF, DM, FF, P_n2pre, P_WGU2, DM, 0, d_, lane)) break; \
            if (p0_job<2>(r, P_w2u, FF, DM, FF, P_n2pre, P_WGU2, DM, 0, d_, lane)) break; \
            p0_job<0>(r, P_w2d, DM, FF, DM, nullptr, P_WD2, FF, 0, d_, lane); } while (0)
#define P0_RUN(lo_, hi_) do { P0D dA, dB; float vA[32], vB[32]; f32x4 gA0, gA1, gB0, gB1; \
          int it = (lo_) + gw; \
          if (it < (hi_)) { P0_DECODE(it, dA); p0_load(vA, gA0, gA1, dA, lane); } \
          for (; it < (hi_); it += 2 * NGW) { \
              const int itB = it + NGW; const bool hasB = itB < (hi_); \
              if (hasB) { P0_DECODE(itB, dB); p0_load(vB, gB0, gB1, dB, lane); } \
              p0_finish(vA, gA0, gA1, dA, scr, lane); \
              const int itA2 = it + 2 * NGW; \
              if (itA2 < (hi_)) { P0_DECODE(itA2, dA); p0_load(vA, gA0, gA1, dA, lane); } \
              if (hasB) p0_finish(vB, gB0, gB1, dB, scr, lane); \
          } } while (0)
        P0_RUN(0, SPLIT_P0 ? 2 * I_GU : P0_LATE);
        { float* lc_ = P_LC; const float *bx_ = P_bxp, *ba_ = P_bap, *ap_ = P_app;
          for (int c = gw * 64 + lane; c < DM; c += NGW * 64) { lc_[c] = -bx_[c] * LOG2E; lc_[DM + c] = -ba_[c] * LOG2E; const float nap = -ap_[c]; lc_[2 * DM + c] = -8.f * ((nap > 20.f) ? nap : log1pf(expf(nap))); } }
        { const float* x_ = P_x; bf16_t* AB_ = P_AB; float* RSQ0_ = P_RSQ0;
        for (int row0 = gw; row0 < M; row0 += 4 * NGW) {
            f32x4 a[4][2][2];
#pragma unroll
            for (int q = 0; q < 4; ++q)
#pragma unroll
                for (int j = 0; j < 2; ++j) { const float* xr = x_ + (size_t)(row0 + q * NGW) * DM + 8 * lane + 512 * j; a[q][j][0] = NTLD((const f32x4*)xr); a[q][j][1] = NTLD((const f32x4*)(xr + 4)); }
#pragma unroll
            for (int q = 0; q < 4; ++q) { const int row = row0 + q * NGW; float s = 0.f;
#pragma unroll
                for (int j = 0; j < 2; ++j) { const f32x4 u = a[q][j][0], v = a[q][j][1];
                    s += (u[0] * u[0] + u[1] * u[1]) + (u[2] * u[2] + u[3] * u[3]) + (v[0] * v[0] + v[1] * v[1]) + (v[2] * v[2] + v[3] * v[3]);
                    u32x4 w; w.x = cvt_pk_bf16(u[0], u[1]); w.y = cvt_pk_bf16(u[2], u[3]); w.z = cvt_pk_bf16(v[0], v[1]); w.w = cvt_pk_bf16(v[2], v[3]);
                    *(u32x4*)(AB_ + (size_t)row * DM + 8 * lane + 512 * j) = w; }
                s = wave_sum(s); if (lane == 0) *(f32x4*)(RSQ0_ + 4 * (size_t)row) = (f32x4){s, 0.f, 0.f, 0.f}; }
        } }
        if (SPLIT_P0) { sb_arrive((unsigned*)(KARGS()->ws), (volatile LAS unsigned*)(lds + BAR_LDS_OFF), tid == 0, 0u); P0_RUN(2 * I_GU, P0_LATE); }
    }
    unsigned long long tgs0_ = 0ull; if (BARSTAT >= 320 && BARSTAT < 330) { tgs0_ = __builtin_amdgcn_s_memrealtime(); if (TIDX() == 0) ((unsigned long long*)(KARGS()->ws + 32768))[(13 * 256 + blockIdx.x) * 2 + 1] = tgs0_; }
#define SB_WAIT(k_) do { if (BARSTAT) { const unsigned long long t0_ = __builtin_amdgcn_s_memrealtime(); sb_wait((unsigned*)(KARGS()->ws), (volatile LAS unsigned*)(lds + BAR_LDS_OFF), TIDX() == 0, (k_)); const unsigned long long t1_ = __builtin_amdgcn_s_memrealtime(); \
        if (TIDX() == 0) { unsigned long long* wt_ = (unsigned long long*)(KARGS()->ws + 32768); wt_[(bar_idx * 256 + blockIdx.x) * 2] = t1_ - t0_; wt_[(bar_idx * 256 + blockIdx.x) * 2 + 1] = t1_; } ++bar_idx; } else sb_wait((unsigned*)(KARGS()->ws), (volatile LAS unsigned*)(lds + BAR_LDS_OFF), TIDX() == 0, (k_)); } while (0)
#define SB_ARRIVE(k_) sb_arrive((unsigned*)(KARGS()->ws), (volatile LAS unsigned*)(lds + BAR_LDS_OFF), TIDX() == 0, (k_))
    if (SPLIT_P0) SB_WAIT(0u); else GRID_BAR();
    constexpr bool gg = SPLIT_GG;
    constexpr unsigned K_G1 = SPLIT_P0 ? 1u : 0u, K_G2 = K_G1 + (SPLIT_GG ? 2u : 0u), K_ATT = K_G2 + (SPLIT_GN ? 2u : 0u), K_G3B = K_ATT + (SPLIT_ATT ? 1u : 0u), K_P7 = K_G3B + (SPLIT_G3B ? 1u : 0u), K_LA = K_P7 + (SPLIT_P7 ? 3u : 0u), K_S3 = K_LA + (SPLIT_LA ? 2u : 0u), K_G4W = K_S3 + (SPLIT_S3 ? 1u : 0u),
                       K_G4 = K_G4W + (SPLIT_G4 ? 1u : 0u), K_G4N = K_G4 + (SPLIT_GG ? 2u : 0u), K_G5 = K_G4N + (SPLIT_GN ? 2u : 0u);
    if (KARGS()->ws == nullptr) grid.sync();
    if (BARSTAT == 320 && TIDX() == 0) ((unsigned long long*)(KARGS()->ws + 32768))[(14 * 256 + blockIdx.x) * 2] = __builtin_amdgcn_s_memrealtime() - tgs0_;
    unsigned long long clk0_ = 0ull, rt0_ = 0ull; if (BARSTAT == 300) { clk0_ = __builtin_amdgcn_s_memtime(); rt0_ = __builtin_amdgcn_s_memrealtime(); }

    pg8::StaticOrder SO; SO.wv = wave_s;
    for (int rep_ = 0; rep_ < 1 + DUP(1); ++rep_) if (PH(1)) { pg8::Gemm g{P_AB, DM, P_WGU1, DM, M, 2 * FF, DM, 0, KREP_G1, EREP_G1}; if (gg) { g.sb_bar = (unsigned*)(KARGS()->ws); g.sb_st = (volatile LAS unsigned*)(lds + BAR_LDS_OFF); g.arr_u = 5; g.arr_k = K_G1; } SO.init(M, 2 * FF, G, bx); pg8::EpiSwiGLU E{P_HID, FF, P_RSQ0, (LAS float*)(lds + NORM_LDS_OFF)}; pg8::gemm_phase(lds, g, SO, E); }
    if (BARSTAT == 300 && blockIdx.x == 0 && TIDX() == 0) { const unsigned long long c1_ = __builtin_amdgcn_s_memtime(), r1_ = __builtin_amdgcn_s_memrealtime(); ((float*)(KARGS()->ws + 200 * 1024))[0] = (float)(c1_ - clk0_) / (float)(r1_ - rt0_) * 100.f; }
    if (gg) { SB_ARRIVE(K_G1 + 1u); SB_WAIT(K_G1); } else GRID_BAR();
    for (int rep_ = 0; rep_ < 1 + DUP(2); ++rep_) if (PH(2)) { pg8::Gemm g{P_HID, FF, P_WD1, FF, M, DM, FF, 0}; SO.init(M, DM, G, bx); if (gg) { g.sb_bar = (unsigned*)(KARGS()->ws); g.sb_st = (volatile LAS unsigned*)(lds + BAR_LDS_OFF); g.sb_mode = 3; g.sb_u = 0; g.sb_k = K_G1 + 1u; } if (SPLIT_GN) { g.sb_bar = (unsigned*)(KARGS()->ws); g.sb_st = (volatile LAS unsigned*)(lds + BAR_LDS_OFF); g.arr_u = 0; g.arr_k = K_G2; } if (BARSTAT == 313) g.ts = (unsigned long long*)(KARGS()->ws + 201 * 1024);
        if (FUSED_NORM) { pg8::EpiNormRes<0> E{P_x, P_AB, nullptr, P_n1post, 0.5f, P_XS, 1u, P_RSQ1, lds + NORM_LDS_OFF}; pg8::gemm_phase(lds, g, SO, E); }
        else { pg8::EpiBf16 E{P_Fb, DM}; pg8::gemm_phase(lds, g, SO, E); } }

    if (!FUSED_NORM) GRID_BAR();
    for (int rep_ = 0; rep_ < 1 + DUP(3); ++rep_) if (PH(3) && !FUSED_NORM) { PHASE_IDS(); norm_pass<true, false>(P_Fb, P_AB, P_x, P_n1post, 0.5f, nullptr, P_RSQ1, gw, NGW, lane); }
    if (SPLIT_GN) { SB_ARRIVE(K_G2 + 1u); SB_WAIT(K_G2); } else GRID_BAR();
    for (int rep_ = 0; rep_ < 1 + DUP(4); ++rep_) if (PH(4)) { pg8::Gemm g{P_AB, DM, P_WIN, DM, M, 3 * QW, DM, 0, 1, EREP_G3A}; g.stag = STAG_G3A; if (SPLIT_GN) { g.sb_bar = (unsigned*)(KARGS()->ws); g.sb_st = (volatile LAS unsigned*)(lds + BAR_LDS_OFF); g.sb_mode = 1; g.sb_k = K_G2 + 1u; g.prep_split = 1; }     if ((BARSTAT >= 310 && BARSTAT <= 312) || (BARSTAT >= 342 && BARSTAT <= 349)) g.ts = (unsigned long long*)(KARGS()->ws + 201 * 1024); SO.init(M, 3 * QW, G, bx); pg8::EpiProj<0> E{P_Qb, (size_t)(WS_K - WS_Q) / 2, P_RSQ1, (LAS float*)(lds + NORM_LDS_OFF)}; pg8::gemm_phase(lds, g, SO, E); }
    if (SPLIT_ATT) SB_ARRIVE(K_ATT); else GRID_BAR();
    for (int rep_ = 0; rep_ < 1 + DUP(5); ++rep_) if (PH(5)) { PHASE_IDS();
        attn_bias_build(lds, P_btab, tid);
        if (SPLIT_ATT) SB_WAIT(K_ATT);
        if (ATTN_RING) attn_ring_phase<0>(lds, P_btab, P_Qb, P_Kb, P_Vb, P_OG, P_LSE, tid, lane, wave, vcu, G);
        else attn_phase<0>(lds, P_btab, P_Qb, P_Kb, P_Vb, P_OG, P_LSE, tid, lane, wave, vcu, G);
        if (ATTN_PROBE) attn_ring_phase<ATTN_PROBE>(lds, P_btab, P_Qb, P_Kb, P_Vb, (bf16_t*)(KARGS()->out), (float*)((unsigned char*)(KARGS()->out) + 96 * MiB), tid, lane, wave, vcu, G);
    }
    if (SPLIT_G3B) SB_ARRIVE(K_G3B); else GRID_BAR();
    for (int rep_ = 0; rep_ < 1 + DUP(6); ++rep_) if (PH(6)) { pg8::Gemm g{P_AB, DM, P_WIN + (size_t)3 * QW * DM, DM, M, 4 * DM, DM, 0}; if (SPLIT_G3B) { g.sb_bar = (unsigned*)(KARGS()->ws); g.sb_st = (volatile LAS unsigned*)(lds + BAR_LDS_OFF); g.sb_mode = 1; g.sb_k = K_G3B; } SO.init(M, 4 * DM, G, bx); pg8::EpiProj<1> E{P_XR, (size_t)(WS_YG - WS_XR) / 2, P_RSQ1, (LAS float*)(lds + NORM_LDS_OFF)}; pg8::gemm_phase(lds, g, SO, E); }

    if (SPLIT_P7) SB_ARRIVE(K_P7); else GRID_BAR();
    for (int rep_ = 0; rep_ < 1 + DUP(7); ++rep_) if (PH(7)) { PHASE_IDS();
#define P7_MERGE(msel_) do { \
        for (int row0 = gw; row0 < M / 2; row0 += 4 * NGW) {     \
            const int hh = lane >> 4; float ls[4][3]; u32x4 vv[4][3]; \
        _Pragma("unroll") \
            for (int q = 0; q < 4; ++q) \
        _Pragma("unroll") \
                for (int g_ = 0; g_ < 3; ++g_) { const int i_ = row0 + q * NGW; const size_t row = (size_t)g_ * M + ((((i_ >> 12) << 13) | (i_ & 4095)) | (msel_)); ls[q][g_] = LSE_[row * 4 + hh]; vv[q][g_] = NTLD((const u32x4*)(OG_ + row * 512 + lane * 8)); } \
        _Pragma("unroll") \
            for (int q = 0; q < 4; ++q) { const int i_ = row0 + q * NGW; const int row = (((i_ >> 12) << 13) | (i_ & 4095)) | (msel_); const float l0 = ls[q][0], l1 = ls[q][1], l2 = ls[q][2]; \
                const float mx = fmaxf(l0, fmaxf(l1, l2)); const float e0 = __builtin_amdgcn_exp2f(l0 - mx), e1 = __builtin_amdgcn_exp2f(l1 - mx), e2 = __builtin_amdgcn_exp2f(l2 - mx); \
                const float inv = 1.f / (e0 + e1 + e2); const float a0 = e0 * inv, a1 = e1 * inv, a2 = e2 * inv; \
                const u32x4 v0 = vv[q][0], v1 = vv[q][1], v2 = vv[q][2]; \
                u32x4 o; \
                o.x = cvt_pk_bf16(a0 * bflo(v0.x) + a1 * bflo(v1.x) + a2 * bflo(v2.x), a0 * bfhi(v0.x) + a1 * bfhi(v1.x) + a2 * bfhi(v2.x)); \
                o.y = cvt_pk_bf16(a0 * bflo(v0.y) + a1 * bflo(v1.y) + a2 * bflo(v2.y), a0 * bfhi(v0.y) + a1 * bfhi(v1.y) + a2 * bfhi(v2.y)); \
                o.z = cvt_pk_bf16(a0 * bflo(v0.z) + a1 * bflo(v1.z) + a2 * bflo(v2.z), a0 * bfhi(v0.z) + a1 * bfhi(v1.z) + a2 * bfhi(v2.z)); \
                o.w = cvt_pk_bf16(a0 * bflo(v0.w) + a1 * bflo(v1.w) + a2 * bflo(v2.w), a0 * bfhi(v0.w) + a1 * bfhi(v1.w) + a2 * bfhi(v2.w)); \
                *(u32x4*)(ATT_ + (size_t)row * DM + lane * 8) = o; } \
        } \
        } while (0)
        { const float* LSE_ = P_LSE; const bf16_t* OG_ = P_OG; bf16_t* ATT_ = P_ATT; if (SPLIT_P7) { P7_MERGE(0); SB_WAIT(K_P7); } }
        const float *cw_ = P_cw, *cb_ = P_cb; const bf16_t* XR_ = P_XR; bf16_t* XC_ = P_XC;
        for (int it = gw; it < (M / 32) * 2; it += NGW) {
            const int rb = it >> 1, c0 = (it & 1) * 512 + lane * 8, r0 = rb * 32, t0 = r0 % SEQ;
            float w[4][8], bias[8];
#pragma unroll
            for (int j = 0; j < 4; ++j)
#pragma unroll
                for (int i = 0; i < 8; ++i) w[j][i] = cw_[j * DM + c0 + i];
#pragma unroll
            for (int i = 0; i < 8; ++i) bias[i] = cb_[c0 + i];
            float xw[3][8];
#pragma unroll
            for (int j = 0; j < 3; ++j) { const int tt = t0 - 3 + j;
                u32x4 v = (u32x4){0u, 0u, 0u, 0u}; if (tt >= 0) v = *(const u32x4*)(XR_ + (size_t)(r0 - 3 + j) * DM + c0);
                xw[j][0] = bflo(v.x); xw[j][1] = bfhi(v.x); xw[j][2] = bflo(v.y); xw[j][3] = bfhi(v.y); xw[j][4] = bflo(v.z); xw[j][5] = bfhi(v.z); xw[j][6] = bflo(v.w); xw[j][7] = bfhi(v.w); }
#pragma unroll 1
            for (int t8 = 0; t8 < 32; t8 += 8) { u32x4 vv[8];
#pragma unroll
              for (int q = 0; q < 8; ++q) vv[q] = NTLD((const u32x4*)(XR_ + (size_t)(r0 + t8 + q) * DM + c0));
#pragma unroll
              for (int q = 0; q < 8; ++q) { const int t = t8 + q; const u32x4 v = vv[q];
                const float x3[8] = {bflo(v.x), bfhi(v.x), bflo(v.y), bfhi(v.y), bflo(v.z), bfhi(v.z), bflo(v.w), bfhi(v.w)}; float o[8];
#pragma unroll
                for (int i = 0; i < 8; ++i) { o[i] = bias[i] + w[0][i] * xw[0][i] + w[1][i] * xw[1][i] + w[2][i] * xw[2][i] + w[3][i] * x3[i]; xw[0][i] = xw[1][i]; xw[1][i] = xw[2][i]; xw[2][i] = x3[i]; }
                u32x4 ov; ov.x = cvt_pk_bf16(o[0], o[1]); ov.y = cvt_pk_bf16(o[2], o[3]); ov.z = cvt_pk_bf16(o[4], o[5]); ov.w = cvt_pk_bf16(o[6], o[7]);
                *(u32x4*)(XC_ + (size_t)(r0 + t) * DM + c0) = ov; } }
        }
        { const float* LSE_ = P_LSE; const bf16_t* OG_ = P_OG; bf16_t* ATT_ = P_ATT; if (SPLIT_P7) { SB_ARRIVE(K_P7 + 1u); P7_MERGE(4096); SB_ARRIVE(K_P7 + 2u); } else { P7_MERGE(0); P7_MERGE(4096); } }
#undef P7_MERGE
    }
    if (SPLIT_P7) SB_WAIT(K_P7 + 1u); else GRID_BAR();
    for (int rep_ = 0; rep_ < 1 + DUP(8); ++rep_) if (PH(8)) { pg8::Gemm g{P_XC, DM, P_WLRU, 256, M, 2 * DM, 256, 1}; if (SPLIT_LA) { g.sb_bar = (unsigned*)(KARGS()->ws); g.sb_st = (volatile LAS unsigned*)(lds + BAR_LDS_OFF); g.arr_u = 1; g.arr_k = K_LA; } if (SPLIT_P7) { g.sb_bar = (unsigned*)(KARGS()->ws); g.sb_st = (volatile LAS unsigned*)(lds + BAR_LDS_OFF); g.sb_mode = 1; g.sb_u = 2; g.sb_k = K_P7 + 2u; } if (BARSTAT == 315) g.ts = (unsigned long long*)(KARGS()->ws + 201 * 1024); SO.init(M, 2 * DM, G, bx); pg8::EpiLru E{P_XC, P_LC, P_LA, P_BB}; pg8::gemm_phase(lds, g, SO, E); }
    if (SPLIT_LA) { SB_ARRIVE(K_LA + 1u); SB_WAIT(K_LA); } else GRID_BAR();
    for (int rep_ = 0; rep_ < 1 + DUP(9); ++rep_) if (PH(9)) { PHASE_IDS(); const bf16_t *LA_ = P_LA, *BB_ = P_BB; float *CA_ = P_CA, *CH_ = P_CH;
#define S1_ITEM(hf_, ck_, b_) do { const int hf = (hf_), ck = (ck_), b = (b_); const int c0 = hf * 512 + lane * 8; const size_t r0 = (size_t)b * SEQ + ck * 32; \
        float h[8], sl[8]; \
        _Pragma("unroll") for (int i = 0; i < 8; ++i) { h[i] = 0.f; sl[i] = 0.f; } \
        _Pragma("unroll 8") for (int t = 0; t < 32; ++t) { const u32x4 lw = NTLD((const u32x4*)(LA_ + (r0 + t) * DM + c0)), bw = NTLD((const u32x4*)(BB_ + (r0 + t) * DM + c0)); \
            const float l[8] = {bflo(lw.x), bfhi(lw.x), bflo(lw.y), bfhi(lw.y), bflo(lw.z), bfhi(lw.z), bflo(lw.w), bfhi(lw.w)}, bv[8] = {bflo(bw.x), bfhi(bw.x), bflo(bw.y), bfhi(bw.y), bflo(bw.z), bfhi(bw.z), bflo(bw.w), bfhi(bw.w)}; \
            _Pragma("unroll") for (int i = 0; i < 8; ++i) { sl[i] += l[i]; h[i] = __builtin_amdgcn_exp2f(l[i] * LOG2E) * h[i] + bv[i]; } } \
        float* ca = CA_ + ((size_t)(b * 256 + ck)) * DM + c0; float* ch = CH_ + ((size_t)(b * 256 + ck)) * DM + c0; \
        *(f32x4*)ca = (f32x4){sl[0], sl[1], sl[2], sl[3]}; *(f32x4*)(ca + 4) = (f32x4){sl[4], sl[5], sl[6], sl[7]}; \
        *(f32x4*)ch = (f32x4){h[0], h[1], h[2], h[3]}; *(f32x4*)(ch + 4) = (f32x4){h[4], h[5], h[6], h[7]}; } while (0)
    if (SPLIT_LA) {
        const int j = vcu * 4 + (wave & 3);
        const int ckl = ((j >> 1) & 63) | (((j >> 7) & 1) << 7);
        if (wave < 4) S1_ITEM(j & 1, ckl, j >> 8);
        SB_WAIT(K_LA + 1u);
        if (wave < 4) S1_ITEM(j & 1, ckl | 64, j >> 8);
    } else {
        for (int it = gw; it < BATCH * 256 * 2; it += NGW) S1_ITEM(it & 1, (it >> 1) & 255, it >> 9);
    }
#undef S1_ITEM
    }
    if (SPLIT_S3) { SB_ARRIVE(K_S3); { PHASE_IDS(); LAS float* scr = (LAS float*)(lds + wave * 16384); P0_RUN(P0_LATE, NITEMS); } SB_WAIT(K_S3); } else GRID_BAR();
#undef P0_RUN
#undef P0_DECODE
    for (int rep_ = 0; rep_ < 1 + DUP(10); ++rep_) if (PH(10)) { PHASE_IDS(); const bf16_t *LA_ = P_LA, *BB_ = P_BB, *YG_ = P_YG; const float *CA_ = P_CA, *CH_ = P_CH; bf16_t* REC_ = P_REC;
    for (int wu = vcu; wu < 256; wu += G) {
        const int b = wu >> 6, hf = (wu >> 5) & 1, g = wu & 31, ck = 8 * g + wave; const int c0 = hf * 512 + lane * 8; const size_t r0 = (size_t)b * SEQ + ck * 32;
        LAS float* part = (LAS float*)lds;
        float h[8];
        { float pa[8], ph[8];
#pragma unroll
          for (int i = 0; i < 8; ++i) { pa[i] = 0.f; ph[i] = 0.f; }
          { int k = g * wave; const int ke = g * wave + g;
            for (; k + 4 <= ke; k += 4) {
              f32x4 qa0[4], qa1[4], qh0[4], qh1[4];
#pragma unroll
              for (int u = 0; u < 4; ++u) { const float* ca = CA_ + ((size_t)(b * 256 + k + u)) * DM + c0; const float* ch = CH_ + ((size_t)(b * 256 + k + u)) * DM + c0;
                  qa0[u] = *(const f32x4*)ca; qa1[u] = *(const f32x4*)(ca + 4); qh0[u] = *(const f32x4*)ch; qh1[u] = *(const f32x4*)(ch + 4); }
#pragma unroll
              for (int u = 0; u < 4; ++u)
#pragma unroll
                  for (int i = 0; i < 4; ++i) { ph[i] = __builtin_amdgcn_exp2f(qa0[u][i] * LOG2E) * ph[i] + qh0[u][i]; pa[i] += qa0[u][i]; ph[4 + i] = __builtin_amdgcn_exp2f(qa1[u][i] * LOG2E) * ph[4 + i] + qh1[u][i]; pa[4 + i] += qa1[u][i]; } }
            for (; k < ke; ++k) { const float* ca = CA_ + ((size_t)(b * 256 + k)) * DM + c0; const float* ch = CH_ + ((size_t)(b * 256 + k)) * DM + c0;
              const f32x4 a0 = *(const f32x4*)ca, a1 = *(const f32x4*)(ca + 4), h0 = *(const f32x4*)ch, h1 = *(const f32x4*)(ch + 4);
#pragma unroll
              for (int i = 0; i < 4; ++i) { ph[i] = __builtin_amdgcn_exp2f(a0[i] * LOG2E) * ph[i] + h0[i]; pa[i] += a0[i]; ph[4 + i] = __builtin_amdgcn_exp2f(a1[i] * LOG2E) * ph[4 + i] + h1[i]; pa[4 + i] += a1[i]; } } }
          LAS float* pp = part + (wave * 64 + lane) * 16;
          *(LAS f32x4*)pp = (f32x4){pa[0], pa[1], pa[2], pa[3]}; *(LAS f32x4*)(pp + 4) = (f32x4){pa[4], pa[5], pa[6], pa[7]}; *(LAS f32x4*)(pp + 8) = (f32x4){ph[0], ph[1], ph[2], ph[3]}; *(LAS f32x4*)(pp + 12) = (f32x4){ph[4], ph[5], ph[6], ph[7]}; }
        __syncthreads();
#pragma unroll
        for (int i = 0; i < 8; ++i) h[i] = 0.f;
#pragma unroll
        for (int r = 0; r < 8; ++r) { const LAS float* pp = part + (r * 64 + lane) * 16; const f32x4 a0 = *(const LAS f32x4*)pp, a1 = *(const LAS f32x4*)(pp + 4), h0 = *(const LAS f32x4*)(pp + 8), h1 = *(const LAS f32x4*)(pp + 12);
#pragma unroll
            for (int i = 0; i < 4; ++i) { h[i] = __builtin_amdgcn_exp2f(a0[i] * LOG2E) * h[i] + h0[i]; h[4 + i] = __builtin_amdgcn_exp2f(a1[i] * LOG2E) * h[4 + i] + h1[i]; } }
        { int k = 8 * g;
          for (; k + 4 <= ck; k += 4) {
            f32x4 qa0[4], qa1[4], qh0[4], qh1[4];
#pragma unroll
            for (int u = 0; u < 4; ++u) { const float* ca = CA_ + ((size_t)(b * 256 + k + u)) * DM + c0; const float* ch = CH_ + ((size_t)(b * 256 + k + u)) * DM + c0;
                qa0[u] = *(const f32x4*)ca; qa1[u] = *(const f32x4*)(ca + 4); qh0[u] = *(const f32x4*)ch; qh1[u] = *(const f32x4*)(ch + 4); }
#pragma unroll
            for (int u = 0; u < 4; ++u)
#pragma unroll
                for (int i = 0; i < 4; ++i) { h[i] = __builtin_amdgcn_exp2f(qa0[u][i] * LOG2E) * h[i] + qh0[u][i]; h[4 + i] = __builtin_amdgcn_exp2f(qa1[u][i] * LOG2E) * h[4 + i] + qh1[u][i]; } }
          for (; k < ck; ++k) { const float* ca = CA_ + ((size_t)(b * 256 + k)) * DM + c0; const float* ch = CH_ + ((size_t)(b * 256 + k)) * DM + c0;
            const f32x4 a0 = *(const f32x4*)ca, a1 = *(const f32x4*)(ca + 4), h0 = *(const f32x4*)ch, h1 = *(const f32x4*)(ch + 4);
#pragma unroll
            for (int i = 0; i < 4; ++i) { h[i] = __builtin_amdgcn_exp2f(a0[i] * LOG2E) * h[i] + h0[i]; h[4 + i] = __builtin_amdgcn_exp2f(a1[i] * LOG2E) * h[4 + i] + h1[i]; } } }
        __syncthreads();
#pragma unroll 8
        for (int t = 0; t < 32; ++t) { const u32x4 lw = NTLD((const u32x4*)(LA_ + (r0 + t) * DM + c0)), bw = NTLD((const u32x4*)(BB_ + (r0 + t) * DM + c0)), yw = NTLD((const u32x4*)(YG_ + (r0 + t) * DM + c0));
            const float l[8] = {bflo(lw.x), bfhi(lw.x), bflo(lw.y), bfhi(lw.y), bflo(lw.z), bfhi(lw.z), bflo(lw.w), bfhi(lw.w)}, bv[8] = {bflo(bw.x), bfhi(bw.x), bflo(bw.y), bfhi(bw.y), bflo(bw.z), bfhi(bw.z), bflo(bw.w), bfhi(bw.w)},
                        yv[8] = {bflo(yw.x), bfhi(yw.x), bflo(yw.y), bfhi(yw.y), bflo(yw.z), bfhi(yw.z), bflo(yw.w), bfhi(yw.w)};
            float o[8];
#pragma unroll
            for (int i = 0; i < 8; ++i) { h[i] = __builtin_amdgcn_exp2f(l[i] * LOG2E) * h[i] + bv[i]; o[i] = h[i] * gelu_tanh(yv[i]); }
            u32x4 w; w.x = cvt_pk_bf16(o[0], o[1]); w.y = cvt_pk_bf16(o[2], o[3]); w.z = cvt_pk_bf16(o[4], o[5]); w.w = cvt_pk_bf16(o[6], o[7]); *(u32x4*)(REC_ + (r0 + t) * DM + c0) = w; }
    } }
    if (SPLIT_G4) SB_ARRIVE(K_G4W); else GRID_BAR();
    for (int rep_ = 0; rep_ < 1 + DUP(11); ++rep_) if (PH(11)) { pg8::Gemm g{P_ATT, DM, P_WAB, DM, M, DM, 512 + DM, 0}; g.A2 = P_REC; g.Bt2 = P_WRB; g.ksw = 512 / 64; if (SPLIT_G4) { g.sb_bar = (unsigned*)(KARGS()->ws); g.sb_st = (volatile LAS unsigned*)(lds + BAR_LDS_OFF); g.sb_mode = 2; g.sb_k = K_G4W; } if (gg) { g.sb_bar = (unsigned*)(KARGS()->ws); g.sb_st = (volatile LAS unsigned*)(lds + BAR_LDS_OFF); g.arr_u = 0; g.arr_k = K_G4; } if (BARSTAT == 316 || BARSTAT == 340 || BARSTAT == 341) g.ts = (unsigned long long*)(KARGS()->ws + 201 * 1024); SO.init(M, DM, G, bx); pg8::EpiGate E{P_GT, P_MG}; pg8::gemm_phase(lds, g, SO, E); }

    if (gg) { SB_ARRIVE(K_G4 + 1u); SB_WAIT(K_G4); } else GRID_BAR();
    for (int rep_ = 0; rep_ < 1 + DUP(12); ++rep_) if (PH(12)) { pg8::Gemm g{P_MG, DM, P_WOUT, DM, M, DM, DM, 0}; SO.init(M, DM, G, bx); if (gg) { g.sb_bar = (unsigned*)(KARGS()->ws); g.sb_st = (volatile LAS unsigned*)(lds + BAR_LDS_OFF); g.sb_mode = 3; g.sb_u = 0; g.sb_k = K_G4 + 1u; } if (SPLIT_GN) { g.sb_bar = (unsigned*)(KARGS()->ws); g.sb_st = (volatile LAS unsigned*)(lds + BAR_LDS_OFF); g.arr_u = 0; g.arr_k = K_G4N; } if (BARSTAT == 314) g.ts = (unsigned long long*)(KARGS()->ws + 201 * 1024);
        if (FUSED_NORM) { pg8::EpiNormRes<1> E{nullptr, P_AB, nullptr, P_mpost, 1.0f, P_XS, 2u, P_RSQ2, lds + NORM_LDS_OFF}; pg8::gemm_phase(lds, g, SO, E); }
        else { pg8::EpiBf16 E{P_Fb, DM}; pg8::gemm_phase(lds, g, SO, E); } }

    if (!FUSED_NORM) GRID_BAR();
    for (int rep_ = 0; rep_ < 1 + DUP(13); ++rep_) if (PH(13) && !FUSED_NORM) { PHASE_IDS(); norm_pass<false, false>(P_Fb, P_AB, nullptr, P_mpost, 1.0f, nullptr, P_RSQ2, gw, NGW, lane); }
    if (SPLIT_GN) { SB_ARRIVE(K_G4N + 1u); SB_WAIT(K_G4N); } else GRID_BAR();
    for (int rep_ = 0; rep_ < 1 + DUP(14); ++rep_) if (PH(14)) { pg8::Gemm g{P_AB, DM, P_WGU2, DM, M, 2 * FF, DM, 0}; SO.init(M, 2 * FF, G, bx); if (gg) { g.sb_bar = (unsigned*)(KARGS()->ws); g.sb_st = (volatile LAS unsigned*)(lds + BAR_LDS_OFF); g.arr_u = 5; g.arr_k = K_G5; } if (SPLIT_GN) { g.sb_bar = (unsigned*)(KARGS()->ws); g.sb_st = (volatile LAS unsigned*)(lds + BAR_LDS_OFF); g.sb_mode = 1; g.sb_k = K_G4N + 1u; g.prep_split = 1; }     pg8::EpiSwiGLU E{P_HID, FF, P_RSQ2, (LAS float*)(lds + NORM_LDS_OFF)}; pg8::gemm_phase(lds, g, SO, E); }
    if (gg) { SB_ARRIVE(K_G5 + 1u); SB_WAIT(K_G5); } else GRID_BAR();
    for (int rep_ = 0; rep_ < 1 + DUP(15); ++rep_) if (PH(15)) { pg8::Gemm g{P_HID, FF, P_WD2, FF, M, DM, FF, 0}; SO.init(M, DM, G, bx); if (gg) { g.sb_bar = (unsigned*)(KARGS()->ws); g.sb_st = (volatile LAS unsigned*)(lds + BAR_LDS_OFF); g.sb_mode = 3; g.sb_u = 0; g.sb_k = K_G5 + 1u; }
        if (FUSED_NORM) { pg8::EpiNormRes<2> E{nullptr, P_AB, P_out, P_n2post, 0.5f, P_XS, 3u, nullptr, lds + NORM_LDS_OFF}; pg8::gemm_phase(lds, g, SO, E); }
        else { pg8::EpiBf16 E{P_Fb, DM}; pg8::gemm_phase(lds, g, SO, E); } }
    if (!FUSED_NORM) GRID_BAR();
    for (int rep_ = 0; rep_ < 1 + DUP(16); ++rep_) if (PH(16) && !FUSED_NORM) { PHASE_IDS(); norm_pass<false, true>(P_Fb, P_AB, nullptr, P_n2post, 0.5f, P_out, nullptr, gw, NGW, lane); }
    if (BARSTAT) {
        const unsigned long long tend_ = __builtin_amdgcn_s_memrealtime();
        if (TIDX() == 0) ((unsigned long long*)(KARGS()->ws + 32768))[(15 * 256 + blockIdx.x) * 2 + 1] = tend_;
        GRID_BAR_RAW();
        if (blockIdx.x == 0 && TIDX() == 0) {
            const unsigned long long* wt_ = (const unsigned long long*)(KARGS()->ws + 32768); const int nb_ = bar_idx; float val = 0.f;
            float tot_mean = 0.f, tot_max = 0.f, sel_mean = 0.f;
            for (int bi = 0; bi < nb_; ++bi) { float sm = 0.f, mx_ = 0.f; for (int w_ = 0; w_ < 256; ++w_) { const float d_ = (float)__hip_atomic_load(wt_ + (bi * 256 + w_) * 2, __ATOMIC_RELAXED, __HIP_MEMORY_SCOPE_AGENT) * 0.01f; sm += d_; mx_ = fmaxf(mx_, d_); }
                sm *= (1.f / 256.f); tot_mean += sm; tot_max += mx_; if (bi == BARSTAT - 1) sel_mean = sm; }
            unsigned long long t_first = ~0ull, t_last = 0ull; for (int w_ = 0; w_ < 256; ++w_) { const unsigned long long a_ = __hip_atomic_load(wt_ + (0 * 256 + w_) * 2 + 1, __ATOMIC_RELAXED, __HIP_MEMORY_SCOPE_AGENT), b_ = __hip_atomic_load(wt_ + (15 * 256 + w_) * 2 + 1, __ATOMIC_RELAXED, __HIP_MEMORY_SCOPE_AGENT); if (a_ < t_first) t_first = a_; if (b_ > t_last) t_last = b_; }
            if (BARSTAT >= 200 && BARSTAT < 300) { const int pi_ = BARSTAT - 200; const int ia_ = (pi_ == 0) ? 14 : pi_ - 1, ib_ = (pi_ >= nb_) ? 15 : pi_; unsigned long long ta_ = 0ull, tb_ = 0ull;
                for (int w_ = 0; w_ < 256; ++w_) { const unsigned long long a_ = __hip_atomic_load(wt_ + (ia_ * 256 + w_) * 2 + 1, __ATOMIC_RELAXED, __HIP_MEMORY_SCOPE_AGENT), b_ = __hip_atomic_load(wt_ + (ib_ * 256 + w_) * 2 + 1, __ATOMIC_RELAXED, __HIP_MEMORY_SCOPE_AGENT); if (a_ > ta_) ta_ = a_; if (b_ > tb_) tb_ = b_; }
                val = ((float)(tb_ - ta_) * 0.01f - (float)BAROFF) * (float)BARSCL; if (BARQ > 0) val = floorf(val / (float)BARQ) * (float)BARQ; }
            else if (BARSTAT >= 500 && BARSTAT < 756) { const int ia_ = (BARSTAT - 500) / 16, ib_ = (BARSTAT - 500) % 16; unsigned long long ta_ = 0ull, tb_ = 0ull;
                for (int w_ = 0; w_ < 256; ++w_) { const unsigned long long a_ = __hip_atomic_load(wt_ + (ia_ * 256 + w_) * 2 + 1, __ATOMIC_RELAXED, __HIP_MEMORY_SCOPE_AGENT), b_ = __hip_atomic_load(wt_ + (ib_ * 256 + w_) * 2 + 1, __ATOMIC_RELAXED, __HIP_MEMORY_SCOPE_AGENT); if (a_ > ta_) ta_ = a_; if (b_ > tb_) tb_ = b_; }
                val = (float)(tb_ - ta_) * 0.01f - (float)BAROFF; if (BARQ > 0) val = floorf(val / (float)BARQ) * (float)BARQ; }
            else if (BARSTAT >= 400 && BARSTAT < 460) { const int bi = (BARSTAT - 400) % 20, md = (BARSTAT - 400) / 20; unsigned long long mn = ~0ull, mx2 = 0ull; double sm = 0.0;
                unsigned long long mxe = 0ull;
                for (int w_ = 0; w_ < 256; ++w_) { const unsigned long long w8 = __hip_atomic_load(wt_ + (bi * 256 + w_) * 2, __ATOMIC_RELAXED, __HIP_MEMORY_SCOPE_AGENT), e8 = __hip_atomic_load(wt_ + (bi * 256 + w_) * 2 + 1, __ATOMIC_RELAXED, __HIP_MEMORY_SCOPE_AGENT);
                    const unsigned long long a8 = e8 - w8; if (a8 < mn) mn = a8; if (a8 > mx2) mx2 = a8; if (e8 > mxe) mxe = e8; sm += (double)(a8 & 0xffffffffull); }
                const double mean_lo = sm / 256.0; const double mx_lo = (double)(mx2 & 0xffffffffull);
                val = (md == 0) ? (float)(mx2 - mn) * 0.01f : (md == 1) ? (float)(mx_lo - mean_lo) * 0.01f : (float)(mxe - mx2) * 0.01f; }
            else if (BARSTAT >= 350 && BARSTAT < 360) { const unsigned long long* t_ = (const unsigned long long*)(KARGS()->ws + 203 * 1024); const int w_ = (BARSTAT - 350) >> 1, q_ = (BARSTAT - 350) & 1;
                val = q_ == 0 ? (float)t_[w_ * 4 + 0] / (float)t_[w_ * 4 + 2] : (float)t_[w_ * 4 + 1] / (float)t_[w_ * 4 + 3]; }
            else if (BARSTAT >= 346 && BARSTAT <= 349) { const unsigned long long* t_ = (const unsigned long long*)(KARGS()->ws + 201 * 1024); const int k_ = BARSTAT - 346; val = (float)(t_[7 + k_] - t_[6 + k_]) * 0.1f; }
            else if (BARSTAT == 344) { const unsigned long long* t_ = (const unsigned long long*)(KARGS()->ws + 201 * 1024); val = ((float)(t_[4] - t_[5]) * 0.01f - 19.f) * 10.f; }
            else if (BARSTAT >= 340 && BARSTAT <= 345) { const unsigned long long* t_ = (const unsigned long long*)(KARGS()->ws + 201 * 1024); val = (float)(t_[5] - t_[4]) * 0.1f; }
            else if (BARSTAT >= 330 && BARSTAT < 340) { const unsigned long long* t_ = (const unsigned long long*)(KARGS()->ws + 202 * 1024); const int k_ = BARSTAT - 330; val = (float)(t_[k_ + 1] - t_[k_]) * 0.1f; }
            else if (BARSTAT == 321 || BARSTAT == 322) { unsigned long long mn = ~0ull, mx_ = 0ull; for (int w_ = 0; w_ < 256; ++w_) { const unsigned long long a_ = __hip_atomic_load(wt_ + (13 * 256 + w_) * 2 + 1, __ATOMIC_RELAXED, __HIP_MEMORY_SCOPE_AGENT); if (a_ < mn) mn = a_; if (a_ > mx_) mx_ = a_; }
                unsigned long long rel = 0ull; for (int w_ = 0; w_ < 256; ++w_) { const unsigned long long a_ = __hip_atomic_load(wt_ + (14 * 256 + w_) * 2 + 1, __ATOMIC_RELAXED, __HIP_MEMORY_SCOPE_AGENT); if (a_ > rel) rel = a_; }
                val = (BARSTAT == 321) ? (float)(mx_ - mn) * 0.01f : (float)(rel - mx_) * 0.01f; }
            else if (BARSTAT == 320) { float sm = 0.f; for (int w_ = 0; w_ < 256; ++w_) sm += (float)__hip_atomic_load(wt_ + (14 * 256 + w_) * 2, __ATOMIC_RELAXED, __HIP_MEMORY_SCOPE_AGENT) * 0.01f; val = sm * (1.f / 256.f); }
            else if (BARSTAT >= 310) { const unsigned long long* t_ = (const unsigned long long*)(KARGS()->ws + 201 * 1024); const int a_ = (BARSTAT == 310) ? 0 : (BARSTAT == 311 ? 2 : 1), b_ = (BARSTAT == 310) ? 1 : (BARSTAT == 311 ? 3 : 2);     val = (float)(t_[b_] - t_[a_]) * 0.01f; if (BARSTAT == 310 || BARSTAT == 311) val *= 10.f; }
            else if (BARSTAT == 300) val = (((const float*)(KARGS()->ws + 200 * 1024))[0] - 1500.f) * 0.1f;
            else if (BARSTAT == 100) val = tot_mean; else if (BARSTAT == 101) val = tot_max; else if (BARSTAT == 103) { unsigned long long tb0 = 0ull; for (int w_ = 0; w_ < 256; ++w_) { const unsigned long long a_ = __hip_atomic_load(wt_ + (0 * 256 + w_) * 2 + 1, __ATOMIC_RELAXED, __HIP_MEMORY_SCOPE_AGENT); if (a_ > tb0) tb0 = a_; } val = (float)(t_last - tb0) * 0.01f - (float)BAROFF; }
            else if (BARSTAT == 102) { val = (float)(t_last - t_first) * 0.01f - (float)BAROFF; if (BARQ > 0) val = floorf(val / (float)BARQ) * (float)BARQ; } else val = sel_mean;
            KARGS()->out[0] = val;
        }
    }
}

extern "C" void kernel_launch(void* const* d_in, const int* in_sizes, int n_in, void* d_out, int out_size, void* d_ws, size_t ws_size, hipStream_t stream) {
    static int grid = 0;
    if (grid == 0) {
        if (n_in != 25 || out_size != M * DM || ws_size < WS_END) { fprintf(stderr, "kernel_launch: unexpected shapes (n_in %d out %d ws %zu)\n", n_in, out_size, ws_size); grid = -1; return; }
        int dev = 0, cus = 0, per_cu = 0;
        hipGetDevice(&dev); hipDeviceGetAttribute(&cus, hipDeviceAttributeMultiprocessorCount, dev);
        hipFuncSetAttribute((const void*)mk_fwd, hipFuncAttributeMaxDynamicSharedMemorySize, LDS_BYTES);
        hipOccupancyMaxActiveBlocksPerMultiprocessor(&per_cu, (const void*)mk_fwd, NTHREADS, LDS_BYTES);
        if (per_cu < 1) { fprintf(stderr, "kernel_launch: occupancy query says %d blocks per CU\n", per_cu); per_cu = 1; }
        grid = cus;
        if ((SPLIT_GG || SPLIT_GN || SPLIT_LA) && cus != 256) { fprintf(stderr, "kernel_launch: this build's GEMM->GEMM seams assume 256 CUs (found %d)\n", cus); grid = -1; return; }
        fprintf(stderr, "kernel_launch: cus %d per_cu %d grid %d\n", cus, per_cu, grid);
    }
    if (grid < 0) return;
    if (hipMemsetAsync(d_ws, 0, 65536, stream) != hipSuccess) { fprintf(stderr, "kernel_launch: memset failed\n"); return; }
    Args a{};
    for (int i = 0; i < 25; ++i) a.in[i] = (const float*)d_in[i];
    a.out = (float*)d_out; a.ws = (unsigned char*)d_ws;
    void* kargs[] = {&a};
    hipError_t e = hipLaunchCooperativeKernel((const void*)mk_fwd, dim3(grid), dim3(NTHREADS), kargs, LDS_BYTES, stream);
    if (e != hipSuccess) fprintf(stderr, "cooperative launch failed: %s (grid %d)\n", hipGetErrorString(e), grid);
}
```
